# Optimizing an MI355X kernel written in HIP

```python
import math
import jax, jax.numpy as jnp
from jax import lax
import numpy as np

D_MODEL = 2048
BATCH = 2
SEQ = 16384
DEPTH = 2

GRID_W = 64
CTX_LEN = 256
CHUNK = 128
A_GROUPS = 8
A_DIM = D_MODEL // 2 // A_GROUPS
A_WIDTH = A_GROUPS * A_DIM
B_HEADS = 8
B_DIM = D_MODEL // 2 // B_HEADS
B_WIDTH = B_HEADS * B_DIM
NA_ROWS = 8
NA_COLS = 16
C_WIDTH = D_MODEL
CONV_W = 3
N_EXPERTS = 16
CAP_FACTOR = 2
EXPERT_FF = D_MODEL // 2
N_EVEN = (DEPTH + 1) // 2
N_ODD = DEPTH // 2
EPS = 1e-6

kernel_name = "hybrid_gmlp_natten_shortconv_ecmoe_dit"


def rmsnorm(x, g):
    xf = x.astype(jnp.float32)
    y = xf * lax.rsqrt(jnp.mean(xf * xf, axis=-1, keepdims=True) + EPS)
    return (y * g.astype(jnp.float32)).astype(x.dtype)


def modulate(h, shift, scale):
    return h * (1 + scale) + shift


def softmax32(s):
    return jax.nn.softmax(s.astype(jnp.float32), axis=-1)


def chunk_gmlp(u, v, w_s, b_s, g_v):
    B, N, _ = u.shape
    u = u.reshape(B, N, A_GROUPS, A_DIM)
    vn = rmsnorm(v.reshape(B, N, A_GROUPS, A_DIM), g_v)
    vn = vn.reshape(B, N // CHUNK, CHUNK, A_GROUPS, A_DIM)
    s = jnp.einsum('gpq,bnqgc->bnpgc', w_s, vn) + b_s.T[:, :, None]
    return (u * s.reshape(B, N, A_GROUPS, A_DIM)).reshape(B, N, A_WIDTH)


def context_attention(q, k, v):
    B, L, H, d = q.shape
    s = jnp.einsum('blhd,bmhd->bhlm', q, k).astype(jnp.float32) * (d ** -0.5)
    p = softmax32(s).astype(v.dtype)
    return jnp.einsum('bhlm,bmhd->blhd', p, v).reshape(B, L, H * d)


def neighborhood_attention(q, k, v, kc, vc, rpb):
    B, S, H, d = q.shape
    rows = S // GRID_W
    kr = min(NA_ROWS, rows)
    scale = d ** -0.5
    qg = q.reshape(B, rows, GRID_W, H, d)
    kg = k.reshape(B, rows, GRID_W, H, d)
    vg = v.reshape(B, rows, GRID_W, H, d)
    cols = jnp.arange(GRID_W)
    cstart = jnp.clip(cols - NA_COLS // 2, 0, GRID_W - NA_COLS)
    cidx = cstart[:, None] + jnp.arange(NA_COLS)[None, :]
    col_off = cidx - cols[:, None] + (NA_COLS - 1)
    rpb_col = rpb[:, :, col_off]

    def row_step(r):
        rs = jnp.clip(r - kr // 2, 0, rows - kr)
        qr = lax.dynamic_index_in_dim(qg, r, axis=1, keepdims=False)
        kb = lax.dynamic_slice_in_dim(kg, rs, kr, axis=1)
        vb = lax.dynamic_slice_in_dim(vg, rs, kr, axis=1)
        kw = kb[:, :, cidx]
        vw = vb[:, :, cidx]
        row_off = rs + jnp.arange(kr) - r + (NA_ROWS - 1)
        bias = jnp.transpose(rpb_col[:, row_off], (0, 2, 1, 3))
        s_loc = jnp.einsum('bjhd,brjchd->bhjrc', qr, kw).astype(jnp.float32) * scale + bias[None]
        s_ctx = jnp.einsum('bjhd,blhd->bhjl', qr, kc).astype(jnp.float32) * scale
        s_all = jnp.concatenate([s_loc.reshape(B, H, GRID_W, kr * NA_COLS), s_ctx], axis=-1)
        p = softmax32(s_all).astype(v.dtype)
        p_loc = p[..., :kr * NA_COLS].reshape(B, H, GRID_W, kr, NA_COLS)
        p_ctx = p[..., kr * NA_COLS:]
        return (jnp.einsum('bhjrc,brjchd->bjhd', p_loc, vw)
                + jnp.einsum('bhjl,blhd->bjhd', p_ctx, vc))

    out = lax.map(row_step, jnp.arange(rows))
    return jnp.moveaxis(out, 0, 1).reshape(B, S, H * d)


def split_ab(p, gq, gk):
    B, N, _ = p.shape
    u = jax.nn.gelu(p[..., :A_WIDTH])
    v = jax.nn.gelu(p[..., A_WIDTH:2 * A_WIDTH])
    o = 2 * A_WIDTH
    q = rmsnorm(p[..., o:o + B_WIDTH].reshape(B, N, B_HEADS, B_DIM), gq)
    k = rmsnorm(p[..., o + B_WIDTH:o + 2 * B_WIDTH].reshape(B, N, B_HEADS, B_DIM), gk)
    vv = p[..., o + 2 * B_WIDTH:o + 3 * B_WIDTH].reshape(B, N, B_HEADS, B_DIM)
    return u, v, q, k, vv


def mixer_ab(hl, hc, w_in, w_out, w_s, b_s, g_v, gq, gk, rpb, with_ctx_out):
    ul, vl, ql, kl, vvl = split_ab(hl @ w_in, gq, gk)
    uc, vc, qc, kc, vvc = split_ab(hc @ w_in, gq, gk)
    a_l = chunk_gmlp(ul, vl, w_s, b_s, g_v)
    b_l = neighborhood_attention(ql, kl, vvl, kc, vvc, rpb)
    out_l = jnp.concatenate([a_l, b_l], axis=-1) @ w_out
    out_c = None
    if with_ctx_out:
        a_c = chunk_gmlp(uc, vc, w_s, b_s, g_v)
        b_c = context_attention(qc, kc, vvc)
        out_c = jnp.concatenate([a_c, b_c], axis=-1) @ w_out
    return out_l, out_c


def short_conv(z, w):
    N = z.shape[1]
    pad = CONV_W // 2
    zp = jnp.pad(z, ((0, 0), (pad, pad), (0, 0)))
    y = w[0] * zp[:, 0:N]
    for t in range(1, CONV_W):
        y = y + w[t] * zp[:, t:t + N]
    return y


def mixer_c(h, w_in, conv_w, w_out):
    p = h @ w_in
    bg = p[..., :C_WIDTH]
    cg = p[..., C_WIDTH:2 * C_WIDTH]
    z = p[..., 2 * C_WIDTH:]
    return (bg * short_conv(cg * z, conv_w)) @ w_out


def ec_moe(h, w_r, w_gate, w_up, w_down):
    B, N, D = h.shape
    cap = CAP_FACTOR * N // N_EXPERTS
    aff = softmax32(jnp.einsum('bnd,de->bne', h, w_r))
    g, idx = lax.top_k(jnp.transpose(aff, (0, 2, 1)), cap)
    xs = jax.vmap(lambda hb, ib: hb[ib])(h, idx)
    hid = jax.nn.silu(jnp.einsum('becd,edf->becf', xs, w_gate)) * jnp.einsum('becd,edf->becf', xs, w_up)
    y = jnp.einsum('becf,efd->becd', hid, w_down) * g[..., None].astype(h.dtype)
    return jax.vmap(lambda ib, yb: jnp.zeros((N, D), yb.dtype).at[ib.reshape(-1)].add(yb.reshape(-1, D)))(idx, y)


def setup_inputs(seed: int = 0) -> dict:
    key = jax.random.key(seed)
    ks = jax.random.split(key, 24)
    D = D_MODEL

    def nrm(k, shape, s):
        return jax.random.normal(k, shape, jnp.float32) * s

    return {
        "x": nrm(ks[0], (BATCH, SEQ, D), 1.0),
        "c": nrm(ks[1], (BATCH, D), 1.0),
        "ctx": nrm(ks[2], (BATCH, CTX_LEN, D), 1.0),
        "c_ctx": nrm(ks[3], (D,), 1.0),
        "ada_w": nrm(ks[4], (DEPTH, D, 6 * D), D ** -0.5),
        "ada_b": nrm(ks[5], (DEPTH, 6 * D), 0.02),
        "norm1_g": 1.0 + nrm(ks[6], (DEPTH, D), 0.02),
        "norm2_g": 1.0 + nrm(ks[7], (DEPTH, D), 0.02),
        "ab_w_in": nrm(ks[8], (N_EVEN, D, 2 * A_WIDTH + 3 * B_WIDTH), D ** -0.5),
        "ab_w_out": nrm(ks[9], (N_EVEN, A_WIDTH + B_WIDTH, D), (A_WIDTH + B_WIDTH) ** -0.5),
        "a_ws": nrm(ks[10], (N_EVEN, A_GROUPS, CHUNK, CHUNK), CHUNK ** -0.5),
        "a_bs": 1.0 + nrm(ks[11], (N_EVEN, A_GROUPS, CHUNK), 0.02),
        "a_vnorm_g": 1.0 + nrm(ks[12], (N_EVEN, A_GROUPS, A_DIM), 0.02),
        "b_qnorm_g": 1.0 + nrm(ks[13], (N_EVEN, B_DIM), 0.02),
        "b_knorm_g": 1.0 + nrm(ks[14], (N_EVEN, B_DIM), 0.02),
        "b_rpb": nrm(ks[15], (N_EVEN, B_HEADS, 2 * NA_ROWS - 1, 2 * NA_COLS - 1), 0.1),
        "c_w_in": nrm(ks[16], (N_ODD, D, 3 * C_WIDTH), D ** -0.5),
        "c_conv_w": nrm(ks[17], (N_ODD, CONV_W, C_WIDTH), CONV_W ** -0.5),
        "c_w_out": nrm(ks[18], (N_ODD, C_WIDTH, D), C_WIDTH ** -0.5),
        "router_w": nrm(ks[19], (DEPTH, D, N_EXPERTS), D ** -0.5),
        "moe_w_gate": nrm(ks[20], (DEPTH, N_EXPERTS, D, EXPERT_FF), D ** -0.5),
        "moe_w_up": nrm(ks[21], (DEPTH, N_EXPERTS, D, EXPERT_FF), D ** -0.5),
        "moe_w_down": nrm(ks[22], (DEPTH, N_EXPERTS, EXPERT_FF, D), EXPERT_FF ** -0.5),
    }


def reference(x, c, ctx, c_ctx, ada_w, ada_b, norm1_g, norm2_g, ab_w_in, ab_w_out, a_ws, a_bs,
              a_vnorm_g, b_qnorm_g, b_knorm_g, b_rpb, c_w_in, c_conv_w, c_w_out, router_w,
              moe_w_gate, moe_w_up, moe_w_down):
    xl = x
    xc = ctx
    for i in range(DEPTH):
        upd_ctx = i < DEPTH - 1
        mod_l = (jax.nn.silu(c) @ ada_w[i] + ada_b[i])[:, None, :]
        mod_c = jax.nn.silu(c_ctx) @ ada_w[i] + ada_b[i]
        sh1, sc1, g1, sh2, sc2, g2 = jnp.split(mod_l, 6, axis=-1)
        csh1, csc1, cg1, csh2, csc2, cg2 = jnp.split(mod_c, 6, axis=-1)

        hl = modulate(rmsnorm(xl, norm1_g[i]), sh1, sc1)
        if i % 2 == 0:
            j = i // 2
            hc = modulate(rmsnorm(xc, norm1_g[i]), csh1, csc1)
            ml, mc = mixer_ab(hl, hc, ab_w_in[j], ab_w_out[j], a_ws[j], a_bs[j], a_vnorm_g[j],
                              b_qnorm_g[j], b_knorm_g[j], b_rpb[j], upd_ctx)
        else:
            j = i // 2
            ml = mixer_c(hl, c_w_in[j], c_conv_w[j], c_w_out[j])
            mc = None
            if upd_ctx:
                hc = modulate(rmsnorm(xc, norm1_g[i]), csh1, csc1)
                mc = mixer_c(hc, c_w_in[j], c_conv_w[j], c_w_out[j])
        xl = xl + g1 * ml
        if upd_ctx:
            xc = xc + cg1 * mc

        xl = xl + g2 * ec_moe(modulate(rmsnorm(xl, norm2_g[i]), sh2, sc2),
                              router_w[i], moe_w_gate[i], moe_w_up[i], moe_w_down[i])
        if upd_ctx:
            xc = xc + cg2 * ec_moe(modulate(rmsnorm(xc, norm2_g[i]), csh2, csc2),
                                   router_w[i], moe_w_gate[i], moe_w_up[i], moe_w_down[i])
    return xl
```

```cpp
#include <hip/hip_runtime.h>
#include <cstdio>
#include <cstdint>

#ifndef MK_SPLIT
#define MK_SPLIT 0
#endif
#ifndef MK_STOP
#define MK_STOP 99
#endif

namespace pg8 {
#define PG8_LAS __attribute__((address_space(3)))
typedef unsigned short bf16_t;
typedef short bf16x8 __attribute__((ext_vector_type(8)));
typedef float f32x4 __attribute__((ext_vector_type(4)));
typedef unsigned u32x4 __attribute__((ext_vector_type(4)));
constexpr int BM = 256, BK = 64, HALF = 128, HTB = HALF * BK * 2, STAGE_BYTES = 8 * HTB, NXCD = 8, WGM = 8;

__host__ __device__ __forceinline__ int lds_byte(int r, int c) { const int st = (r >> 4) * 2 + (c >> 5), rr = r & 15, cc = c & 31, ob = rr * 64 + cc * 2; return st * 1024 + (ob ^ (((ob >> 9) & 1) << 5)); }
__host__ __device__ __forceinline__ void stage_rc(int b, int& R, int& C) { const int st = b / 1024, sb = b % 1024, swz = sb ^ (((sb >> 9) & 1) << 5); R = (st >> 1) * 16 + swz / 64; C = (st & 1) * 32 + (swz % 64) / 2; }
__host__ __device__ __forceinline__ int perm32(int rho) { const int n = rho >> 4, i = rho & 15; return 8 * (i >> 2) + 4 * n + (i & 3); }

struct Unit { int pm, pn, pb; };
struct Gemm { const bf16_t* A; const bf16_t* Bt; int M, N, K; };

template <bool GROUPED>
struct StaticOrder {
    int nM, nN, nwg, G, c;
    __host__ __device__ void init(int M, int N, int G_, int c_) { nM = M / BM; nN = N / BM; nwg = nM * nN; G = G_; c = c_; }
    __host__ __device__ bool next(int i, Unit& u) const {
        const long L = (long)i * G + c; if (L >= nwg) return false;
        int wgid = (int)L; { const int q = nwg / NXCD, r = nwg % NXCD, xcd = wgid % NXCD, off = wgid / NXCD; wgid = (xcd < r ? xcd * (q + 1) : r * (q + 1) + (xcd - r) * q) + off; }
        const int nig = WGM * nN, gid = wgid / nig, fm = gid * WGM, gsz = (nM - fm) < WGM ? (nM - fm) : WGM;
        u.pm = fm + ((wgid % nig) % gsz); u.pn = (wgid % nig) / gsz;
        u.pb = GROUPED ? ((u.pm >> 4) * 8 + u.pn) : u.pn;
        return true;
    }
    __device__ __forceinline__ void a_ready(const Unit&) const {}
    __device__ __forceinline__ void done(const Unit&) const {}
};

__device__ __forceinline__ unsigned cvt_pk_bf16(float lo, float hi) { unsigned r; asm volatile("v_cvt_pk_bf16_f32 %0, %1, %2" : "=v"(r) : "v"(lo), "v"(hi)); return r; }

template <class Epi, class Sched, bool ALIGN_EPI = false, bool SP2 = false>
__device__ __forceinline__ void gemm_phase(PG8_LAS unsigned char* lds, const Gemm g, const Sched& S, const Epi& E) {
    const int tid = threadIdx.x, wid = __builtin_amdgcn_readfirstlane(tid >> 6), lane = tid & 63, wr = wid >> 2, wc = wid & 3, fr = lane & 15, fq = lane >> 4;
    const int K = g.K, nt = K / BK;
    unsigned voffA[2], voffB[2];
#pragma unroll
    for (int i = 0; i < 2; ++i) { int R, C; stage_rc(tid * 16 + i * 8192, R, C); const int Rb = Epi::PERM ? ((R & ~31) + perm32(R & 31)) : R;
        voffA[i] = (unsigned)(R * K + C) * 2u; voffB[i] = (unsigned)(Rb * K + C) * 2u; }
    const size_t kstep = (size_t)(BK * 2);
    const size_t hstep = (size_t)HALF * K * 2;
    const size_t tstep = 2 * hstep;
    const unsigned ldsw = (unsigned)wid * 1024u;
    const int aoff = lds_byte(wr * 64 + fr, fq * 8), boff = lds_byte(wc * 32 + fr, fq * 8);
#define PG8_SA(b, h) (((b) * 2 + (h)) * HTB)
#define PG8_SB(b, h) ((4 + (b) * 2 + (h)) * HTB)
#define PG8_STAGE(bufoff, gbase, voff) do { _Pragma("unroll") for (int _i = 0; _i < 2; ++_i) \
        __builtin_amdgcn_global_load_lds((const unsigned*)((const char*)(gbase) + (voff)[_i]), (PG8_LAS unsigned*)(lds + (bufoff) + ldsw + _i * 8192), 16, 0, 0); } while (0)
#define PG8_LDA(dst, b, h) do { _Pragma("unroll") for (int m = 0; m < 4; ++m) _Pragma("unroll") for (int k = 0; k < 2; ++k) dst[m][k] = *(const PG8_LAS bf16x8*)(lds + PG8_SA(b, h) + aoff + m * 2048 + k * 1024); } while (0)
#define PG8_LDB(dst, b, h) do { _Pragma("unroll") for (int n = 0; n < 2; ++n) _Pragma("unroll") for (int k = 0; k < 2; ++k) dst[n][k] = *(const PG8_LAS bf16x8*)(lds + PG8_SB(b, h) + boff + n * 2048 + k * 1024); } while (0)
#define PG8_MMA(ai, bj, At, Bt) do { __builtin_amdgcn_s_setprio(1); _Pragma("unroll") for (int m = 0; m < 4; ++m) _Pragma("unroll") for (int n = 0; n < 2; ++n) _Pragma("unroll") for (int k = 0; k < 2; ++k) \
        acc[ai][bj][m][n] = __builtin_amdgcn_mfma_f32_16x16x32_bf16(Bt[n][k], At[m][k], acc[ai][bj][m][n], 0, 0, 0); __builtin_amdgcn_s_setprio(0); } while (0)
#define PG8_WAIT_V(n) asm volatile("s_waitcnt vmcnt(" #n ")" ::: "memory")
#define PG8_WAIT_L(n) asm volatile("s_waitcnt lgkmcnt(" #n ")" ::: "memory")
#define PG8_BAR __builtin_amdgcn_s_barrier()
#define PG8_SCHED __builtin_amdgcn_sched_barrier(0)
    Unit cur, nxt; int ui = 0;
    if (!S.next(0, cur)) return;
    f32x4 acc[2][2][4][2];
#pragma unroll
    for (int a = 0; a < 2; ++a)
#pragma unroll
        for (int b = 0; b < 2; ++b)
#pragma unroll
            for (int m = 0; m < 4; ++m)
#pragma unroll
                for (int n = 0; n < 2; ++n) acc[a][b][m][n] = (f32x4){0.f, 0.f, 0.f, 0.f};
    bf16x8 At[4][2], B0[2][2], B1[2][2];
    const char* cA = (const char*)g.A + (size_t)cur.pm * tstep; const char* cB = (const char*)g.Bt + (size_t)cur.pb * tstep;
    S.a_ready(cur);
    if constexpr (SP2) {
        PG8_STAGE(PG8_SB(0, 0), cB, voffB); PG8_STAGE(PG8_SB(0, 1), cB + hstep, voffB); PG8_STAGE(PG8_SA(0, 0), cA, voffA); PG8_STAGE(PG8_SA(0, 1), cA + hstep, voffA);
        if (wr == 1) PG8_BAR;
        PG8_WAIT_V(2); PG8_BAR;
        PG8_STAGE(PG8_SB(1, 0), cB + kstep, voffB); PG8_STAGE(PG8_SA(1, 0), cA + kstep, voffA); PG8_STAGE(PG8_SB(1, 1), cB + hstep + kstep, voffB);
        PG8_WAIT_V(6); PG8_BAR;
    } else {
        PG8_STAGE(PG8_SB(0, 0), cB, voffB); PG8_STAGE(PG8_SA(0, 0), cA, voffA); PG8_STAGE(PG8_SB(0, 1), cB + hstep, voffB); PG8_STAGE(PG8_SA(0, 1), cA + hstep, voffA);
        if (wr == 1) PG8_BAR;
        PG8_WAIT_V(4); PG8_BAR;
        PG8_STAGE(PG8_SB(1, 0), cB + kstep, voffB); PG8_STAGE(PG8_SA(1, 0), cA + kstep, voffA); PG8_STAGE(PG8_SB(1, 1), cB + hstep + kstep, voffB);
        PG8_WAIT_V(6); PG8_BAR;
    }
    for (;;) {
        const bool has_next = S.next(ui + 1, nxt);
        const char* nA = has_next ? (const char*)g.A + (size_t)nxt.pm * tstep : cA; const char* nB = has_next ? (const char*)g.Bt + (size_t)nxt.pb * tstep : cB;
        for (int t = 0; t < nt; t += 2) {
            const bool last = (t == nt - 2);
            const char* a1 = cA + (size_t)(t + 1) * kstep;
            const char* a2 = last ? nA : cA + (size_t)(t + 2) * kstep; const char* b2 = last ? nB : cB + (size_t)(t + 2) * kstep;
            const char* a3 = a2 + kstep; const char* b3 = b2 + kstep;
            if (last && has_next) S.a_ready(nxt);
            if constexpr (SP2) {
            PG8_LDB(B0, 0, 0); PG8_LDB(B1, 0, 1); PG8_SCHED; PG8_LDA(At, 0, 0); PG8_STAGE(PG8_SA(1, 1), a1 + hstep, voffA);
            PG8_WAIT_V(8); PG8_WAIT_L(0); PG8_BAR; PG8_MMA(0, 0, At, B0); PG8_MMA(0, 1, At, B1); PG8_BAR; PG8_SCHED;
            PG8_LDA(At, 0, 1); PG8_STAGE(PG8_SB(0, 0), b2, voffB); PG8_STAGE(PG8_SB(0, 1), b2 + hstep, voffB); PG8_STAGE(PG8_SA(0, 0), a2, voffA);
            PG8_WAIT_V(8); PG8_WAIT_L(0); PG8_BAR; PG8_MMA(1, 0, At, B0); PG8_MMA(1, 1, At, B1); PG8_BAR; PG8_SCHED;
            PG8_LDB(B0, 1, 0); PG8_LDB(B1, 1, 1); PG8_SCHED; PG8_LDA(At, 1, 0); PG8_STAGE(PG8_SA(0, 1), a2 + hstep, voffA);
            PG8_WAIT_V(8); PG8_WAIT_L(0); PG8_BAR; PG8_MMA(0, 0, At, B0); PG8_MMA(0, 1, At, B1); PG8_BAR; PG8_SCHED;
            PG8_LDA(At, 1, 1); PG8_STAGE(PG8_SB(1, 0), b3, voffB); PG8_STAGE(PG8_SB(1, 1), b3 + hstep, voffB); PG8_STAGE(PG8_SA(1, 0), a3, voffA);
            PG8_WAIT_V(8); PG8_WAIT_L(0); PG8_BAR; PG8_MMA(1, 0, At, B0); PG8_MMA(1, 1, At, B1); PG8_BAR; PG8_SCHED;
            } else {
            PG8_LDB(B0, 0, 0); PG8_SCHED; PG8_LDA(At, 0, 0); PG8_STAGE(PG8_SA(1, 1), a1 + hstep, voffA);
            PG8_WAIT_L(8); PG8_BAR; PG8_WAIT_L(0); PG8_MMA(0, 0, At, B0); PG8_BAR; PG8_SCHED;
            PG8_LDB(B1, 0, 1); PG8_STAGE(PG8_SB(0, 0), b2, voffB);
            PG8_BAR; PG8_WAIT_L(0); PG8_MMA(0, 1, At, B1); PG8_BAR;
            PG8_LDA(At, 0, 1); PG8_STAGE(PG8_SA(0, 0), a2, voffA);
            PG8_BAR; PG8_WAIT_L(0); PG8_MMA(1, 0, At, B0); PG8_BAR; PG8_SCHED;
            PG8_STAGE(PG8_SB(0, 1), b2 + hstep, voffB);
            PG8_WAIT_V(6); PG8_BAR; PG8_MMA(1, 1, At, B1); PG8_BAR;
            PG8_LDB(B0, 1, 0); PG8_SCHED; PG8_LDA(At, 1, 0); PG8_STAGE(PG8_SA(0, 1), a2 + hstep, voffA);
            PG8_WAIT_L(8); PG8_BAR; PG8_WAIT_L(0); PG8_MMA(0, 0, At, B0); PG8_BAR; PG8_SCHED;
            PG8_LDB(B1, 1, 1); PG8_STAGE(PG8_SB(1, 0), b3, voffB);
            PG8_BAR; PG8_WAIT_L(0); PG8_MMA(0, 1, At, B1); PG8_BAR;
            PG8_LDA(At, 1, 1); PG8_STAGE(PG8_SA(1, 0), a3, voffA);
            PG8_BAR; PG8_WAIT_L(0); PG8_MMA(1, 0, At, B0); PG8_BAR; PG8_SCHED;
            PG8_STAGE(PG8_SB(1, 1), b3 + hstep, voffB);
            PG8_WAIT_V(6); PG8_BAR; PG8_MMA(1, 1, At, B1); PG8_BAR;
            }
        }
        if constexpr (ALIGN_EPI) { if (wr == 0) PG8_BAR; }
        E(acc, cur, wr, wc, fr, fq);
        if (!has_next) break;
#pragma unroll
        for (int a = 0; a < 2; ++a)
#pragma unroll
            for (int b = 0; b < 2; ++b)
#pragma unroll
                for (int m = 0; m < 4; ++m)
#pragma unroll
                    for (int n = 0; n < 2; ++n) acc[a][b][m][n] = (f32x4){0.f, 0.f, 0.f, 0.f};
        cur = nxt; cA = nA; cB = nB; ++ui;
        if constexpr (ALIGN_EPI) { if (wr == 1) PG8_BAR; }
    }
    PG8_WAIT_V(0);
    if constexpr (!ALIGN_EPI) { if (wr == 0) PG8_BAR; }
    PG8_BAR;
#undef PG8_SA
#undef PG8_SB
#undef PG8_STAGE
#undef PG8_LDA
#undef PG8_LDB
#undef PG8_MMA
#undef PG8_WAIT_V
#undef PG8_WAIT_L
#undef PG8_BAR
#undef PG8_SCHED
}
}

constexpr int D = 2048, NB = 2, SEQ = 16384, NT = NB * SEQ, CTXL = 256, NCTX = NB * CTXL, MTOT = NT + NCTX;
constexpr int NEXP = 16, CAP = 2048, FF = 1024, GRIDW = 64, NROWS = 256;
constexpr float EPS = 1e-6f;
constexpr float LOG2E = 1.4426950408889634f;
constexpr int NWAVES = 8;

constexpr size_t MiB = 1u << 20;
constexpr size_t WS_CTL = 0, CTL_ZERO_BYTES = 1 * MiB;
constexpr size_t CTL_TOKCNT0 = 262144, CTL_TOKCNT1 = 393216, CTL_BAR = 524288;
constexpr size_t WS_MOD = 1 * MiB;
constexpr size_t WS_AFF = 2 * MiB;
constexpr size_t WS_IDX = 4 * MiB;
constexpr size_t WS_TOKLIST = 5 * MiB;
constexpr size_t WS_WSB = 9 * MiB;
constexpr size_t WS_WIN0 = 10 * MiB, WS_WOUT0 = 30 * MiB, WS_WCIN = 38 * MiB, WS_WCOUT = 62 * MiB;
constexpr size_t WS_GU = 70 * MiB;
constexpr size_t WS_DN = 326 * MiB;
constexpr size_t WS_H = 454 * MiB;
constexpr size_t WS_R2 = 584 * MiB;
constexpr size_t WS_R3 = 968 * MiB;
constexpr size_t WS_END = 1224 * MiB;
constexpr size_t R2_T = (size_t)MTOT * 1024;

constexpr int LDS_SCR = 0;
constexpr int LDSCTL_OFF = 135168, MISC_OFF = LDSCTL_OFF + 320;
constexpr int LDS_BYTES = 147456;

#define GAS __attribute__((address_space(1)))
#define LAS __attribute__((address_space(3)))
#define DI __device__ __forceinline__
typedef unsigned short bf16;
typedef unsigned v4u __attribute__((ext_vector_type(4)));
typedef unsigned v2u __attribute__((ext_vector_type(2)));
typedef float f32x4 __attribute__((ext_vector_type(4)));
typedef float f32x16 __attribute__((ext_vector_type(16)));
typedef short bf16x8 __attribute__((ext_vector_type(8)));
typedef short s16x4 __attribute__((ext_vector_type(4)));
typedef GAS unsigned gu32;
#define RLX_AGENT __ATOMIC_RELAXED, __HIP_MEMORY_SCOPE_AGENT
#define LDS_WAIT() asm volatile("s_waitcnt lgkmcnt(0)" ::: "memory")
#define VM_WAIT() asm volatile("s_waitcnt vmcnt(0)" ::: "memory")
DI float bf_lo(unsigned u) { return __uint_as_float(u << 16); }
DI float bf_hi(unsigned u) { return __uint_as_float(u & 0xffff0000u); }
DI unsigned pk2(float lo, float hi) { return pg8::cvt_pk_bf16(lo, hi); }
DI float wave_sum(float v) {
#pragma unroll
    for (int o = 1; o < 64; o <<= 1) v += __shfl_xor(v, o);
    return v;
}
DI int wave_sum_i(int v) {
#pragma unroll
    for (int o = 1; o < 64; o <<= 1) v += __shfl_xor(v, o);
    return v;
}
DI float fast_rcp(float x) { return __builtin_amdgcn_rcpf(x); }
DI float fast_exp2(float x) { return __builtin_amdgcn_exp2f(x); }
DI float sigmoidf_(float z) { return fast_rcp(1.0f + fast_exp2(-z * LOG2E)); }
DI float gelu_tanh(float x) { const float z = 1.5957691216057308f * (x + 0.044715f * x * x * x); return x * sigmoidf_(z); }
DI float siluf_(float x) { return x * sigmoidf_(x); }

#define XB_TMO      128
#define XB_XCNT(j)  (256  + 64 * (j))
#define XB_XSUB(j)  (1280 + 64 * (j))
#define XB_XGEN(j)  (2304 + 64 * (j))
#define XB_TOP      3328
#define XB_TOPGEN   3392
#define XCD_BAR_WORDS 3456
#define XB_SPIN_CAP (1u << 18)

__device__ __forceinline__ unsigned xb_ld(unsigned* p)              { return __hip_atomic_load(p, __ATOMIC_RELAXED, __HIP_MEMORY_SCOPE_AGENT); }
__device__ __forceinline__ unsigned xb_add(unsigned* p, unsigned v) { return __hip_atomic_fetch_add(p, v, __ATOMIC_RELAXED, __HIP_MEMORY_SCOPE_AGENT); }
__device__ __forceinline__ unsigned xb_xcc_id() { return (unsigned)__builtin_amdgcn_s_getreg((3 << 11) | 20) & 0xFu; }
#define XB_SPIN(cond, bar) do { unsigned _sp = 0; while (cond) { __builtin_amdgcn_s_sleep(1); \
    if ((++_sp & 255u) == 0u) { if (xb_ld(&(bar)[XB_TMO])) break; if (_sp > XB_SPIN_CAP) { atomicAdd(&(bar)[XB_TMO], 1u); break; } } } } while (0)

struct XcdBarrier {
    unsigned* bar; unsigned x;
    volatile LAS unsigned* st;
};
__device__ __forceinline__ XcdBarrier xcd_barrier_post(unsigned* bar, volatile LAS unsigned* st) {
    XcdBarrier b; b.bar = bar; b.x = xb_xcc_id(); b.st = st;
    if (threadIdx.x == 0) (void)xb_add(&bar[XB_XCNT(b.x)], 1u);
    return b;
}
__device__ __forceinline__ void xcd_barrier_complete(unsigned* bar, unsigned x, unsigned& nloc, unsigned& nx) {
    const unsigned G = gridDim.x * gridDim.y * gridDim.z;
    unsigned sum, cnt, mine, sp = 0u;
    for (;;) {
        sum = 0u; cnt = 0u; mine = 0u;
#pragma unroll
        for (unsigned j = 0; j < 16; ++j) { const unsigned c = xb_ld(&bar[XB_XCNT(j)]); sum += c; cnt += (c > 0u) ? 1u : 0u; mine = (j == x) ? c : mine; }
        if (sum == G) break;
        __builtin_amdgcn_s_sleep(1);
        if ((++sp & 255u) == 0u) { if (xb_ld(&bar[XB_TMO])) break; if (sp > XB_SPIN_CAP) { atomicAdd(&bar[XB_TMO], 1u); break; } }
    }
    nloc = mine > 0u ? mine : 1u; nx = cnt > 0u ? cnt : 1u;
}
__device__ __forceinline__ void xcd_barrier(const XcdBarrier& b) {
    asm volatile("s_waitcnt vmcnt(0)" ::: "memory");
    __syncthreads();
    if (threadIdx.x == 0) {
        unsigned* bar = b.bar;
        __builtin_amdgcn_s_waitcnt(0);
        unsigned nloc = b.st[0], nx = b.st[1];
        if (nloc == 0u) { xcd_barrier_complete(bar, b.x, nloc, nx); b.st[0] = nloc; b.st[1] = nx; }
        const unsigned old = xb_add(&bar[XB_XSUB(b.x)], 1u);
        const unsigned gen = old / nloc;
        if (old + 1u == (gen + 1u) * nloc) {
            __builtin_amdgcn_fence(__ATOMIC_RELEASE, "agent");
            asm volatile("s_waitcnt vmcnt(0)" ::: "memory");
            const unsigned og = xb_add(&bar[XB_TOP], 1u);
            const unsigned tg = og / nx;
            if (og + 1u == (tg + 1u) * nx) xb_add(&bar[XB_TOPGEN], 1u);
            else XB_SPIN(xb_ld(&bar[XB_TOPGEN]) == tg, bar);
            __builtin_amdgcn_fence(__ATOMIC_ACQUIRE, "agent");
            xb_add(&bar[XB_XGEN(b.x)], 1u);
            asm volatile("s_waitcnt vmcnt(0)" ::: "memory");
        } else {
            XB_SPIN(xb_ld(&bar[XB_XGEN(b.x)]) == gen, bar);
            __builtin_amdgcn_fence(__ATOMIC_ACQUIRE, "agent");
            asm volatile("s_waitcnt vmcnt(0)" ::: "memory");
        }
    }
    __syncthreads();
}

using pg8::Unit; using pg8::BM; using pg8::HALF;
struct EpiIn0 {
    static constexpr bool PERM = true;
    bf16* O;
    DI void operator()(const f32x4 (&acc)[2][2][4][2], const Unit& u, int wr, int wc, int fr, int fq) const {
        const int row0 = u.pm * BM + wr * 64 + fr; const int t = u.pn >> 2; const int colt = (u.pn & 3) * BM;
        bf16* base = O + (size_t)t * R2_T; const int col0 = colt + wc * 32 + 8 * fq; const bool act = t < 2;
#pragma unroll
        for (int ai = 0; ai < 2; ++ai)
#pragma unroll
            for (int m = 0; m < 4; ++m) { bf16* rowp = base + (size_t)(row0 + ai * HALF + m * 16) * 1024 + col0;
#pragma unroll
                for (int bj = 0; bj < 2; ++bj) { f32x4 v0 = acc[ai][bj][m][0], v1 = acc[ai][bj][m][1];
                    if (act) {
#pragma unroll
                        for (int j = 0; j < 4; ++j) { v0[j] = gelu_tanh(v0[j]); v1[j] = gelu_tanh(v1[j]); } }
                    v4u w; w.x = pk2(v0[0], v0[1]); w.y = pk2(v0[2], v0[3]); w.z = pk2(v1[0], v1[1]); w.w = pk2(v1[2], v1[3]);
                    *(v4u*)(rowp + bj * HALF) = w; } }
    }
};
struct EpiResid {
    static constexpr bool PERM = false;
    const float* base; float* out; const float* gate0;
    DI void operator()(const f32x4 (&acc)[2][2][4][2], const Unit& u, int wr, int wc, int fr, int fq) const {
        const int row0 = u.pm * BM + wr * 64 + fr, col0 = u.pn * BM + wc * 32 + 4 * fq;
        const float* gate = gate0 + (size_t)((u.pm * BM) >> 14) * 12288;
        f32x4 gv[2][2];
#pragma unroll
        for (int bj = 0; bj < 2; ++bj)
#pragma unroll
            for (int n = 0; n < 2; ++n) gv[bj][n] = *(const f32x4*)(gate + col0 + bj * HALF + n * 16);
#pragma unroll
        for (int ai = 0; ai < 2; ++ai)
#pragma unroll
            for (int m = 0; m < 4; ++m) { const size_t off = (size_t)(row0 + ai * HALF + m * 16) * D + col0;
#pragma unroll
                for (int bj = 0; bj < 2; ++bj)
#pragma unroll
                    for (int n = 0; n < 2; ++n) { const f32x4 bs = *(const f32x4*)(base + off + bj * HALF + n * 16);
                        *(f32x4*)(out + off + bj * HALF + n * 16) = bs + gv[bj][n] * acc[ai][bj][m][n]; } }
    }
};
struct EpiSwiglu {
    static constexpr bool PERM = true;
    bf16* O;
    DI void operator()(const f32x4 (&acc)[2][2][4][2], const Unit& u, int wr, int wc, int fr, int fq) const {
        const int row0 = u.pm * BM + wr * 64 + fr, col0 = u.pn * HALF + wc * 32 + 8 * fq;
#pragma unroll
        for (int ai = 0; ai < 2; ++ai)
#pragma unroll
            for (int m = 0; m < 4; ++m) { bf16* rowp = O + (size_t)(row0 + ai * HALF + m * 16) * FF + col0;
                f32x4 g0 = acc[ai][0][m][0], g1 = acc[ai][0][m][1]; const f32x4 u0 = acc[ai][1][m][0], u1 = acc[ai][1][m][1];
#pragma unroll
                for (int j = 0; j < 4; ++j) { g0[j] = siluf_(g0[j]) * u0[j]; g1[j] = siluf_(g1[j]) * u1[j]; }
                v4u w; w.x = pk2(g0[0], g0[1]); w.y = pk2(g0[2], g0[3]); w.z = pk2(g1[0], g1[1]); w.w = pk2(g1[2], g1[3]);
                *(v4u*)rowp = w; }
    }
};
struct EpiPlain {
    static constexpr bool PERM = true;
    bf16* O; int ldc;
    DI void operator()(const f32x4 (&acc)[2][2][4][2], const Unit& u, int wr, int wc, int fr, int fq) const {
        const int row0 = u.pm * BM + wr * 64 + fr, col0 = u.pn * BM + wc * 32 + 8 * fq;
#pragma unroll
        for (int ai = 0; ai < 2; ++ai)
#pragma unroll
            for (int m = 0; m < 4; ++m) { bf16* rowp = O + (size_t)(row0 + ai * HALF + m * 16) * ldc + col0;
#pragma unroll
                for (int bj = 0; bj < 2; ++bj) { const f32x4 v0 = acc[ai][bj][m][0], v1 = acc[ai][bj][m][1];
                    v4u w; w.x = pk2(v0[0], v0[1]); w.y = pk2(v0[2], v0[3]); w.z = pk2(v1[0], v1[1]); w.w = pk2(v1[2], v1[3]);
                    *(v4u*)(rowp + bj * HALF) = w; } }
    }
};
struct EpiCin {
    static constexpr bool PERM = true;
    bf16* BG; bf16* CZ;
    DI void operator()(const f32x4 (&acc)[2][2][4][2], const Unit& u, int wr, int wc, int fr, int fq) const {
        const int row0 = u.pm * BM + wr * 64 + fr;
        if (u.pn < 8) {
            const int col0 = u.pn * BM + wc * 32 + 8 * fq;
#pragma unroll
            for (int ai = 0; ai < 2; ++ai)
#pragma unroll
                for (int m = 0; m < 4; ++m) { bf16* rowp = BG + (size_t)(row0 + ai * HALF + m * 16) * D + col0;
#pragma unroll
                    for (int bj = 0; bj < 2; ++bj) { const f32x4 v0 = acc[ai][bj][m][0], v1 = acc[ai][bj][m][1];
                        v4u w; w.x = pk2(v0[0], v0[1]); w.y = pk2(v0[2], v0[3]); w.z = pk2(v1[0], v1[1]); w.w = pk2(v1[2], v1[3]);
                        *(v4u*)(rowp + bj * HALF) = w; } }
        } else {
            const int col0 = (u.pn - 8) * HALF + wc * 32 + 8 * fq;
#pragma unroll
            for (int ai = 0; ai < 2; ++ai)
#pragma unroll
                for (int m = 0; m < 4; ++m) { bf16* rowp = CZ + (size_t)(row0 + ai * HALF + m * 16) * D + col0;
                    const f32x4 p0 = acc[ai][0][m][0] * acc[ai][1][m][0], p1 = acc[ai][0][m][1] * acc[ai][1][m][1];
                    v4u w; w.x = pk2(p0[0], p0[1]); w.y = pk2(p0[2], p0[3]); w.z = pk2(p1[0], p1[1]); w.w = pk2(p1[2], p1[3]);
                    *(v4u*)rowp = w; }
        }
    }
};

DI unsigned off_b(unsigned row, unsigned ch) { return 256u * row + 16u * (ch ^ (((row & 3) << 2) | ((row >> 2) & 3))); }
DI bf16x8 row_frag(const LAS unsigned char* img, int lane, int s) { return *(const LAS bf16x8*)(img + off_b(lane & 31, 2 * s + (lane >> 5))); }
template <bool KROW>
DI bf16x8 tr_frag(const LAS unsigned char* img, int lane, int c, int ks) {
    const unsigned h = lane >> 5, blk = (lane >> 4) & 1, q = (lane & 15) >> 2, p = lane & 3;
    const unsigned r0 = KROW ? (16 * ks + 4 * h + q) : (16 * ks + 8 * h + q), r1 = KROW ? (r0 + 8) : (r0 + 4);
    const unsigned ch = 4 * c + 2 * blk + (p >> 1), sub = 8 * (p & 1);
    const s16x4 lo = __builtin_amdgcn_ds_read_tr16_b64_v4i16((LAS s16x4*)(img + off_b(r0, ch) + sub));
    const s16x4 hi = __builtin_amdgcn_ds_read_tr16_b64_v4i16((LAS s16x4*)(img + off_b(r1, ch) + sub));
    return __builtin_shufflevector(lo, hi, 0, 1, 2, 3, 4, 5, 6, 7);
}
DI int crow(int reg, int h) { return (reg & 3) + 8 * (reg >> 2) + 4 * h; }
#define MFMA32(a, b, c) __builtin_amdgcn_mfma_f32_32x32x16_bf16((a), (b), (c), 0, 0, 0)

struct Params { const float* in[23]; float* out; unsigned char* ws; int ph_lo, ph_hi, li, pad; };
enum { I_X = 0, I_C, I_CTX, I_CCTX, I_ADAW, I_ADAB, I_N1G, I_N2G, I_ABWIN, I_ABWOUT, I_AWS, I_ABS, I_AVG, I_BQG, I_BKG, I_RPB, I_CWIN, I_CONVW, I_CWOUT, I_ROUTER, I_WGATE, I_WUP, I_WDOWN };

DI void xpose_item(const float* __restrict__ W, int N, bf16* __restrict__ WT, int Kd, int k0, int n0, int dstrow0, LAS float* scr, int lane) {
    const GAS f32x4* src = (const GAS f32x4*)(W + (size_t)k0 * N + n0);
    const int lr = lane >> 4, lc = lane & 15;
    f32x4 v[16];
#pragma unroll
    for (int i = 0; i < 16; ++i) v[i] = src[(size_t)(lr + 4 * i) * (N / 4) + lc];
#pragma unroll
    for (int i = 0; i < 16; ++i) { LAS float* d = scr + (lr + 4 * i) * 65 + 4 * lc; d[0] = v[i].x; d[1] = v[i].y; d[2] = v[i].z; d[3] = v[i].w; }
    LDS_WAIT(); asm volatile("" ::: "memory");
    const int c = lane & 7;
#pragma unroll
    for (int i = 0; i < 8; ++i) { const int n = 8 * i + (lane >> 3); const LAS float* s = scr + (8 * c) * 65 + n;
        v4u o; o.x = pk2(s[0 * 65], s[1 * 65]); o.y = pk2(s[2 * 65], s[3 * 65]); o.z = pk2(s[4 * 65], s[5 * 65]); o.w = pk2(s[6 * 65], s[7 * 65]);
        *(GAS v4u*)(WT + (size_t)(dstrow0 + n) * Kd + k0 + 8 * c) = o; }
    LDS_WAIT(); asm volatile("" ::: "memory");
}
DI int ilv_row(int j, int hv) { return ((j >> 7) << 8) + hv * 128 + (j & 127); }

DI void phase_prologue(const Params& P, LAS unsigned char* lds, int tid, int lane, int wave) {
    unsigned char* ws = P.ws;
    for (int u = blockIdx.x; u < 192; u += gridDim.x) {
        const int l = u / 96, cb = u % 96;
        LAS float* sv = (LAS float*)(lds + LDS_SCR);
        LAS float* part = (LAS float*)(lds + LDS_SCR + 24576);
        for (int i = tid; i < 3 * 2048; i += 512) { const int r = i >> 11, k = i & 2047; const float c = r < 2 ? P.in[I_C][r * 2048 + k] : P.in[I_CCTX][k]; sv[i] = c / (1.0f + __expf(-c)); }
        __syncthreads();
        const int col4 = tid & 31, ks = tid >> 5;
        const GAS f32x4* w = (const GAS f32x4*)(P.in[I_ADAW] + (size_t)l * 2048 * 12288 + (size_t)(ks * 128) * 12288 + cb * 128) + col4;
        f32x4 a0 = {0.f, 0.f, 0.f, 0.f}, a1 = a0, a2 = a0;
#pragma unroll 8
        for (int k = 0; k < 128; ++k) { const f32x4 wv = w[(size_t)k * (12288 / 4)]; const int kk = ks * 128 + k;
            a0 += wv * sv[kk]; a1 += wv * sv[2048 + kk]; a2 += wv * sv[4096 + kk]; }
        *(LAS f32x4*)(part + (ks * 3 + 0) * 128 + 4 * col4) = a0; *(LAS f32x4*)(part + (ks * 3 + 1) * 128 + 4 * col4) = a1; *(LAS f32x4*)(part + (ks * 3 + 2) * 128 + 4 * col4) = a2;
        __syncthreads();
        if (tid < 384) { const int r = tid >> 7, cc = tid & 127; float s = P.in[I_ADAB][l * 12288 + cb * 128 + cc];
#pragma unroll
            for (int q = 0; q < 16; ++q) s += part[(q * 3 + r) * 128 + cc];
            ((float*)(ws + WS_MOD))[(size_t)(l * 3 + r) * 12288 + cb * 128 + cc] = s; }
        __syncthreads();
    }
    { const float* src = P.in[I_AWS]; bf16* dst = (bf16*)(ws + WS_WSB);
      for (int i = blockIdx.x * 512 + tid; i < 8 * 128 * 128 / 2; i += gridDim.x * 512) { const float a = src[2 * i], b = src[2 * i + 1]; ((unsigned*)dst)[i] = pk2(a, b); } }
    LAS float* scr = (LAS float*)(lds + LDS_SCR + wave * 16640);
    const int gw = blockIdx.x * NWAVES + wave, NGW = gridDim.x * NWAVES;
    constexpr int I0 = 32 * 80, I1 = 32 * 32, I2 = 32 * 96, I3 = 32 * 32, IM = 512, I4 = 32 * IM, NITEMS = I0 + I1 + I2 + I3 + 3 * I4;
    for (int it = gw; it < NITEMS; it += NGW) {
        int r = it;
        if (r < I0) { const int kb = r / 80, nb = r % 80; xpose_item(P.in[I_ABWIN], 5120, (bf16*)(ws + WS_WIN0), 2048, kb * 64, nb * 64, nb * 64, scr, lane); continue; } r -= I0;
        if (r < I1) { const int kb = r / 32, nb = r % 32; xpose_item(P.in[I_ABWOUT], 2048, (bf16*)(ws + WS_WOUT0), 2048, kb * 64, nb * 64, nb * 64, scr, lane); continue; } r -= I1;
        if (r < I2) { const int kb = r / 96, nb = r % 96; const int n0 = nb * 64;
            const int drow = n0 < 2048 ? n0 : (n0 < 4096 ? 2048 + ilv_row(n0 - 2048, 0) : 2048 + ilv_row(n0 - 4096, 1));
            xpose_item(P.in[I_CWIN], 6144, (bf16*)(ws + WS_WCIN), 2048, kb * 64, n0, drow, scr, lane); continue; } r -= I2;
        if (r < I3) { const int kb = r / 32, nb = r % 32; xpose_item(P.in[I_CWOUT], 2048, (bf16*)(ws + WS_WCOUT), 2048, kb * 64, nb * 64, nb * 64, scr, lane); continue; } r -= I3;
        if (r < I4) { const int mt = r / IM, q = r % IM, kb = q / 16, nb = q % 16;
            xpose_item(P.in[I_WGATE] + (size_t)mt * 2048 * 1024, 1024, (bf16*)(ws + WS_GU) + (size_t)mt * 2048 * 2048, 2048, kb * 64, nb * 64, ilv_row(nb * 64, 0), scr, lane); continue; } r -= I4;
        if (r < I4) { const int mt = r / IM, q = r % IM, kb = q / 16, nb = q % 16;
            xpose_item(P.in[I_WUP] + (size_t)mt * 2048 * 1024, 1024, (bf16*)(ws + WS_GU) + (size_t)mt * 2048 * 2048, 2048, kb * 64, nb * 64, ilv_row(nb * 64, 1), scr, lane); continue; } r -= I4;
        { const int mt = r / IM, q = r % IM, kb = q / 32, nb = q % 32;
            xpose_item(P.in[I_WDOWN] + (size_t)mt * 1024 * 2048, 2048, (bf16*)(ws + WS_DN) + (size_t)mt * 2048 * 1024, 1024, kb * 64, nb * 64, nb * 64, scr, lane); }
    }
}

DI void norm_mod_row(f32x4 (&v)[8], const float* __restrict__ g, const float* __restrict__ shift, const float* __restrict__ scale, int lane) {
    float ss = 0.f;
#pragma unroll
    for (int j = 0; j < 8; ++j) ss += (v[j].x * v[j].x + v[j].y * v[j].y) + (v[j].z * v[j].z + v[j].w * v[j].w);
    const float rstd = 1.0f / sqrtf(wave_sum(ss) * (1.0f / D) + EPS);
#pragma unroll
    for (int j = 0; j < 8; ++j) { const int c = 256 * j + 4 * lane; const f32x4 gg = *(const f32x4*)(g + c), sc = *(const f32x4*)(scale + c), sh = *(const f32x4*)(shift + c);
        v[j] = (v[j] * rstd * gg) * (1.0f + sc) + sh; }
}
DI void store_row_bf16(bf16* __restrict__ orow, const f32x4 (&v)[8], int lane) {
    GAS v2u* o = (GAS v2u*)orow + lane;
#pragma unroll
    for (int j = 0; j < 8; ++j) { v2u w; w.x = pk2(v[j].x, v[j].y); w.y = pk2(v[j].z, v[j].w); o[64 * j] = w; }
}
DI void load_row_f32(f32x4 (&v)[8], const float* __restrict__ xrow, int lane) {
    const GAS f32x4* xr = (const GAS f32x4*)xrow + lane;
#pragma unroll
    for (int j = 0; j < 8; ++j) v[j] = xr[64 * j];
}

DI void phase_norm1_l0(const Params& P, int lane, int wave) {
    const float* mod = (const float*)(P.ws + WS_MOD); bf16* H = (bf16*)(P.ws + WS_H);
    const int gw = blockIdx.x * NWAVES + wave, NGW = gridDim.x * NWAVES;
    for (int row = gw; row < MTOT; row += NGW) {
        const float* src = row < NT ? P.in[I_X] + (size_t)row * D : P.in[I_CTX] + (size_t)(row - NT) * D;
        const int r = row < NT ? (row >> 14) : 2;
        const float* m = mod + (size_t)r * 12288;
        f32x4 v[8]; load_row_f32(v, src, lane);
#if MK_STOP < 5
        if (row < NT) { GAS f32x4* o = (GAS f32x4*)(P.out + (size_t)row * D) + lane;
#pragma unroll
            for (int j = 0; j < 8; ++j) o[64 * j] = v[j]; }
#endif
        norm_mod_row(v, P.in[I_N1G], m + 0 * 2048, m + 1 * 2048, lane);
        store_row_bf16(H + (size_t)row * D, v, lane);
    }
}

DI void phase_norm2_router(const Params& P, int layer, LAS unsigned char* lds, int tid, int lane, int wave) {
    const float* mod = (const float*)(P.ws + WS_MOD) + (size_t)layer * 3 * 12288; bf16* H = (bf16*)(P.ws + WS_H);
    float* AFF = (float*)(P.ws + WS_AFF);
    LAS float* wrt = (LAS float*)(lds + LDS_SCR);
    { const GAS f32x4* wr = (const GAS f32x4*)(P.in[I_ROUTER] + (size_t)layer * 2048 * 16);
      for (int i = tid; i < 2048 * 4; i += 512) { const f32x4 w = wr[i]; const int k = i >> 2, e0 = (i & 3) * 4;
          wrt[(e0 + 0) * 2048 + k] = w.x; wrt[(e0 + 1) * 2048 + k] = w.y; wrt[(e0 + 2) * 2048 + k] = w.z; wrt[(e0 + 3) * 2048 + k] = w.w; } }
    __syncthreads();
    const int gw = blockIdx.x * NWAVES + wave, NGW = gridDim.x * NWAVES;
    const float* n2g = P.in[I_N2G] + (size_t)layer * D;
    for (int row = gw; row < NT; row += NGW) {
        const int b = row >> 14, n = row & 16383;
        const float* m = mod + (size_t)b * 12288;
        f32x4 v[8]; load_row_f32(v, P.out + (size_t)row * D, lane);
        norm_mod_row(v, n2g, m + 3 * 2048, m + 4 * 2048, lane);
        store_row_bf16(H + (size_t)row * D, v, lane);
        float lg[16];
#pragma unroll
        for (int e = 0; e < 16; ++e) lg[e] = 0.f;
#pragma unroll
        for (int j = 0; j < 8; ++j) {
#pragma unroll
            for (int e = 0; e < 16; ++e) { const f32x4 w = *(const LAS f32x4*)(wrt + e * 2048 + 256 * j + 4 * lane);
                lg[e] += (v[j].x * w.x + v[j].y * w.y) + (v[j].z * w.z + v[j].w * w.w); } }
#pragma unroll
        for (int e = 0; e < 16; ++e) lg[e] = wave_sum(lg[e]);
        float mx = lg[0];
#pragma unroll
        for (int e = 1; e < 16; ++e) mx = fmaxf(mx, lg[e]);
        float sum = 0.f;
#pragma unroll
        for (int e = 0; e < 16; ++e) { lg[e] = __expf(lg[e] - mx); sum += lg[e]; }
        const float inv = 1.0f / sum;
        float mine = 0.f;
#pragma unroll
        for (int e = 0; e < 16; ++e) mine = (lane == e) ? lg[e] * inv : mine;
        if (lane < 16) AFF[((size_t)(b * 16 + lane)) * SEQ + n] = mine;
    }
    __syncthreads();
}

DI void phase_topk(const Params& P, int layer, LAS unsigned char* lds, int tid, int lane, int wave) {
    LAS unsigned* vals = (LAS unsigned*)(lds + LDS_SCR);
    LAS int* red = (LAS int*)(lds + LDS_SCR + 65536);
    LAS int* slotctr = (LAS int*)(lds + LDS_SCR + 65536 + 64);
    const unsigned* AFF = (const unsigned*)(P.ws + WS_AFF);
    int* IDX = (int*)(P.ws + WS_IDX);
    unsigned* tokcnt = (unsigned*)(P.ws + (layer ? CTL_TOKCNT1 : CTL_TOKCNT0));
    unsigned long long* toklist = (unsigned long long*)(P.ws + WS_TOKLIST);
    for (int j = blockIdx.x; j < 32; j += gridDim.x) {
        const int b = j >> 4, e = j & 15;
        const unsigned* src = AFF + (size_t)j * SEQ;
#pragma unroll 8
        for (int i = 0; i < 32; ++i) vals[tid + 512 * i] = src[tid + 512 * i];
        if (tid == 0) slotctr[0] = 0;
        __syncthreads();
        int par = 0;
#define TK_COUNT(pred, total) do { int _c = 0; _Pragma("unroll 8") for (int i = 0; i < 32; ++i) { const int idx = tid + 512 * i; const unsigned v = vals[idx]; (void)idx; _c += (pred) ? 1 : 0; } \
        _c = wave_sum_i(_c); if (lane == 0) red[par * 8 + wave] = _c; __syncthreads(); total = 0; _Pragma("unroll") for (int w = 0; w < 8; ++w) total += red[par * 8 + w]; par ^= 1; } while (0)
        unsigned T = 0u;
        for (int bit = 30; bit >= 0; --bit) { const unsigned cand = T | (1u << bit); int total; TK_COUNT(v >= cand, total); if (total >= CAP) T = cand; }
        int ngt; TK_COUNT(v > T, ngt);
        const int need = CAP - ngt;
        int lo = 0, hi = SEQ - 1;
        while (lo < hi) { const int mid = (lo + hi) >> 1; int c; TK_COUNT(v == T && idx <= mid, c); if (c >= need) hi = mid; else lo = mid + 1; }
        const int J = lo;
#undef TK_COUNT
        for (int i = 0; i < 32; ++i) { const int idx = tid + 512 * i; const unsigned v = vals[idx];
            if (v > T || (v == T && idx <= J)) {
                const int slot = __hip_atomic_fetch_add(slotctr, 1, __ATOMIC_RELAXED, __HIP_MEMORY_SCOPE_WORKGROUP);
                IDX[j * CAP + slot] = idx;
                const int tok = b * SEQ + idx; const unsigned rowid = (unsigned)(e * 4096 + b * 2048 + slot);
                const unsigned p = __hip_atomic_fetch_add(tokcnt + tok, 1u, RLX_AGENT);
                toklist[(size_t)tok * 16 + (p & 15u)] = ((unsigned long long)v << 32) | rowid; } }
        __syncthreads();
    }
}

DI void phase_gather(const Params& P, int lane, int wave) {
    const int* IDX = (const int*)(P.ws + WS_IDX); const bf16* H = (const bf16*)(P.ws + WS_H); bf16* XS = (bf16*)(P.ws + WS_R2);
    const int gw = blockIdx.x * NWAVES + wave, NGW = gridDim.x * NWAVES;
    for (int rowid = gw; rowid < 65536; rowid += NGW) {
        const int e = rowid >> 12, b = (rowid >> 11) & 1, slot = rowid & 2047;
        const int n = IDX[(b * 16 + e) * CAP + slot];
        const GAS v4u* s = (const GAS v4u*)(H + (size_t)(b * SEQ + n) * D) + lane; GAS v4u* d = (GAS v4u*)(XS + (size_t)rowid * D) + lane;
        v4u t[4];
#pragma unroll
        for (int j = 0; j < 4; ++j) t[j] = s[64 * j];
#pragma unroll
        for (int j = 0; j < 4; ++j) d[64 * j] = t[j];
    }
}

template <bool NEXT_NORM>
DI void phase_combine(const Params& P, int layer, int lane, int wave) {
    const float* mod = (const float*)(P.ws + WS_MOD) + (size_t)layer * 3 * 12288;
    const float* modn = (const float*)(P.ws + WS_MOD) + (size_t)(layer + 1) * 3 * 12288;
    const unsigned* tokcnt = (const unsigned*)(P.ws + (layer ? CTL_TOKCNT1 : CTL_TOKCNT0));
    const unsigned long long* toklist = (const unsigned long long*)(P.ws + WS_TOKLIST);
    const bf16* YB = (const bf16*)(P.ws + WS_R3); bf16* H = (bf16*)(P.ws + WS_H);
    const int gw = blockIdx.x * NWAVES + wave, NGW = gridDim.x * NWAVES;
    for (int tok = gw; tok < NT; tok += NGW) {
        const int b = tok >> 14;
        f32x4 v[8]; load_row_f32(v, P.out + (size_t)tok * D, lane);
        int cnt = (int)tokcnt[tok]; cnt = __builtin_amdgcn_readfirstlane(cnt); cnt = cnt > 16 ? 16 : cnt;
        f32x4 a[8];
#pragma unroll
        for (int j = 0; j < 8; ++j) a[j] = (f32x4){0.f, 0.f, 0.f, 0.f};
        for (int p = 0; p < cnt; ++p) {
            const unsigned long long ent = toklist[(size_t)tok * 16 + p];
            const unsigned rowid = (unsigned)__builtin_amdgcn_readfirstlane((int)(unsigned)ent); const float gate = __uint_as_float((unsigned)__builtin_amdgcn_readfirstlane((int)(unsigned)(ent >> 32)));
            const GAS v2u* y = (const GAS v2u*)(YB + (size_t)rowid * D) + lane;
#pragma unroll
            for (int j = 0; j < 8; ++j) { const v2u w = y[64 * j]; a[j].x += gate * bf_lo(w.x); a[j].y += gate * bf_hi(w.x); a[j].z += gate * bf_lo(w.y); a[j].w += gate * bf_hi(w.y); }
        }
        const float* g2 = mod + (size_t)b * 12288 + 5 * 2048;
        GAS f32x4* o = (GAS f32x4*)(P.out + (size_t)tok * D) + lane;
#pragma unroll
        for (int j = 0; j < 8; ++j) { const f32x4 gg = *(const f32x4*)(g2 + 256 * j + 4 * lane); v[j] += gg * a[j]; o[64 * j] = v[j]; }
        if constexpr (NEXT_NORM) {
            const float* m = modn + (size_t)b * 12288;
            norm_mod_row(v, P.in[I_N1G] + (size_t)(layer + 1) * D, m + 0 * 2048, m + 1 * 2048, lane);
            store_row_bf16(H + (size_t)tok * D, v, lane);
        }
    }
}

DI void phase_knorm(const Params& P, int lane, int wave) {
    bf16* KK = (bf16*)(P.ws + WS_R2) + 3 * R2_T; const float* gk = P.in[I_BKG];
    const int gw = blockIdx.x * NWAVES + wave, NGW = gridDim.x * NWAVES;
    const int d0 = (lane & 7) * 16;
    float gkr[16];
#pragma unroll
    for (int i = 0; i < 16; ++i) gkr[i] = gk[d0 + i];
    for (int row = gw; row < MTOT; row += NGW) {
        GAS v4u* p = (GAS v4u*)(KK + (size_t)row * 1024) + 2 * lane;
        const v4u w0 = p[0], w1 = p[1];
        float f[16];
        f[0] = bf_lo(w0.x); f[1] = bf_hi(w0.x); f[2] = bf_lo(w0.y); f[3] = bf_hi(w0.y); f[4] = bf_lo(w0.z); f[5] = bf_hi(w0.z); f[6] = bf_lo(w0.w); f[7] = bf_hi(w0.w);
        f[8] = bf_lo(w1.x); f[9] = bf_hi(w1.x); f[10] = bf_lo(w1.y); f[11] = bf_hi(w1.y); f[12] = bf_lo(w1.z); f[13] = bf_hi(w1.z); f[14] = bf_lo(w1.w); f[15] = bf_hi(w1.w);
        float ss = 0.f;
#pragma unroll
        for (int i = 0; i < 16; ++i) ss += f[i] * f[i];
        ss += __shfl_xor(ss, 1); ss += __shfl_xor(ss, 2); ss += __shfl_xor(ss, 4);
        const float rstd = 1.0f / sqrtf(ss * (1.0f / 128.0f) + EPS);
#pragma unroll
        for (int i = 0; i < 16; ++i) f[i] = f[i] * rstd * gkr[i];
        v4u o0, o1; o0.x = pk2(f[0], f[1]); o0.y = pk2(f[2], f[3]); o0.z = pk2(f[4], f[5]); o0.w = pk2(f[6], f[7]); o1.x = pk2(f[8], f[9]); o1.y = pk2(f[10], f[11]); o1.z = pk2(f[12], f[13]); o1.w = pk2(f[14], f[15]);
        p[0] = o0; p[1] = o1;
    }
}

DI void phase_gmlp(const Params& P, LAS unsigned char* lds, int tid, int lane, int wave) {
    const bf16* U = (const bf16*)(P.ws + WS_R2); const bf16* V = U + R2_T; const bf16* WSB = (const bf16*)(P.ws + WS_WSB);
    bf16* CAT = (bf16*)(P.ws + WS_R3);
    LAS unsigned char* wimg = lds + LDS_SCR;
    LAS unsigned char* vimg = lds + LDS_SCR + 32768;
    const int ql = lane & 31, hf = lane >> 5;
    for (int u = blockIdx.x; u < 2048; u += gridDim.x) {
        const int g = u & 7, cn = (u >> 3) & 127, b = u >> 10;
        const int tok0 = b * SEQ + cn * 128;
        const float* gv = P.in[I_AVG] + g * 128;
#pragma unroll
        for (int i = 0; i < 4; ++i) { const int cidx = tid + 512 * i, q = cidx >> 4, ch = cidx & 15;
            const v4u raw = *(const GAS v4u*)(V + (size_t)(tok0 + q) * 1024 + g * 128 + ch * 8);
            float f[8]; f[0] = bf_lo(raw.x); f[1] = bf_hi(raw.x); f[2] = bf_lo(raw.y); f[3] = bf_hi(raw.y); f[4] = bf_lo(raw.z); f[5] = bf_hi(raw.z); f[6] = bf_lo(raw.w); f[7] = bf_hi(raw.w);
            float ss = 0.f;
#pragma unroll
            for (int k = 0; k < 8; ++k) ss += f[k] * f[k];
            ss += __shfl_xor(ss, 1); ss += __shfl_xor(ss, 2); ss += __shfl_xor(ss, 4); ss += __shfl_xor(ss, 8);
            const float rstd = 1.0f / sqrtf(ss * (1.0f / 128.0f) + EPS);
            const f32x4 g0 = *(const f32x4*)(gv + ch * 8), g1 = *(const f32x4*)(gv + ch * 8 + 4);
            v4u o; o.x = pk2(f[0] * rstd * g0.x, f[1] * rstd * g0.y); o.y = pk2(f[2] * rstd * g0.z, f[3] * rstd * g0.w); o.z = pk2(f[4] * rstd * g1.x, f[5] * rstd * g1.y); o.w = pk2(f[6] * rstd * g1.z, f[7] * rstd * g1.w);
            *(LAS v4u*)(vimg + (q >> 5) * 8192 + off_b(q & 31, ch)) = o;
            const v4u wraw = *(const GAS v4u*)(WSB + (size_t)(g * 128 + q) * 128 + ch * 8);
            *(LAS v4u*)(wimg + (q >> 5) * 8192 + off_b(q & 31, ch)) = wraw; }
        __syncthreads();
        const int cb = wave & 3, pb0 = 2 * (wave >> 2);
        f32x16 acc0, acc1;
#pragma unroll
        for (int i = 0; i < 16; ++i) { acc0[i] = 0.f; acc1[i] = 0.f; }
#pragma unroll
        for (int ks = 0; ks < 8; ++ks) {
            const bf16x8 a = tr_frag<false>(vimg + (ks >> 1) * 8192, lane, cb, ks & 1);
            const bf16x8 b0 = row_frag(wimg + (pb0 + 0) * 8192, lane, ks), b1 = row_frag(wimg + (pb0 + 1) * 8192, lane, ks);
            acc0 = MFMA32(a, b0, acc0); acc1 = MFMA32(a, b1, acc1);
        }
#pragma unroll
        for (int x = 0; x < 2; ++x) { const int p = 32 * (pb0 + x) + ql; const int tok = tok0 + p; const float bs = P.in[I_ABS][g * 128 + p];
#pragma unroll
            for (int rq = 0; rq < 4; ++rq) { const int c = 32 * cb + 8 * rq + 4 * hf;
                const v2u uu = *(const GAS v2u*)(U + (size_t)tok * 1024 + g * 128 + c);
                const float s0 = (x ? acc1[4 * rq + 0] : acc0[4 * rq + 0]) + bs, s1 = (x ? acc1[4 * rq + 1] : acc0[4 * rq + 1]) + bs, s2 = (x ? acc1[4 * rq + 2] : acc0[4 * rq + 2]) + bs, s3 = (x ? acc1[4 * rq + 3] : acc0[4 * rq + 3]) + bs;
                v2u o; o.x = pk2(bf_lo(uu.x) * s0, bf_hi(uu.x) * s1); o.y = pk2(bf_lo(uu.y) * s2, bf_hi(uu.y) * s3);
                *(GAS v2u*)(CAT + (size_t)tok * D + g * 128 + c) = o; } }
        __syncthreads();
    }
}

DI void phase_attn(const Params& P, LAS unsigned char* lds, int tid, int lane, int wave) {
    const bf16* Qb = (const bf16*)(P.ws + WS_R2) + 2 * R2_T; const bf16* KK = Qb + R2_T; const bf16* VV = KK + R2_T;
    bf16* CAT = (bf16*)(P.ws + WS_R3);
    LAS unsigned char* kbuf = lds + LDS_SCR;
    LAS unsigned char* vbuf = lds + LDS_SCR + 32768;
    LAS float* rpbL = (LAS float*)(lds + LDS_SCR + 65536);
    const int ql = lane & 31, hf = lane >> 5;
    const float* gq = P.in[I_BQG];
    for (int u = blockIdx.x; u < 1024; u += gridDim.x) {
        const int h = u & 7, rg = (u >> 3) & 63, b = u >> 9;
        const int qr = 4 * rg + (wave >> 1), qc = 32 * (wave & 1) + ql;
        const int tq = b * SEQ + qr * GRIDW + qc;
        bf16x8 Qf[8];
        { v4u raw[8]; float ss = 0.f;
#pragma unroll
          for (int s = 0; s < 8; ++s) { raw[s] = *(const GAS v4u*)(Qb + (size_t)tq * 1024 + h * 128 + 16 * s + 8 * hf);
              const float a0 = bf_lo(raw[s].x), a1 = bf_hi(raw[s].x), a2 = bf_lo(raw[s].y), a3 = bf_hi(raw[s].y), a4 = bf_lo(raw[s].z), a5 = bf_hi(raw[s].z), a6 = bf_lo(raw[s].w), a7 = bf_hi(raw[s].w);
              ss += (a0 * a0 + a1 * a1) + (a2 * a2 + a3 * a3) + (a4 * a4 + a5 * a5) + (a6 * a6 + a7 * a7); }
          ss += __shfl_xor(ss, 32);
          const float qs = (1.0f / sqrtf(ss * (1.0f / 128.0f) + EPS)) * (0.08838834764831845f * LOG2E);
#pragma unroll
          for (int s = 0; s < 8; ++s) { const f32x4 g0 = *(const f32x4*)(gq + 16 * s + 8 * hf), g1 = *(const f32x4*)(gq + 16 * s + 8 * hf + 4);
              v4u o; o.x = pk2(bf_lo(raw[s].x) * qs * g0.x, bf_hi(raw[s].x) * qs * g0.y); o.y = pk2(bf_lo(raw[s].y) * qs * g0.z, bf_hi(raw[s].y) * qs * g0.w);
              o.z = pk2(bf_lo(raw[s].z) * qs * g1.x, bf_hi(raw[s].z) * qs * g1.y); o.w = pk2(bf_lo(raw[s].w) * qs * g1.z, bf_hi(raw[s].w) * qs * g1.w);
              Qf[s] = __builtin_bit_cast(bf16x8, o); } }
        if (tid < 465) rpbL[tid] = P.in[I_RPB][h * 465 + tid] * LOG2E;
        const int rs_q = min(max(qr - 4, 0), NROWS - 8);
        const int krlo = min(max(4 * rg - 4, 0), NROWS - 8), krhi = min(max(4 * rg + 3 - 4, 0), NROWS - 8) + 7, ntl = krhi - krlo + 1, T = ntl + 4;
        const int cs = min(max(qc - 8, 0), GRIDW - 16);
        f32x16 O[4];
#pragma unroll
        for (int db = 0; db < 4; ++db)
#pragma unroll
            for (int i = 0; i < 16; ++i) O[db][i] = 0.f;
        float m_run = -1e30f, l_run = 0.f;
        v4u kreg[2], vreg[2];
#define ATT_LOAD(t) do { const int _tb = (t) < ntl ? b * SEQ + (krlo + (t)) * GRIDW : NT + b * CTXL + 64 * ((t) - ntl); \
        _Pragma("unroll") for (int _i = 0; _i < 2; ++_i) { const int _c = tid + 512 * _i, _key = _c >> 4, _ch = _c & 15; const size_t _o = (size_t)(_tb + _key) * 1024 + h * 128 + _ch * 8; \
            kreg[_i] = *(const GAS v4u*)(KK + _o); vreg[_i] = *(const GAS v4u*)(VV + _o); } } while (0)
#define ATT_STORE(buf) do { _Pragma("unroll") for (int _i = 0; _i < 2; ++_i) { const int _c = tid + 512 * _i, _key = _c >> 4, _ch = _c & 15; const unsigned _o = (buf) * 16384 + (_key >> 5) * 8192 + off_b(_key & 31, _ch); \
            *(LAS v4u*)(kbuf + _o) = kreg[_i]; *(LAS v4u*)(vbuf + _o) = vreg[_i]; } } while (0)
        ATT_LOAD(0); ATT_STORE(0);
        __syncthreads();
        for (int t = 0; t < T; ++t) {
            if (t + 1 < T) ATT_LOAD(t + 1);
            const bool local = t < ntl; const int kr = krlo + t;
            const bool active = !local || (kr >= rs_q && kr <= rs_q + 7);
            if (active) {
                const LAS unsigned char* kb_ = kbuf + (t & 1) * 16384; const LAS unsigned char* vb_ = vbuf + (t & 1) * 16384;
                f32x16 S0, S1;
#pragma unroll
                for (int i = 0; i < 16; ++i) { S0[i] = 0.f; S1[i] = 0.f; }
#pragma unroll
                for (int s = 0; s < 8; ++s) { const bf16x8 a0 = row_frag(kb_, lane, s), a1 = row_frag(kb_ + 8192, lane, s); S0 = MFMA32(a0, Qf[s], S0); S1 = MFMA32(a1, Qf[s], S1); }
                if (local) {
                    const int dr = kr - qr + 7;
#pragma unroll
                    for (int r = 0; r < 16; ++r) { const int kc0 = crow(r, hf), kc1 = 32 + kc0;
                        { const bool ok = (unsigned)(kc0 - cs) < 16u; const int ci = min(max(kc0 - qc + 15, 0), 30); const float bia = rpbL[dr * 31 + ci]; S0[r] = ok ? S0[r] + bia : -1e30f; }
                        { const bool ok = (unsigned)(kc1 - cs) < 16u; const int ci = min(max(kc1 - qc + 15, 0), 30); const float bia = rpbL[dr * 31 + ci]; S1[r] = ok ? S1[r] + bia : -1e30f; } }
                }
                float mt = S0[0];
#pragma unroll
                for (int r = 1; r < 16; ++r) mt = fmaxf(mt, S0[r]);
#pragma unroll
                for (int r = 0; r < 16; ++r) mt = fmaxf(mt, S1[r]);
                mt = fmaxf(mt, __shfl_xor(mt, 32));
                const float m_new = fmaxf(m_run, mt), alpha = fast_exp2(m_run - m_new);
                m_run = m_new;
                float ps = 0.f;
#pragma unroll
                for (int r = 0; r < 16; ++r) { S0[r] = fast_exp2(S0[r] - m_new); S1[r] = fast_exp2(S1[r] - m_new); ps += S0[r] + S1[r]; }
                l_run = l_run * alpha + ps;
#pragma unroll
                for (int db = 0; db < 4; ++db)
#pragma unroll
                    for (int i = 0; i < 16; ++i) O[db][i] *= alpha;
#pragma unroll
                for (int kb = 0; kb < 2; ++kb)
#pragma unroll
                    for (int s2 = 0; s2 < 2; ++s2) {
                        v4u pp;
                        if (kb == 0) { pp.x = pk2(S0[8 * s2 + 0], S0[8 * s2 + 1]); pp.y = pk2(S0[8 * s2 + 2], S0[8 * s2 + 3]); pp.z = pk2(S0[8 * s2 + 4], S0[8 * s2 + 5]); pp.w = pk2(S0[8 * s2 + 6], S0[8 * s2 + 7]); }
                        else         { pp.x = pk2(S1[8 * s2 + 0], S1[8 * s2 + 1]); pp.y = pk2(S1[8 * s2 + 2], S1[8 * s2 + 3]); pp.z = pk2(S1[8 * s2 + 4], S1[8 * s2 + 5]); pp.w = pk2(S1[8 * s2 + 6], S1[8 * s2 + 7]); }
                        const bf16x8 pf = __builtin_bit_cast(bf16x8, pp);
#pragma unroll
                        for (int db = 0; db < 4; ++db) { const bf16x8 a = tr_frag<true>(vb_ + kb * 8192, lane, db, s2); O[db] = MFMA32(a, pf, O[db]); }
                    }
            }
            if (t + 1 < T) ATT_STORE((t + 1) & 1);
            __syncthreads();
        }
#undef ATT_LOAD
#undef ATT_STORE
        const float inv = 1.0f / (l_run + __shfl_xor(l_run, 32));
        bf16* orow = CAT + (size_t)tq * D + 1024 + h * 128;
#pragma unroll
        for (int db = 0; db < 4; ++db)
#pragma unroll
            for (int rq = 0; rq < 4; ++rq) { v2u o; o.x = pk2(O[db][4 * rq + 0] * inv, O[db][4 * rq + 1] * inv); o.y = pk2(O[db][4 * rq + 2] * inv, O[db][4 * rq + 3] * inv);
                *(GAS v2u*)(orow + 32 * db + 8 * rq + 4 * hf) = o; }
    }
}

DI void phase_conv(const Params& P, int lane, int wave) {
    const bf16* BG = (const bf16*)(P.ws + WS_R2); const bf16* CZ = BG + (size_t)NT * D; bf16* WC = (bf16*)(P.ws + WS_R3);
    const float* cw = P.in[I_CONVW];
    const int gw = blockIdx.x * NWAVES + wave, NGW = gridDim.x * NWAVES;
    for (int tok = gw; tok < NT; tok += NGW) {
        const int n = tok & (SEQ - 1); const bool hasm = n > 0, hasp = n < SEQ - 1;
        const GAS v2u* bg = (const GAS v2u*)(BG + (size_t)tok * D) + lane; const GAS v2u* z0 = (const GAS v2u*)(CZ + (size_t)tok * D) + lane;
        const GAS v2u* zm = (const GAS v2u*)(CZ + (size_t)(tok - (hasm ? 1 : 0)) * D) + lane; const GAS v2u* zp = (const GAS v2u*)(CZ + (size_t)(tok + (hasp ? 1 : 0)) * D) + lane;
        GAS v2u* o = (GAS v2u*)(WC + (size_t)tok * D) + lane;
        const float fm = hasm ? 1.f : 0.f, fp = hasp ? 1.f : 0.f;
#pragma unroll
        for (int j = 0; j < 8; ++j) { const int c = 256 * j + 4 * lane;
            const f32x4 w0 = *(const f32x4*)(cw + c) * fm, w1 = *(const f32x4*)(cw + D + c), w2 = *(const f32x4*)(cw + 2 * D + c) * fp;
            const v2u b_ = bg[64 * j], a = zm[64 * j], m = z0[64 * j], p = zp[64 * j];
            const float r0 = bf_lo(b_.x) * (w0.x * bf_lo(a.x) + w1.x * bf_lo(m.x) + w2.x * bf_lo(p.x));
            const float r1 = bf_hi(b_.x) * (w0.y * bf_hi(a.x) + w1.y * bf_hi(m.x) + w2.y * bf_hi(p.x));
            const float r2 = bf_lo(b_.y) * (w0.z * bf_lo(a.y) + w1.z * bf_lo(m.y) + w2.z * bf_lo(p.y));
            const float r3 = bf_hi(b_.y) * (w0.w * bf_hi(a.y) + w1.w * bf_hi(m.y) + w2.w * bf_hi(p.y));
            v2u w; w.x = pk2(r0, r1); w.y = pk2(r2, r3); o[64 * j] = w; }
    }
}

constexpr int NPHASE = 21;
__global__ void __launch_bounds__(NWAVES * 64, 2) mega_fwd(Params P) {
    extern __shared__ __attribute__((aligned(16))) unsigned char lds_raw[];
    LAS unsigned char* lds = (LAS unsigned char*)lds_raw;
    volatile LAS unsigned* MISC = (volatile LAS unsigned*)(lds + MISC_OFF);
    const int tid = threadIdx.x, lane = tid & 63, wave = __builtin_amdgcn_readfirstlane(tid >> 6);
    for (int u = tid; u < (LDS_BYTES - LDSCTL_OFF) / 4; u += NWAVES * 64) ((LAS unsigned*)(lds + LDSCTL_OFF))[u] = 0u;
    __syncthreads();
    unsigned* barw = (unsigned*)(P.ws + WS_CTL + CTL_BAR) + (size_t)P.li * XCD_BAR_WORDS;
    XcdBarrier bar; bar.bar = barw; bar.x = 0; bar.st = nullptr;
    const int lo = P.ph_lo, hi = P.ph_hi;
    if (hi - lo > 1) bar = xcd_barrier_post(barw, MISC + 8);
#define IN(k) (lo <= (k) && (k) < hi)
#define SEAM(k) do { if (IN(k) && IN((k) + 1)) xcd_barrier(bar); } while (0)
    unsigned char* ws = P.ws;
    const int G = gridDim.x, cid = blockIdx.x;
    const float* MOD = (const float*)(ws + WS_MOD);

    if (IN(0)) { phase_prologue(P, lds, tid, lane, wave); __syncthreads(); } SEAM(0);
    if (IN(1)) { phase_norm1_l0(P, lane, wave); } SEAM(1);
    if (IN(2)) {
        pg8::Gemm g{(const bf16*)(ws + WS_H), (const bf16*)(ws + WS_WIN0), MTOT, 5120, D}; pg8::StaticOrder<false> S; S.init(MTOT, 5120, G, cid);
        EpiIn0 E{(bf16*)(ws + WS_R2)};
        pg8::gemm_phase<EpiIn0, pg8::StaticOrder<false>, true, true>(lds, g, S, E);
    } SEAM(2);
    if (IN(3)) { phase_knorm(P, lane, wave); phase_gmlp(P, lds, tid, lane, wave); } SEAM(3);
    if (IN(4)) { phase_attn(P, lds, tid, lane, wave); } SEAM(4);
    if (IN(5)) {
        pg8::Gemm g{(const bf16*)(ws + WS_R3), (const bf16*)(ws + WS_WOUT0), NT, D, D}; pg8::StaticOrder<false> S; S.init(NT, D, G, cid);
        EpiResid E{P.in[I_X], P.out, MOD + 2 * 2048};
        pg8::gemm_phase<EpiResid, pg8::StaticOrder<false>, true, true>(lds, g, S, E);
    } SEAM(5);
#define MOE_PHASES(L, base) \
    if (IN(base + 0)) { phase_norm2_router(P, L, lds, tid, lane, wave); } SEAM(base + 0); \
    if (IN(base + 1)) { phase_topk(P, L, lds, tid, lane, wave); } SEAM(base + 1); \
    if (IN(base + 2)) { phase_gather(P, lane, wave); } SEAM(base + 2); \
    if (IN(base + 3)) { pg8::Gemm g{(const bf16*)(ws + WS_R2), (const bf16*)(ws + WS_GU) + (size_t)(L) * 16 * 2048 * 2048, 65536, 2048, D}; pg8::StaticOrder<true> S; S.init(65536, 2048, G, cid); \
        EpiSwiglu E{(bf16*)(ws + WS_R2) + (size_t)65536 * D}; pg8::gemm_phase<EpiSwiglu, pg8::StaticOrder<true>, true, true>(lds, g, S, E); } SEAM(base + 3); \
    if (IN(base + 4)) { pg8::Gemm g{(const bf16*)(ws + WS_R2) + (size_t)65536 * D, (const bf16*)(ws + WS_DN) + (size_t)(L) * 16 * 2048 * 1024, 65536, 2048, FF}; pg8::StaticOrder<true> S; S.init(65536, 2048, G, cid); \
        EpiPlain E{(bf16*)(ws + WS_R3), D}; pg8::gemm_phase<EpiPlain, pg8::StaticOrder<true>, true, true>(lds, g, S, E); } SEAM(base + 4);
    MOE_PHASES(0, 6)
    if (IN(11)) { phase_combine<true>(P, 0, lane, wave); } SEAM(11);
    if (IN(12)) {
        pg8::Gemm g{(const bf16*)(ws + WS_H), (const bf16*)(ws + WS_WCIN), NT, 6144, D}; pg8::StaticOrder<false> S; S.init(NT, 6144, G, cid);
        EpiCin E{(bf16*)(ws + WS_R2), (bf16*)(ws + WS_R2) + (size_t)NT * D};
        pg8::gemm_phase<EpiCin, pg8::StaticOrder<false>, true, true>(lds, g, S, E);
    } SEAM(12);
    if (IN(13)) { phase_conv(P, lane, wave); } SEAM(13);
    if (IN(14)) {
        pg8::Gemm g{(const bf16*)(ws + WS_R3), (const bf16*)(ws + WS_WCOUT), NT, D, D}; pg8::StaticOrder<false> S; S.init(NT, D, G, cid);
        EpiResid E{P.out, P.out, MOD + 3 * 12288 + 2 * 2048};
        pg8::gemm_phase<EpiResid, pg8::StaticOrder<false>, true, true>(lds, g, S, E);
    } SEAM(14);
    MOE_PHASES(1, 15)
    if (IN(20)) { phase_combine<false>(P, 1, lane, wave); }
#undef IN
#undef SEAM
}

extern "C" void kernel_launch(void* const* d_in, const int* in_sizes, int n_in, void* d_out, int out_size, void* d_ws, size_t ws_size, hipStream_t stream) {
    static int grid = 0;
    if (grid == 0) {
        if (n_in != 23 || out_size != NT * D || ws_size < WS_END) { fprintf(stderr, "kernel_launch: unexpected shapes (n_in %d out %d ws %zu)\n", n_in, out_size, ws_size); grid = -1; return; }
        int dev = 0, cus = 0, per_cu = 0;
        if (hipGetDevice(&dev) != hipSuccess || hipDeviceGetAttribute(&cus, hipDeviceAttributeMultiprocessorCount, dev) != hipSuccess) { grid = -1; return; }
        if (hipFuncSetAttribute((const void*)mega_fwd, hipFuncAttributeMaxDynamicSharedMemorySize, LDS_BYTES) != hipSuccess) { fprintf(stderr, "kernel_launch: hipFuncSetAttribute failed\n"); grid = -1; return; }
        if (hipOccupancyMaxActiveBlocksPerMultiprocessor(&per_cu, (const void*)mega_fwd, NWAVES * 64, LDS_BYTES) != hipSuccess || per_cu < 1) { fprintf(stderr, "kernel_launch: occupancy query says %d\n", per_cu); }
        (void)hipGetLastError();
        grid = cus;
    }
    if (grid < 0) return;
    (void)hipMemsetAsync((char*)d_ws + WS_CTL, 0, CTL_ZERO_BYTES, stream);
    Params p{};
    for (int i = 0; i < 23; ++i) p.in[i] = (const float*)d_in[i];
    p.out = (float*)d_out; p.ws = (unsigned char*)d_ws; p.pad = 0;
    const int last = MK_STOP < NPHASE - 1 ? MK_STOP : NPHASE - 1;
#if MK_SPLIT
    for (int k = 0; k <= last; ++k) { p.ph_lo = k; p.ph_hi = k + 1; p.li = 0; hipLaunchKernelGGL(mega_fwd, dim3(grid), dim3(NWAVES * 64), LDS_BYTES, stream, p); }
#else
    p.ph_lo = 0; p.ph_hi = last + 1; p.li = 0;
    hipLaunchKernelGGL(mega_fwd, dim3(grid), dim3(NWAVES * 64), LDS_BYTES, stream, p);
#endif
}
```

```cpp
#include <hip/hip_runtime.h>
#include <cstdio>
#include <cstdint>

#ifndef MK_SPLIT
#define MK_SPLIT 0
#endif
#ifndef MK_STOP
#define MK_STOP 99
#endif
#ifndef MK_FP8_L0
#define MK_FP8_L0 1
#endif
#ifndef MK_FP8_L1
#define MK_FP8_L1 1
#endif
#ifndef MK_DUP
#define MK_DUP -1
#endif

namespace pg8 {
#define PG8_LAS __attribute__((address_space(3)))
typedef unsigned short bf16_t;
typedef short bf16x8 __attribute__((ext_vector_type(8)));
typedef float f32x4 __attribute__((ext_vector_type(4)));
typedef unsigned u32x4 __attribute__((ext_vector_type(4)));
constexpr int BM = 256, BK = 64, HALF = 128, HTB = HALF * BK * 2, STAGE_BYTES = 8 * HTB, NXCD = 8, WGM = 8;

__host__ __device__ __forceinline__ int lds_byte(int r, int c) { const int st = (r >> 4) * 2 + (c >> 5), rr = r & 15, cc = c & 31, ob = rr * 64 + cc * 2; return st * 1024 + (ob ^ (((ob >> 9) & 1) << 5)); }
__host__ __device__ __forceinline__ void stage_rc(int b, int& R, int& C) { const int st = b / 1024, sb = b % 1024, swz = sb ^ (((sb >> 9) & 1) << 5); R = (st >> 1) * 16 + swz / 64; C = (st & 1) * 32 + (swz % 64) / 2; }
__host__ __device__ __forceinline__ int perm32(int rho) { const int n = rho >> 4, i = rho & 15; return 8 * (i >> 2) + 4 * n + (i & 3); }

struct Unit { int pm, pn, pb; };
struct Gemm { const bf16_t* A; const bf16_t* Bt; int M, N, K; };

template <bool GROUPED>
struct StaticOrder {
    int nM, nN, nwg, G, c;
    __host__ __device__ void init(int M, int N, int G_, int c_) { nM = M / BM; nN = N / BM; nwg = nM * nN; G = G_; c = c_; }
    __host__ __device__ bool next(int i, Unit& u) const {
        const long L = (long)i * G + c; if (L >= nwg) return false;
        int wgid = (int)L; { const int q = nwg / NXCD, r = nwg % NXCD, xcd = wgid % NXCD, off = wgid / NXCD; wgid = (xcd < r ? xcd * (q + 1) : r * (q + 1) + (xcd - r) * q) + off; }
        const int nig = WGM * nN, gid = wgid / nig, fm = gid * WGM, gsz = (nM - fm) < WGM ? (nM - fm) : WGM;
        u.pm = fm + ((wgid % nig) % gsz); u.pn = (wgid % nig) / gsz;
        u.pb = GROUPED ? ((u.pm >> 4) * 8 + u.pn) : u.pn;
        return true;
    }
    __device__ __forceinline__ void a_ready(const Unit&) const {}
    __device__ __forceinline__ void done(const Unit&) const {}
};

__device__ __forceinline__ unsigned cvt_pk_bf16(float lo, float hi) { unsigned r; asm volatile("v_cvt_pk_bf16_f32 %0, %1, %2" : "=v"(r) : "v"(lo), "v"(hi)); return r; }

typedef int i32x4 __attribute__((ext_vector_type(4)));
typedef int i32x8 __attribute__((ext_vector_type(8)));
__device__ __forceinline__ i32x8 cat8(bf16x8 lo, bf16x8 hi) { return __builtin_shufflevector(__builtin_bit_cast(i32x4, lo), __builtin_bit_cast(i32x4, hi), 0, 1, 2, 3, 4, 5, 6, 7); }
template <class Epi, class Sched, bool ALIGN_EPI = false, bool SP2 = false, bool FP8 = false>
__device__ __forceinline__ void gemm_phase(PG8_LAS unsigned char* lds, const Gemm g, const Sched& S, const Epi& E) {
    const int tid = threadIdx.x, wid = __builtin_amdgcn_readfirstlane(tid >> 6), lane = tid & 63, wr = wid >> 2, wc = wid & 3, fr = lane & 15, fq = lane >> 4;
    const int K = g.K, nt = K / BK;
    unsigned voffA[2], voffB[2];
#pragma unroll
    for (int i = 0; i < 2; ++i) { int R, C; stage_rc(tid * 16 + i * 8192, R, C); const int Rb = Epi::PERM ? ((R & ~31) + perm32(R & 31)) : R;
        voffA[i] = (unsigned)(R * K + C) * 2u; voffB[i] = (unsigned)(Rb * K + C) * 2u; }
    const size_t kstep = (size_t)(BK * 2);
    const size_t hstep = (size_t)HALF * K * 2;
    const size_t tstep = 2 * hstep;
    const unsigned ldsw = (unsigned)wid * 1024u;
    const int aoff = lds_byte(wr * 64 + fr, fq * 8), boff = lds_byte(wc * 32 + fr, fq * 8);
#define PG8_SA(b, h) (((b) * 2 + (h)) * HTB)
#define PG8_SB(b, h) ((4 + (b) * 2 + (h)) * HTB)
#define PG8_STAGE(bufoff, gbase, voff) do { _Pragma("unroll") for (int _i = 0; _i < 2; ++_i) \
        __builtin_amdgcn_global_load_lds((const unsigned*)((const char*)(gbase) + (voff)[_i]), (PG8_LAS unsigned*)(lds + (bufoff) + ldsw + _i * 8192), 16, 0, 0); } while (0)
#define PG8_LDA(dst, b, h) do { _Pragma("unroll") for (int m = 0; m < 4; ++m) _Pragma("unroll") for (int k = 0; k < 2; ++k) dst[m][k] = *(const PG8_LAS bf16x8*)(lds + PG8_SA(b, h) + aoff + m * 2048 + k * 1024); } while (0)
#define PG8_LDB(dst, b, h) do { _Pragma("unroll") for (int n = 0; n < 2; ++n) _Pragma("unroll") for (int k = 0; k < 2; ++k) dst[n][k] = *(const PG8_LAS bf16x8*)(lds + PG8_SB(b, h) + boff + n * 2048 + k * 1024); } while (0)
#define PG8_MMA(ai, bj, At, Bt) do { __builtin_amdgcn_s_setprio(1); _Pragma("unroll") for (int m = 0; m < 4; ++m) _Pragma("unroll") for (int n = 0; n < 2; ++n) { \
        if constexpr (FP8) { const i32x8 _a = cat8(Bt[n][0], Bt[n][1]), _b = cat8(At[m][0], At[m][1]); asm volatile("v_mfma_f32_16x16x128_f8f6f4 %0, %1, %2, %0" : "+v"(acc[ai][bj][m][n]) : "v"(_a), "v"(_b)); } \
        else { _Pragma("unroll") for (int k = 0; k < 2; ++k) acc[ai][bj][m][n] = __builtin_amdgcn_mfma_f32_16x16x32_bf16(Bt[n][k], At[m][k], acc[ai][bj][m][n], 0, 0, 0); } } \
        __builtin_amdgcn_s_setprio(0); } while (0)
#define PG8_WAIT_V(n) asm volatile("s_waitcnt vmcnt(" #n ")" ::: "memory")
#define PG8_WAIT_L(n) asm volatile("s_waitcnt lgkmcnt(" #n ")" ::: "memory")
#define PG8_BAR __builtin_amdgcn_s_barrier()
#define PG8_SCHED __builtin_amdgcn_sched_barrier(0)
    Unit cur, nxt; int ui = 0;
    if (!S.next(0, cur)) return;
    f32x4 acc[2][2][4][2];
#pragma unroll
    for (int a = 0; a < 2; ++a)
#pragma unroll
        for (int b = 0; b < 2; ++b)
#pragma unroll
            for (int m = 0; m < 4; ++m)
#pragma unroll
                for (int n = 0; n < 2; ++n) acc[a][b][m][n] = (f32x4){0.f, 0.f, 0.f, 0.f};
    bf16x8 At[4][2], B0[2][2], B1[2][2];
    const char* cA = (const char*)g.A + (size_t)cur.pm * tstep; const char* cB = (const char*)g.Bt + (size_t)cur.pb * tstep;
    S.a_ready(cur);
    if constexpr (SP2) {
        PG8_STAGE(PG8_SB(0, 0), cB, voffB); PG8_STAGE(PG8_SB(0, 1), cB + hstep, voffB); PG8_STAGE(PG8_SA(0, 0), cA, voffA); PG8_STAGE(PG8_SA(0, 1), cA + hstep, voffA);
        if (wr == 1) PG8_BAR;
        PG8_WAIT_V(2); PG8_BAR;
        PG8_STAGE(PG8_SB(1, 0), cB + kstep, voffB); PG8_STAGE(PG8_SA(1, 0), cA + kstep, voffA); PG8_STAGE(PG8_SB(1, 1), cB + hstep + kstep, voffB);
        PG8_WAIT_V(6); PG8_BAR;
    } else {
        PG8_STAGE(PG8_SB(0, 0), cB, voffB); PG8_STAGE(PG8_SA(0, 0), cA, voffA); PG8_STAGE(PG8_SB(0, 1), cB + hstep, voffB); PG8_STAGE(PG8_SA(0, 1), cA + hstep, voffA);
        if (wr == 1) PG8_BAR;
        PG8_WAIT_V(4); PG8_BAR;
        PG8_STAGE(PG8_SB(1, 0), cB + kstep, voffB); PG8_STAGE(PG8_SA(1, 0), cA + kstep, voffA); PG8_STAGE(PG8_SB(1, 1), cB + hstep + kstep, voffB);
        PG8_WAIT_V(6); PG8_BAR;
    }
    for (;;) {
        const bool has_next = S.next(ui + 1, nxt);
        const char* nA = has_next ? (const char*)g.A + (size_t)nxt.pm * tstep : cA; const char* nB = has_next ? (const char*)g.Bt + (size_t)nxt.pb * tstep : cB;
        for (int t = 0; t < nt; t += 2) {
            const bool last = (t == nt - 2);
            const char* a1 = cA + (size_t)(t + 1) * kstep;
            const char* a2 = last ? nA : cA + (size_t)(t + 2) * kstep; const char* b2 = last ? nB : cB + (size_t)(t + 2) * kstep;
            const char* a3 = a2 + kstep; const char* b3 = b2 + kstep;
            if (last && has_next) S.a_ready(nxt);
            if constexpr (SP2) {
            PG8_LDB(B0, 0, 0); PG8_LDB(B1, 0, 1); PG8_SCHED; PG8_LDA(At, 0, 0); PG8_STAGE(PG8_SA(1, 1), a1 + hstep, voffA);
            PG8_WAIT_V(8); PG8_WAIT_L(0); PG8_BAR; PG8_MMA(0, 0, At, B0); PG8_MMA(0, 1, At, B1); PG8_BAR; PG8_SCHED;
            PG8_LDA(At, 0, 1); PG8_STAGE(PG8_SB(0, 0), b2, voffB); PG8_STAGE(PG8_SB(0, 1), b2 + hstep, voffB); PG8_STAGE(PG8_SA(0, 0), a2, voffA);
            PG8_WAIT_V(8); PG8_WAIT_L(0); PG8_BAR; PG8_MMA(1, 0, At, B0); PG8_MMA(1, 1, At, B1); PG8_BAR; PG8_SCHED;
            PG8_LDB(B0, 1, 0); PG8_LDB(B1, 1, 1); PG8_SCHED; PG8_LDA(At, 1, 0); PG8_STAGE(PG8_SA(0, 1), a2 + hstep, voffA);
            PG8_WAIT_V(8); PG8_WAIT_L(0); PG8_BAR; PG8_MMA(0, 0, At, B0); PG8_MMA(0, 1, At, B1); PG8_BAR; PG8_SCHED;
            PG8_LDA(At, 1, 1); PG8_STAGE(PG8_SB(1, 0), b3, voffB); PG8_STAGE(PG8_SB(1, 1), b3 + hstep, voffB); PG8_STAGE(PG8_SA(1, 0), a3, voffA);
            PG8_WAIT_V(8); PG8_WAIT_L(0); PG8_BAR; PG8_MMA(1, 0, At, B0); PG8_MMA(1, 1, At, B1); PG8_BAR; PG8_SCHED;
            } else {
            PG8_LDB(B0, 0, 0); PG8_SCHED; PG8_LDA(At, 0, 0); PG8_STAGE(PG8_SA(1, 1), a1 + hstep, voffA);
            PG8_WAIT_L(8); PG8_BAR; PG8_WAIT_L(0); PG8_MMA(0, 0, At, B0); PG8_BAR; PG8_SCHED;
            PG8_LDB(B1, 0, 1); PG8_STAGE(PG8_SB(0, 0), b2, voffB);
            PG8_BAR; PG8_WAIT_L(0); PG8_MMA(0, 1, At, B1); PG8_BAR;
            PG8_LDA(At, 0, 1); PG8_STAGE(PG8_SA(0, 0), a2, voffA);
            PG8_BAR; PG8_WAIT_L(0); PG8_MMA(1, 0, At, B0); PG8_BAR; PG8_SCHED;
            PG8_STAGE(PG8_SB(0, 1), b2 + hstep, voffB);
            PG8_WAIT_V(6); PG8_BAR; PG8_MMA(1, 1, At, B1); PG8_BAR;
            PG8_LDB(B0, 1, 0); PG8_SCHED; PG8_LDA(At, 1, 0); PG8_STAGE(PG8_SA(0, 1), a2 + hstep, voffA);
            PG8_WAIT_L(8); PG8_BAR; PG8_WAIT_L(0); PG8_MMA(0, 0, At, B0); PG8_BAR; PG8_SCHED;
            PG8_LDB(B1, 1, 1); PG8_STAGE(PG8_SB(1, 0), b3, voffB);
            PG8_BAR; PG8_WAIT_L(0); PG8_MMA(0, 1, At, B1); PG8_BAR;
            PG8_LDA(At, 1, 1); PG8_STAGE(PG8_SA(1, 0), a3, voffA);
            PG8_BAR; PG8_WAIT_L(0); PG8_MMA(1, 0, At, B0); PG8_BAR; PG8_SCHED;
            PG8_STAGE(PG8_SB(1, 1), b3 + hstep, voffB);
            PG8_WAIT_V(6); PG8_BAR; PG8_MMA(1, 1, At, B1); PG8_BAR;
            }
        }
        if constexpr (ALIGN_EPI) { if (wr == 0) PG8_BAR; }
        if constexpr (FP8) asm volatile("s_nop 7\n\ts_nop 7\n\ts_nop 7" ::: "memory");
        E(acc, cur, wr, wc, fr, fq);
        if (!has_next) break;
#pragma unroll
        for (int a = 0; a < 2; ++a)
#pragma unroll
            for (int b = 0; b < 2; ++b)
#pragma unroll
                for (int m = 0; m < 4; ++m)
#pragma unroll
                    for (int n = 0; n < 2; ++n) acc[a][b][m][n] = (f32x4){0.f, 0.f, 0.f, 0.f};
        cur = nxt; cA = nA; cB = nB; ++ui;
        if constexpr (ALIGN_EPI) { if (wr == 1) PG8_BAR; }
    }
    PG8_WAIT_V(0);
    if constexpr (!ALIGN_EPI) { if (wr == 0) PG8_BAR; }
    PG8_BAR;
#undef PG8_SA
#undef PG8_SB
#undef PG8_STAGE
#undef PG8_LDA
#undef PG8_LDB
#undef PG8_MMA
#undef PG8_WAIT_V
#undef PG8_WAIT_L
#undef PG8_BAR
#undef PG8_SCHED
}
}

constexpr int D = 2048, NB = 2, SEQ = 16384, NT = NB * SEQ, CTXL = 256, NCTX = NB * CTXL, MTOT = NT + NCTX;
constexpr int NEXP = 16, CAP = 2048, FF = 1024, GRIDW = 64, NROWS = 256;
constexpr float EPS = 1e-6f;
constexpr float LOG2E = 1.4426950408889634f;
constexpr int NWAVES = 8;

constexpr size_t MiB = 1u << 20;
constexpr size_t WS_CTL = 0, CTL_ZERO_BYTES = 1 * MiB;
constexpr size_t CTL_TOKCNT0 = 262144, CTL_TOKCNT1 = 393216, CTL_BAR = 524288;
constexpr size_t WS_MOD = 1 * MiB;
constexpr size_t WS_AFF = 2 * MiB;
constexpr size_t WS_IDX = 4 * MiB;
constexpr size_t WS_TOKLIST = 5 * MiB;
constexpr size_t WS_WSB = 9 * MiB;
constexpr size_t WS_WIN0 = 10 * MiB, WS_WOUT0 = 30 * MiB, WS_WCIN = 38 * MiB, WS_WCOUT = 62 * MiB;
constexpr size_t WS_GU = 70 * MiB;
constexpr size_t WS_DN = 326 * MiB;
constexpr size_t WS_H = 454 * MiB;
constexpr size_t WS_R2 = 584 * MiB;
constexpr size_t WS_R3 = 968 * MiB;
constexpr size_t WS_END = 1224 * MiB;
constexpr size_t R2_T = (size_t)MTOT * 1024;

constexpr int LDS_SCR = 0;
constexpr int LDSCTL_OFF = 135168, MISC_OFF = LDSCTL_OFF + 320;
constexpr int LDS_BYTES = 147456;

#define GAS __attribute__((address_space(1)))
#define LAS __attribute__((address_space(3)))
#define DI __device__ __forceinline__
typedef unsigned short bf16;
typedef unsigned v4u __attribute__((ext_vector_type(4)));
typedef unsigned v2u __attribute__((ext_vector_type(2)));
typedef float f32x4 __attribute__((ext_vector_type(4)));
typedef float f32x16 __attribute__((ext_vector_type(16)));
typedef short bf16x8 __attribute__((ext_vector_type(8)));
typedef short s16x4 __attribute__((ext_vector_type(4)));
typedef GAS unsigned gu32;
#define RLX_AGENT __ATOMIC_RELAXED, __HIP_MEMORY_SCOPE_AGENT
#define LDS_WAIT() asm volatile("s_waitcnt lgkmcnt(0)" ::: "memory")
#define VM_WAIT() asm volatile("s_waitcnt vmcnt(0)" ::: "memory")
DI float bf_lo(unsigned u) { return __uint_as_float(u << 16); }
DI float bf_hi(unsigned u) { return __uint_as_float(u & 0xffff0000u); }
DI unsigned pk2(float lo, float hi) { return pg8::cvt_pk_bf16(lo, hi); }
constexpr float F8_WSCALE = 64.0f, F8_WINV = 1.0f / 64.0f;
DI float clamp448(float x) { return __builtin_amdgcn_fmed3f(x, -448.0f, 448.0f); }
DI unsigned pk4_fp8(float a, float b, float c, float d) { int p = __builtin_amdgcn_cvt_pk_fp8_f32(clamp448(a), clamp448(b), 0, false); p = __builtin_amdgcn_cvt_pk_fp8_f32(clamp448(c), clamp448(d), p, true); return (unsigned)p; }
DI float wave_sum(float v) {
#pragma unroll
    for (int o = 1; o < 64; o <<= 1) v += __shfl_xor(v, o);
    return v;
}
DI int wave_sum_i(int v) {
#pragma unroll
    for (int o = 1; o < 64; o <<= 1) v += __shfl_xor(v, o);
    return v;
}
DI float fast_rcp(float x) { return __builtin_amdgcn_rcpf(x); }
DI float fast_exp2(float x) { return __builtin_amdgcn_exp2f(x); }
DI float sigmoidf_(float z) { return fast_rcp(1.0f + fast_exp2(-z * LOG2E)); }
DI float gelu_tanh(float x) { const float z = 1.5957691216057308f * (x + 0.044715f * x * x * x); return x * sigmoidf_(z); }
DI float siluf_(float x) { return x * sigmoidf_(x); }

#define XB_TMO      128
#define XB_XCNT(j)  (256  + 64 * (j))
#define XB_XSUB(j)  (1280 + 64 * (j))
#define XB_XGEN(j)  (2304 + 64 * (j))
#define XB_TOP      3328
#define XB_TOPGEN   3392
#define XCD_BAR_WORDS 3456
#define XB_SPIN_CAP (1u << 18)

__device__ __forceinline__ unsigned xb_ld(unsigned* p)              { return __hip_atomic_load(p, __ATOMIC_RELAXED, __HIP_MEMORY_SCOPE_AGENT); }
__device__ __forceinline__ unsigned xb_add(unsigned* p, unsigned v) { return __hip_atomic_fetch_add(p, v, __ATOMIC_RELAXED, __HIP_MEMORY_SCOPE_AGENT); }
__device__ __forceinline__ unsigned xb_xcc_id() { return (unsigned)__builtin_amdgcn_s_getreg((3 << 11) | 20) & 0xFu; }
#define XB_SPIN(cond, bar) do { unsigned _sp = 0; while (cond) { __builtin_amdgcn_s_sleep(1); \
    if ((++_sp & 255u) == 0u) { if (xb_ld(&(bar)[XB_TMO])) break; if (_sp > XB_SPIN_CAP) { atomicAdd(&(bar)[XB_TMO], 1u); break; } } } } while (0)

struct XcdBarrier {
    unsigned* bar; unsigned x;
    volatile LAS unsigned* st;
};
__device__ __forceinline__ XcdBarrier xcd_barrier_post(unsigned* bar, volatile LAS unsigned* st) {
    XcdBarrier b; b.bar = bar; b.x = xb_xcc_id(); b.st = st;
    if (threadIdx.x == 0) (void)xb_add(&bar[XB_XCNT(b.x)], 1u);
    return b;
}
__device__ __forceinline__ void xcd_barrier_complete(unsigned* bar, unsigned x, unsigned& nloc, unsigned& nx) {
    const unsigned G = gridDim.x * gridDim.y * gridDim.z;
    unsigned sum, cnt, mine, sp = 0u;
    for (;;) {
        sum = 0u; cnt = 0u; mine = 0u;
#pragma unroll
        for (unsigned j = 0; j < 16; ++j) { const unsigned c = xb_ld(&bar[XB_XCNT(j)]); sum += c; cnt += (c > 0u) ? 1u : 0u; mine = (j == x) ? c : mine; }
        if (sum == G) break;
        __builtin_amdgcn_s_sleep(1);
        if ((++sp & 255u) == 0u) { if (xb_ld(&bar[XB_TMO])) break; if (sp > XB_SPIN_CAP) { atomicAdd(&bar[XB_TMO], 1u); break; } }
    }
    nloc = mine > 0u ? mine : 1u; nx = cnt > 0u ? cnt : 1u;
}
__device__ __forceinline__ void xcd_barrier(const XcdBarrier& b) {
    asm volatile("s_waitcnt vmcnt(0)" ::: "memory");
    __syncthreads();
    if (threadIdx.x == 0) {
        unsigned* bar = b.bar;
        __builtin_amdgcn_s_waitcnt(0);
        unsigned nloc = b.st[0], nx = b.st[1];
        if (nloc == 0u) { xcd_barrier_complete(bar, b.x, nloc, nx); b.st[0] = nloc; b.st[1] = nx; }
        const unsigned old = xb_add(&bar[XB_XSUB(b.x)], 1u);
        const unsigned gen = old / nloc;
        if (old + 1u == (gen + 1u) * nloc) {
            __builtin_amdgcn_fence(__ATOMIC_RELEASE, "agent");
            asm volatile("s_waitcnt vmcnt(0)" ::: "memory");
            const unsigned og = xb_add(&bar[XB_TOP], 1u);
            const unsigned tg = og / nx;
            if (og + 1u == (tg + 1u) * nx) xb_add(&bar[XB_TOPGEN], 1u);
            else XB_SPIN(xb_ld(&bar[XB_TOPGEN]) == tg, bar);
            __builtin_amdgcn_fence(__ATOMIC_ACQUIRE, "agent");
            xb_add(&bar[XB_XGEN(b.x)], 1u);
            asm volatile("s_waitcnt vmcnt(0)" ::: "memory");
        } else {
            XB_SPIN(xb_ld(&bar[XB_XGEN(b.x)]) == gen, bar);
            __builtin_amdgcn_fence(__ATOMIC_ACQUIRE, "agent");
            asm volatile("s_waitcnt vmcnt(0)" ::: "memory");
        }
    }
    __syncthreads();
}

using pg8::Unit; using pg8::BM; using pg8::HALF;
struct EpiIn0 {
    static constexpr bool PERM = true;
    bf16* O;
    DI void operator()(const f32x4 (&acc)[2][2][4][2], const Unit& u, int wr, int wc, int fr, int fq) const {
        const int row0 = u.pm * BM + wr * 64 + fr; const int t = u.pn >> 2; const int colt = (u.pn & 3) * BM;
        bf16* base = O + (size_t)t * R2_T; const int col0 = colt + wc * 32 + 8 * fq; const bool act = t < 2;
#pragma unroll
        for (int ai = 0; ai < 2; ++ai)
#pragma unroll
            for (int m = 0; m < 4; ++m) { bf16* rowp = base + (size_t)(row0 + ai * HALF + m * 16) * 1024 + col0;
#pragma unroll
                for (int bj = 0; bj < 2; ++bj) { f32x4 v0 = acc[ai][bj][m][0], v1 = acc[ai][bj][m][1];
                    if (act) {
#pragma unroll
                        for (int j = 0; j < 4; ++j) { v0[j] = gelu_tanh(v0[j]); v1[j] = gelu_tanh(v1[j]); } }
                    v4u w; w.x = pk2(v0[0], v0[1]); w.y = pk2(v0[2], v0[3]); w.z = pk2(v1[0], v1[1]); w.w = pk2(v1[2], v1[3]);
                    *(v4u*)(rowp + bj * HALF) = w; } }
    }
};
struct EpiResid {
    static constexpr bool PERM = false;
    const float* base; float* out; const float* gate0;
    DI void operator()(const f32x4 (&acc)[2][2][4][2], const Unit& u, int wr, int wc, int fr, int fq) const {
        const int row0 = u.pm * BM + wr * 64 + fr, col0 = u.pn * BM + wc * 32 + 4 * fq;
        const float* gate = gate0 + (size_t)((u.pm * BM) >> 14) * 12288;
        f32x4 gv[2][2];
#pragma unroll
        for (int bj = 0; bj < 2; ++bj)
#pragma unroll
            for (int n = 0; n < 2; ++n) gv[bj][n] = *(const f32x4*)(gate + col0 + bj * HALF + n * 16);
#pragma unroll
        for (int ai = 0; ai < 2; ++ai)
#pragma unroll
            for (int m = 0; m < 4; ++m) { const size_t off = (size_t)(row0 + ai * HALF + m * 16) * D + col0;
#pragma unroll
                for (int bj = 0; bj < 2; ++bj)
#pragma unroll
                    for (int n = 0; n < 2; ++n) { const f32x4 bs = *(const f32x4*)(base + off + bj * HALF + n * 16);
                        *(f32x4*)(out + off + bj * HALF + n * 16) = bs + gv[bj][n] * acc[ai][bj][m][n]; } }
    }
};
template <bool F8>
struct EpiSwiglu {
    static constexpr bool PERM = true;
    void* O;
    DI void operator()(const f32x4 (&acc)[2][2][4][2], const Unit& u, int wr, int wc, int fr, int fq) const {
        const int row0 = u.pm * BM + wr * 64 + fr, col0 = u.pn * HALF + wc * 32 + 8 * fq;
        const float sc = F8 ? F8_WINV : 1.0f;
#pragma unroll
        for (int ai = 0; ai < 2; ++ai)
#pragma unroll
            for (int m = 0; m < 4; ++m) { const size_t eo = (size_t)(row0 + ai * HALF + m * 16) * FF + col0;
                f32x4 g0 = acc[ai][0][m][0] * sc, g1 = acc[ai][0][m][1] * sc; const f32x4 u0 = acc[ai][1][m][0] * sc, u1 = acc[ai][1][m][1] * sc;
#pragma unroll
                for (int j = 0; j < 4; ++j) { g0[j] = siluf_(g0[j]) * u0[j]; g1[j] = siluf_(g1[j]) * u1[j]; }
                if constexpr (F8) { v2u w; w.x = pk4_fp8(g0[0], g0[1], g0[2], g0[3]); w.y = pk4_fp8(g1[0], g1[1], g1[2], g1[3]); *(v2u*)((unsigned char*)O + eo) = w; }
                else { v4u w; w.x = pk2(g0[0], g0[1]); w.y = pk2(g0[2], g0[3]); w.z = pk2(g1[0], g1[1]); w.w = pk2(g1[2], g1[3]); *(v4u*)((bf16*)O + eo) = w; } }
    }
};
struct EpiPlain {
    static constexpr bool PERM = true;
    bf16* O; int ldc; float sc;
    DI void operator()(const f32x4 (&acc)[2][2][4][2], const Unit& u, int wr, int wc, int fr, int fq) const {
        const int row0 = u.pm * BM + wr * 64 + fr, col0 = u.pn * BM + wc * 32 + 8 * fq;
#pragma unroll
        for (int ai = 0; ai < 2; ++ai)
#pragma unroll
            for (int m = 0; m < 4; ++m) { bf16* rowp = O + (size_t)(row0 + ai * HALF + m * 16) * ldc + col0;
#pragma unroll
                for (int bj = 0; bj < 2; ++bj) { const f32x4 v0 = acc[ai][bj][m][0] * sc, v1 = acc[ai][bj][m][1] * sc;
                    v4u w; w.x = pk2(v0[0], v0[1]); w.y = pk2(v0[2], v0[3]); w.z = pk2(v1[0], v1[1]); w.w = pk2(v1[2], v1[3]);
                    *(v4u*)(rowp + bj * HALF) = w; } }
    }
};
struct EpiCin {
    static constexpr bool PERM = true;
    bf16* BG; bf16* CZ;
    DI void operator()(const f32x4 (&acc)[2][2][4][2], const Unit& u, int wr, int wc, int fr, int fq) const {
        const int row0 = u.pm * BM + wr * 64 + fr;
        if (u.pn < 8) {
            const int col0 = u.pn * BM + wc * 32 + 8 * fq;
#pragma unroll
            for (int ai = 0; ai < 2; ++ai)
#pragma unroll
                for (int m = 0; m < 4; ++m) { bf16* rowp = BG + (size_t)(row0 + ai * HALF + m * 16) * D + col0;
#pragma unroll
                    for (int bj = 0; bj < 2; ++bj) { const f32x4 v0 = acc[ai][bj][m][0], v1 = acc[ai][bj][m][1];
                        v4u w; w.x = pk2(v0[0], v0[1]); w.y = pk2(v0[2], v0[3]); w.z = pk2(v1[0], v1[1]); w.w = pk2(v1[2], v1[3]);
                        *(v4u*)(rowp + bj * HALF) = w; } }
        } else {
            const int col0 = (u.pn - 8) * HALF + wc * 32 + 8 * fq;
#pragma unroll
            for (int ai = 0; ai < 2; ++ai)
#pragma unroll
                for (int m = 0; m < 4; ++m) { bf16* rowp = CZ + (size_t)(row0 + ai * HALF + m * 16) * D + col0;
                    const f32x4 p0 = acc[ai][0][m][0] * acc[ai][1][m][0], p1 = acc[ai][0][m][1] * acc[ai][1][m][1];
                    v4u w; w.x = pk2(p0[0], p0[1]); w.y = pk2(p0[2], p0[3]); w.z = pk2(p1[0], p1[1]); w.w = pk2(p1[2], p1[3]);
                    *(v4u*)rowp = w; }
        }
    }
};

DI unsigned off_b(unsigned row, unsigned ch) { return 256u * row + 16u * (ch ^ (((row & 3) << 2) | ((row >> 2) & 3))); }
DI bf16x8 row_frag(const LAS unsigned char* img, int lane, int s) { return *(const LAS bf16x8*)(img + off_b(lane & 31, 2 * s + (lane >> 5))); }
template <bool KROW>
DI bf16x8 tr_frag(const LAS unsigned char* img, int lane, int c, int ks) {
    const unsigned h = lane >> 5, blk = (lane >> 4) & 1, q = (lane & 15) >> 2, p = lane & 3;
    const unsigned r0 = KROW ? (16 * ks + 4 * h + q) : (16 * ks + 8 * h + q), r1 = KROW ? (r0 + 8) : (r0 + 4);
    const unsigned ch = 4 * c + 2 * blk + (p >> 1), sub = 8 * (p & 1);
    const s16x4 lo = __builtin_amdgcn_ds_read_tr16_b64_v4i16((LAS s16x4*)(img + off_b(r0, ch) + sub));
    const s16x4 hi = __builtin_amdgcn_ds_read_tr16_b64_v4i16((LAS s16x4*)(img + off_b(r1, ch) + sub));
    return __builtin_shufflevector(lo, hi, 0, 1, 2, 3, 4, 5, 6, 7);
}
DI int crow(int reg, int h) { return (reg & 3) + 8 * (reg >> 2) + 4 * h; }
#define MFMA32(a, b, c) __builtin_amdgcn_mfma_f32_32x32x16_bf16((a), (b), (c), 0, 0, 0)

struct Params { const float* in[23]; float* out; unsigned char* ws; int ph_lo, ph_hi, li, pad; };
enum { I_X = 0, I_C, I_CTX, I_CCTX, I_ADAW, I_ADAB, I_N1G, I_N2G, I_ABWIN, I_ABWOUT, I_AWS, I_ABS, I_AVG, I_BQG, I_BKG, I_RPB, I_CWIN, I_CONVW, I_CWOUT, I_ROUTER, I_WGATE, I_WUP, I_WDOWN };

template <bool F8>
DI void xpose_item(const float* __restrict__ W, int N, bf16* __restrict__ WT, int Kd, int k0, int n0, int dstrow0, LAS float* scr, int lane) {
    const GAS f32x4* src = (const GAS f32x4*)(W + (size_t)k0 * N + n0);
    const int lr = lane >> 4, lc = lane & 15;
    f32x4 v[16];
#pragma unroll
    for (int i = 0; i < 16; ++i) v[i] = src[(size_t)(lr + 4 * i) * (N / 4) + lc];
#pragma unroll
    for (int i = 0; i < 16; ++i) { LAS float* d = scr + (lr + 4 * i) * 65 + 4 * lc; d[0] = v[i].x; d[1] = v[i].y; d[2] = v[i].z; d[3] = v[i].w; }
    LDS_WAIT(); asm volatile("" ::: "memory");
    if constexpr (F8) {
        const int c = lane & 3;
#pragma unroll
        for (int i = 0; i < 4; ++i) { const int n = 16 * i + (lane >> 2); const LAS float* s = scr + (16 * c) * 65 + n;
            v4u o;
            o.x = pk4_fp8(s[0 * 65] * F8_WSCALE, s[1 * 65] * F8_WSCALE, s[2 * 65] * F8_WSCALE, s[3 * 65] * F8_WSCALE); o.y = pk4_fp8(s[4 * 65] * F8_WSCALE, s[5 * 65] * F8_WSCALE, s[6 * 65] * F8_WSCALE, s[7 * 65] * F8_WSCALE);
            o.z = pk4_fp8(s[8 * 65] * F8_WSCALE, s[9 * 65] * F8_WSCALE, s[10 * 65] * F8_WSCALE, s[11 * 65] * F8_WSCALE); o.w = pk4_fp8(s[12 * 65] * F8_WSCALE, s[13 * 65] * F8_WSCALE, s[14 * 65] * F8_WSCALE, s[15 * 65] * F8_WSCALE);
            *(GAS v4u*)((unsigned char*)WT + (size_t)(dstrow0 + n) * Kd + k0 + 16 * c) = o; }
    } else {
    const int c = lane & 7;
#pragma unroll
    for (int i = 0; i < 8; ++i) { const int n = 8 * i + (lane >> 3); const LAS float* s = scr + (8 * c) * 65 + n;
        v4u o; o.x = pk2(s[0 * 65], s[1 * 65]); o.y = pk2(s[2 * 65], s[3 * 65]); o.z = pk2(s[4 * 65], s[5 * 65]); o.w = pk2(s[6 * 65], s[7 * 65]);
        *(GAS v4u*)(WT + (size_t)(dstrow0 + n) * Kd + k0 + 8 * c) = o; }
    }
    LDS_WAIT(); asm volatile("" ::: "memory");
}
DI int ilv_row(int j, int hv) { return ((j >> 7) << 8) + hv * 128 + (j & 127); }

#define F8L(l) ((l) == 0 ? (MK_FP8_L0 != 0) : (MK_FP8_L1 != 0))
DI void phase_prologue(const Params& P, LAS unsigned char* lds, int tid, int lane, int wave) {
    unsigned char* ws = P.ws;
    for (int u = blockIdx.x; u < 192; u += gridDim.x) {
        const int l = u / 96, cb = u % 96;
        LAS float* sv = (LAS float*)(lds + LDS_SCR);
        LAS float* part = (LAS float*)(lds + LDS_SCR + 24576);
        for (int i = tid; i < 3 * 2048; i += 512) { const int r = i >> 11, k = i & 2047; const float c = r < 2 ? P.in[I_C][r * 2048 + k] : P.in[I_CCTX][k]; sv[i] = c / (1.0f + __expf(-c)); }
        __syncthreads();
        const int col4 = tid & 31, ks = tid >> 5;
        const GAS f32x4* w = (const GAS f32x4*)(P.in[I_ADAW] + (size_t)l * 2048 * 12288 + (size_t)(ks * 128) * 12288 + cb * 128) + col4;
        f32x4 a0 = {0.f, 0.f, 0.f, 0.f}, a1 = a0, a2 = a0;
#pragma unroll 8
        for (int k = 0; k < 128; ++k) { const f32x4 wv = w[(size_t)k * (12288 / 4)]; const int kk = ks * 128 + k;
            a0 += wv * sv[kk]; a1 += wv * sv[2048 + kk]; a2 += wv * sv[4096 + kk]; }
        *(LAS f32x4*)(part + (ks * 3 + 0) * 128 + 4 * col4) = a0; *(LAS f32x4*)(part + (ks * 3 + 1) * 128 + 4 * col4) = a1; *(LAS f32x4*)(part + (ks * 3 + 2) * 128 + 4 * col4) = a2;
        __syncthreads();
        if (tid < 384) { const int r = tid >> 7, cc = tid & 127; float s = P.in[I_ADAB][l * 12288 + cb * 128 + cc];
#pragma unroll
            for (int q = 0; q < 16; ++q) s += part[(q * 3 + r) * 128 + cc];
            ((float*)(ws + WS_MOD))[(size_t)(l * 3 + r) * 12288 + cb * 128 + cc] = s; }
        __syncthreads();
    }
    { const float* src = P.in[I_AWS]; bf16* dst = (bf16*)(ws + WS_WSB);
      for (int i = blockIdx.x * 512 + tid; i < 8 * 128 * 128 / 2; i += gridDim.x * 512) { const float a = src[2 * i], b = src[2 * i + 1]; ((unsigned*)dst)[i] = pk2(a, b); } }
    LAS float* scr = (LAS float*)(lds + LDS_SCR + wave * 16640);
    const int gw = blockIdx.x * NWAVES + wave, NGW = gridDim.x * NWAVES;
    constexpr int I0 = 32 * 80, I1 = 32 * 32, I2 = 32 * 96, I3 = 32 * 32, IM = 512, I4 = 32 * IM, NITEMS = I0 + I1 + I2 + I3 + 3 * I4;
    for (int it = gw; it < NITEMS; it += NGW) {
        int r = it;
        if (r < I0) { const int kb = r / 80, nb = r % 80; xpose_item<false>(P.in[I_ABWIN], 5120, (bf16*)(ws + WS_WIN0), 2048, kb * 64, nb * 64, nb * 64, scr, lane); continue; } r -= I0;
        if (r < I1) { const int kb = r / 32, nb = r % 32; xpose_item<false>(P.in[I_ABWOUT], 2048, (bf16*)(ws + WS_WOUT0), 2048, kb * 64, nb * 64, nb * 64, scr, lane); continue; } r -= I1;
        if (r < I2) { const int kb = r / 96, nb = r % 96; const int n0 = nb * 64;
            const int drow = n0 < 2048 ? n0 : (n0 < 4096 ? 2048 + ilv_row(n0 - 2048, 0) : 2048 + ilv_row(n0 - 4096, 1));
            xpose_item<false>(P.in[I_CWIN], 6144, (bf16*)(ws + WS_WCIN), 2048, kb * 64, n0, drow, scr, lane); continue; } r -= I2;
        if (r < I3) { const int kb = r / 32, nb = r % 32; xpose_item<false>(P.in[I_CWOUT], 2048, (bf16*)(ws + WS_WCOUT), 2048, kb * 64, nb * 64, nb * 64, scr, lane); continue; } r -= I3;
        if (r < I4) { const int mt = r / IM, q = r % IM, kb = q / 16, nb = q % 16;
            if (F8L(mt >> 4)) xpose_item<true>(P.in[I_WGATE] + (size_t)mt * 2048 * 1024, 1024, (bf16*)(ws + WS_GU + (size_t)(mt >> 4) * 16 * 2048 * 2048 * 2 + (size_t)(mt & 15) * 2048 * 2048), 2048, kb * 64, nb * 64, ilv_row(nb * 64, 0), scr, lane);
            else xpose_item<false>(P.in[I_WGATE] + (size_t)mt * 2048 * 1024, 1024, (bf16*)(ws + WS_GU) + (size_t)mt * 2048 * 2048, 2048, kb * 64, nb * 64, ilv_row(nb * 64, 0), scr, lane);
            continue; } r -= I4;
        if (r < I4) { const int mt = r / IM, q = r % IM, kb = q / 16, nb = q % 16;
            if (F8L(mt >> 4)) xpose_item<true>(P.in[I_WUP] + (size_t)mt * 2048 * 1024, 1024, (bf16*)(ws + WS_GU + (size_t)(mt >> 4) * 16 * 2048 * 2048 * 2 + (size_t)(mt & 15) * 2048 * 2048), 2048, kb * 64, nb * 64, ilv_row(nb * 64, 1), scr, lane);
            else xpose_item<false>(P.in[I_WUP] + (size_t)mt * 2048 * 1024, 1024, (bf16*)(ws + WS_GU) + (size_t)mt * 2048 * 2048, 2048, kb * 64, nb * 64, ilv_row(nb * 64, 1), scr, lane);
            continue; } r -= I4;
        { const int mt = r / IM, q = r % IM, kb = q / 32, nb = q % 32;
            if (F8L(mt >> 4)) xpose_item<true>(P.in[I_WDOWN] + (size_t)mt * 1024 * 2048, 2048, (bf16*)(ws + WS_DN + (size_t)(mt >> 4) * 16 * 2048 * 1024 * 2 + (size_t)(mt & 15) * 2048 * 1024), 1024, kb * 64, nb * 64, nb * 64, scr, lane);
            else xpose_item<false>(P.in[I_WDOWN] + (size_t)mt * 1024 * 2048, 2048, (bf16*)(ws + WS_DN) + (size_t)mt * 2048 * 1024, 1024, kb * 64, nb * 64, nb * 64, scr, lane); }
    }
}

DI void norm_mod_row(f32x4 (&v)[8], const float* __restrict__ g, const float* __restrict__ shift, const float* __restrict__ scale, int lane) {
    float ss = 0.f;
#pragma unroll
    for (int j = 0; j < 8; ++j) ss += (v[j].x * v[j].x + v[j].y * v[j].y) + (v[j].z * v[j].z + v[j].w * v[j].w);
    const float rstd = 1.0f / sqrtf(wave_sum(ss) * (1.0f / D) + EPS);
#pragma unroll
    for (int j = 0; j < 8; ++j) { const int c = 256 * j + 4 * lane; const f32x4 gg = *(const f32x4*)(g + c), sc = *(const f32x4*)(scale + c), sh = *(const f32x4*)(shift + c);
        v[j] = (v[j] * rstd * gg) * (1.0f + sc) + sh; }
}
DI void store_row_bf16(bf16* __restrict__ orow, const f32x4 (&v)[8], int lane) {
    GAS v2u* o = (GAS v2u*)orow + lane;
#pragma unroll
    for (int j = 0; j < 8; ++j) { v2u w; w.x = pk2(v[j].x, v[j].y); w.y = pk2(v[j].z, v[j].w); o[64 * j] = w; }
}
DI void store_row_fp8(unsigned char* __restrict__ orow, const f32x4 (&v)[8], int lane) {
    GAS unsigned* o = (GAS unsigned*)orow + lane;
#pragma unroll
    for (int j = 0; j < 8; ++j) o[64 * j] = pk4_fp8(v[j].x, v[j].y, v[j].z, v[j].w);
}
DI void load_row_f32(f32x4 (&v)[8], const float* __restrict__ xrow, int lane) {
    const GAS f32x4* xr = (const GAS f32x4*)xrow + lane;
#pragma unroll
    for (int j = 0; j < 8; ++j) v[j] = xr[64 * j];
}

DI void phase_norm1_l0(const Params& P, int lane, int wave) {
    const float* mod = (const float*)(P.ws + WS_MOD); bf16* H = (bf16*)(P.ws + WS_H);
    const int gw = blockIdx.x * NWAVES + wave, NGW = gridDim.x * NWAVES;
    for (int row = gw; row < MTOT; row += NGW) {
        const float* src = row < NT ? P.in[I_X] + (size_t)row * D : P.in[I_CTX] + (size_t)(row - NT) * D;
        const int r = row < NT ? (row >> 14) : 2;
        const float* m = mod + (size_t)r * 12288;
        f32x4 v[8]; load_row_f32(v, src, lane);
#if MK_STOP < 5
        if (row < NT) { GAS f32x4* o = (GAS f32x4*)(P.out + (size_t)row * D) + lane;
#pragma unroll
            for (int j = 0; j < 8; ++j) o[64 * j] = v[j]; }
#endif
        norm_mod_row(v, P.in[I_N1G], m + 0 * 2048, m + 1 * 2048, lane);
        store_row_bf16(H + (size_t)row * D, v, lane);
    }
}

DI void phase_norm2_router(const Params& P, int layer, LAS unsigned char* lds, int tid, int lane, int wave) {
    const float* mod = (const float*)(P.ws + WS_MOD) + (size_t)layer * 3 * 12288; bf16* H = (bf16*)(P.ws + WS_H);
    float* AFF = (float*)(P.ws + WS_AFF);
    LAS float* wrt = (LAS float*)(lds + LDS_SCR);
    { const GAS f32x4* wr = (const GAS f32x4*)(P.in[I_ROUTER] + (size_t)layer * 2048 * 16);
      for (int i = tid; i < 2048 * 4; i += 512) { const f32x4 w = wr[i]; const int k = i >> 2, e0 = (i & 3) * 4;
          wrt[(e0 + 0) * 2048 + k] = w.x; wrt[(e0 + 1) * 2048 + k] = w.y; wrt[(e0 + 2) * 2048 + k] = w.z; wrt[(e0 + 3) * 2048 + k] = w.w; } }
    __syncthreads();
    const int gw = blockIdx.x * NWAVES + wave, NGW = gridDim.x * NWAVES;
    const float* n2g = P.in[I_N2G] + (size_t)layer * D;
    for (int row = gw; row < NT; row += NGW) {
        const int b = row >> 14, n = row & 16383;
        const float* m = mod + (size_t)b * 12288;
        f32x4 v[8]; load_row_f32(v, P.out + (size_t)row * D, lane);
        norm_mod_row(v, n2g, m + 3 * 2048, m + 4 * 2048, lane);
        if (F8L(layer)) store_row_fp8((unsigned char*)H + (size_t)row * D, v, lane); else store_row_bf16(H + (size_t)row * D, v, lane);
        asm volatile("" ::: "memory");
        float lg[16];
#pragma unroll
        for (int e = 0; e < 16; ++e) lg[e] = 0.f;
#pragma unroll
        for (int j = 0; j < 8; ++j) {
#pragma unroll
            for (int e = 0; e < 16; ++e) { const f32x4 w = *(const LAS f32x4*)(wrt + e * 2048 + 256 * j + 4 * lane);
                lg[e] += (v[j].x * w.x + v[j].y * w.y) + (v[j].z * w.z + v[j].w * w.w); } }
#pragma unroll
        for (int e = 0; e < 16; ++e) lg[e] = wave_sum(lg[e]);
        float mx = lg[0];
#pragma unroll
        for (int e = 1; e < 16; ++e) mx = fmaxf(mx, lg[e]);
        float sum = 0.f;
#pragma unroll
        for (int e = 0; e < 16; ++e) { lg[e] = __expf(lg[e] - mx); sum += lg[e]; }
        const float inv = 1.0f / sum;
        float mine = 0.f;
#pragma unroll
        for (int e = 0; e < 16; ++e) mine = (lane == e) ? lg[e] * inv : mine;
        if (lane < 16) AFF[((size_t)(b * 16 + lane)) * SEQ + n] = mine;
    }
    __syncthreads();
}

DI void phase_topk(const Params& P, int layer, LAS unsigned char* lds, int tid, int lane, int wave) {
    LAS unsigned* vals = (LAS unsigned*)(lds + LDS_SCR);
    LAS int* red = (LAS int*)(lds + LDS_SCR + 65536);
    LAS int* slotctr = (LAS int*)(lds + LDS_SCR + 65536 + 64);
    const unsigned* AFF = (const unsigned*)(P.ws + WS_AFF);
    int* IDX = (int*)(P.ws + WS_IDX);
    unsigned* tokcnt = (unsigned*)(P.ws + (layer ? CTL_TOKCNT1 : CTL_TOKCNT0));
    unsigned long long* toklist = (unsigned long long*)(P.ws + WS_TOKLIST);
    for (int j = blockIdx.x; j < 32; j += gridDim.x) {
        const int b = j >> 4, e = j & 15;
        const unsigned* src = AFF + (size_t)j * SEQ;
#pragma unroll 8
        for (int i = 0; i < 32; ++i) vals[tid + 512 * i] = src[tid + 512 * i];
        if (tid == 0) slotctr[0] = 0;
        __syncthreads();
        int par = 0;
#define TK_COUNT(pred, total) do { int _c = 0; _Pragma("unroll 8") for (int i = 0; i < 32; ++i) { const int idx = tid + 512 * i; const unsigned v = vals[idx]; (void)idx; _c += (pred) ? 1 : 0; } \
        _c = wave_sum_i(_c); if (lane == 0) red[par * 8 + wave] = _c; __syncthreads(); total = 0; _Pragma("unroll") for (int w = 0; w < 8; ++w) total += red[par * 8 + w]; par ^= 1; } while (0)
        unsigned T = 0u;
        for (int bit = 30; bit >= 0; --bit) { const unsigned cand = T | (1u << bit); int total; TK_COUNT(v >= cand, total); if (total >= CAP) T = cand; }
        int ngt; TK_COUNT(v > T, ngt);
        const int need = CAP - ngt;
        int lo = 0, hi = SEQ - 1;
        while (lo < hi) { const int mid = (lo + hi) >> 1; int c; TK_COUNT(v == T && idx <= mid, c); if (c >= need) hi = mid; else lo = mid + 1; }
        const int J = lo;
#undef TK_COUNT
        for (int i = 0; i < 32; ++i) { const int idx = tid + 512 * i; const unsigned v = vals[idx];
            if (v > T || (v == T && idx <= J)) {
                const int slot = __hip_atomic_fetch_add(slotctr, 1, __ATOMIC_RELAXED, __HIP_MEMORY_SCOPE_WORKGROUP);
                IDX[j * CAP + slot] = idx;
                const int tok = b * SEQ + idx; const unsigned rowid = (unsigned)(e * 4096 + b * 2048 + slot);
                const unsigned p = __hip_atomic_fetch_add(tokcnt + tok, 1u, RLX_AGENT);
                toklist[(size_t)tok * 16 + (p & 15u)] = ((unsigned long long)v << 32) | rowid; } }
        __syncthreads();
    }
}

template <bool F8>
DI void phase_gather(const Params& P, int lane, int wave) {
    const int* IDX = (const int*)(P.ws + WS_IDX); const unsigned char* H = (const unsigned char*)(P.ws + WS_H); unsigned char* XS = (unsigned char*)(P.ws + WS_R2);
    const int gw = blockIdx.x * NWAVES + wave, NGW = gridDim.x * NWAVES;
    constexpr int RB = F8 ? D : 2 * D, NV = RB / 1024;
    for (int rowid = gw; rowid < 65536; rowid += NGW) {
        const int e = rowid >> 12, b = (rowid >> 11) & 1, slot = rowid & 2047;
        const int n = IDX[(b * 16 + e) * CAP + slot];
        const GAS v4u* s = (const GAS v4u*)(H + (size_t)(b * SEQ + n) * RB) + lane; GAS v4u* d = (GAS v4u*)(XS + (size_t)rowid * RB) + lane;
        v4u t[NV];
#pragma unroll
        for (int j = 0; j < NV; ++j) t[j] = s[64 * j];
#pragma unroll
        for (int j = 0; j < NV; ++j) d[64 * j] = t[j];
    }
}

template <bool NEXT_NORM>
DI void phase_combine(const Params& P, int layer, int lane, int wave) {
    const float* mod = (const float*)(P.ws + WS_MOD) + (size_t)layer * 3 * 12288;
    const float* modn = (const float*)(P.ws + WS_MOD) + (size_t)(layer + 1) * 3 * 12288;
    const unsigned* tokcnt = (const unsigned*)(P.ws + (layer ? CTL_TOKCNT1 : CTL_TOKCNT0));
    const unsigned long long* toklist = (const unsigned long long*)(P.ws + WS_TOKLIST);
    const bf16* YB = (const bf16*)(P.ws + WS_R3); bf16* H = (bf16*)(P.ws + WS_H);
    const int gw = blockIdx.x * NWAVES + wave, NGW = gridDim.x * NWAVES;
    for (int tok = gw; tok < NT; tok += NGW) {
        const int b = tok >> 14;
        f32x4 v[8]; load_row_f32(v, P.out + (size_t)tok * D, lane);
        int cnt = (int)tokcnt[tok]; cnt = __builtin_amdgcn_readfirstlane(cnt); cnt = cnt > 16 ? 16 : cnt;
        f32x4 a[8];
#pragma unroll
        for (int j = 0; j < 8; ++j) a[j] = (f32x4){0.f, 0.f, 0.f, 0.f};
        for (int p = 0; p < cnt; ++p) {
            const unsigned long long ent = toklist[(size_t)tok * 16 + p];
            const unsigned rowid = (unsigned)__builtin_amdgcn_readfirstlane((int)(unsigned)ent); const float gate = __uint_as_float((unsigned)__builtin_amdgcn_readfirstlane((int)(unsigned)(ent >> 32)));
            const GAS v2u* y = (const GAS v2u*)(YB + (size_t)rowid * D) + lane;
#pragma unroll
            for (int j = 0; j < 8; ++j) { const v2u w = y[64 * j]; a[j].x += gate * bf_lo(w.x); a[j].y += gate * bf_hi(w.x); a[j].z += gate * bf_lo(w.y); a[j].w += gate * bf_hi(w.y); }
        }
        const float* g2 = mod + (size_t)b * 12288 + 5 * 2048;
        GAS f32x4* o = (GAS f32x4*)(P.out + (size_t)tok * D) + lane;
#pragma unroll
        for (int j = 0; j < 8; ++j) { const f32x4 gg = *(const f32x4*)(g2 + 256 * j + 4 * lane); v[j] += gg * a[j]; o[64 * j] = v[j]; }
        if constexpr (NEXT_NORM) {
            const float* m = modn + (size_t)b * 12288;
            norm_mod_row(v, P.in[I_N1G] + (size_t)(layer + 1) * D, m + 0 * 2048, m + 1 * 2048, lane);
            store_row_bf16(H + (size_t)tok * D, v, lane);
        }
    }
}

DI void phase_knorm(const Params& P, int lane, int wave) {
    bf16* KK = (bf16*)(P.ws + WS_R2) + 3 * R2_T; const float* gk = P.in[I_BKG];
    const int gw = blockIdx.x * NWAVES + wave, NGW = gridDim.x * NWAVES;
    const int d0 = (lane & 7) * 16;
    float gkr[16];
#pragma unroll
    for (int i = 0; i < 16; ++i) gkr[i] = gk[d0 + i];
    for (int row = gw; row < MTOT; row += NGW) {
        GAS v4u* p = (GAS v4u*)(KK + (size_t)row * 1024) + 2 * lane;
        const v4u w0 = p[0], w1 = p[1];
        float f[16];
        f[0] = bf_lo(w0.x); f[1] = bf_hi(w0.x); f[2] = bf_lo(w0.y); f[3] = bf_hi(w0.y); f[4] = bf_lo(w0.z); f[5] = bf_hi(w0.z); f[6] = bf_lo(w0.w); f[7] = bf_hi(w0.w);
        f[8] = bf_lo(w1.x); f[9] = bf_hi(w1.x); f[10] = bf_lo(w1.y); f[11] = bf_hi(w1.y); f[12] = bf_lo(w1.z); f[13] = bf_hi(w1.z); f[14] = bf_lo(w1.w); f[15] = bf_hi(w1.w);
        float ss = 0.f;
#pragma unroll
        for (int i = 0; i < 16; ++i) ss += f[i] * f[i];
        ss += __shfl_xor(ss, 1); ss += __shfl_xor(ss, 2); ss += __shfl_xor(ss, 4);
        const float rstd = 1.0f / sqrtf(ss * (1.0f / 128.0f) + EPS);
#pragma unroll
        for (int i = 0; i < 16; ++i) f[i] = f[i] * rstd * gkr[i];
        v4u o0, o1; o0.x = pk2(f[0], f[1]); o0.y = pk2(f[2], f[3]); o0.z = pk2(f[4], f[5]); o0.w = pk2(f[6], f[7]); o1.x = pk2(f[8], f[9]); o1.y = pk2(f[10], f[11]); o1.z = pk2(f[12], f[13]); o1.w = pk2(f[14], f[15]);
        p[0] = o0; p[1] = o1;
    }
}

DI void phase_gmlp(const Params& P, LAS unsigned char* lds, int tid, int lane, int wave) {
    const bf16* U = (const bf16*)(P.ws + WS_R2); const bf16* V = U + R2_T; const bf16* WSB = (const bf16*)(P.ws + WS_WSB);
    bf16* CAT = (bf16*)(P.ws + WS_R3);
    LAS unsigned char* wimg = lds + LDS_SCR;
    LAS unsigned char* vimg = lds + LDS_SCR + 32768;
    const int ql = lane & 31, hf = lane >> 5;
    for (int u = blockIdx.x; u < 2048; u += gridDim.x) {
        const int g = u & 7, cn = (u >> 3) & 127, b = u >> 10;
        const int tok0 = b * SEQ + cn * 128;
        const float* gv = P.in[I_AVG] + g * 128;
#pragma unroll
        for (int i = 0; i < 4; ++i) { const int cidx = tid + 512 * i, q = cidx >> 4, ch = cidx & 15;
            const v4u raw = *(const GAS v4u*)(V + (size_t)(tok0 + q) * 1024 + g * 128 + ch * 8);
            float f[8]; f[0] = bf_lo(raw.x); f[1] = bf_hi(raw.x); f[2] = bf_lo(raw.y); f[3] = bf_hi(raw.y); f[4] = bf_lo(raw.z); f[5] = bf_hi(raw.z); f[6] = bf_lo(raw.w); f[7] = bf_hi(raw.w);
            float ss = 0.f;
#pragma unroll
            for (int k = 0; k < 8; ++k) ss += f[k] * f[k];
            ss += __shfl_xor(ss, 1); ss += __shfl_xor(ss, 2); ss += __shfl_xor(ss, 4); ss += __shfl_xor(ss, 8);
            const float rstd = 1.0f / sqrtf(ss * (1.0f / 128.0f) + EPS);
            const f32x4 g0 = *(const f32x4*)(gv + ch * 8), g1 = *(const f32x4*)(gv + ch * 8 + 4);
            v4u o; o.x = pk2(f[0] * rstd * g0.x, f[1] * rstd * g0.y); o.y = pk2(f[2] * rstd * g0.z, f[3] * rstd * g0.w); o.z = pk2(f[4] * rstd * g1.x, f[5] * rstd * g1.y); o.w = pk2(f[6] * rstd * g1.z, f[7] * rstd * g1.w);
            *(LAS v4u*)(vimg + (q >> 5) * 8192 + off_b(q & 31, ch)) = o;
            const v4u wraw = *(const GAS v4u*)(WSB + (size_t)(g * 128 + q) * 128 + ch * 8);
            *(LAS v4u*)(wimg + (q >> 5) * 8192 + off_b(q & 31, ch)) = wraw; }
        __syncthreads();
        const int cb = wave & 3, pb0 = 2 * (wave >> 2);
        f32x16 acc0, acc1;
#pragma unroll
        for (int i = 0; i < 16; ++i) { acc0[i] = 0.f; acc1[i] = 0.f; }
#pragma unroll
        for (int ks = 0; ks < 8; ++ks) {
            const bf16x8 a = tr_frag<false>(vimg + (ks >> 1) * 8192, lane, cb, ks & 1);
            const bf16x8 b0 = row_frag(wimg + (pb0 + 0) * 8192, lane, ks), b1 = row_frag(wimg + (pb0 + 1) * 8192, lane, ks);
            acc0 = MFMA32(a, b0, acc0); acc1 = MFMA32(a, b1, acc1);
        }
#pragma unroll
        for (int x = 0; x < 2; ++x) { const int p = 32 * (pb0 + x) + ql; const int tok = tok0 + p; const float bs = P.in[I_ABS][g * 128 + p];
#pragma unroll
            for (int rq = 0; rq < 4; ++rq) { const int c = 32 * cb + 8 * rq + 4 * hf;
                const v2u uu = *(const GAS v2u*)(U + (size_t)tok * 1024 + g * 128 + c);
                const float s0 = (x ? acc1[4 * rq + 0] : acc0[4 * rq + 0]) + bs, s1 = (x ? acc1[4 * rq + 1] : acc0[4 * rq + 1]) + bs, s2 = (x ? acc1[4 * rq + 2] : acc0[4 * rq + 2]) + bs, s3 = (x ? acc1[4 * rq + 3] : acc0[4 * rq + 3]) + bs;
                v2u o; o.x = pk2(bf_lo(uu.x) * s0, bf_hi(uu.x) * s1); o.y = pk2(bf_lo(uu.y) * s2, bf_hi(uu.y) * s3);
                *(GAS v2u*)(CAT + (size_t)tok * D + g * 128 + c) = o; } }
        __syncthreads();
    }
}

DI void phase_attn(const Params& P, LAS unsigned char* lds, int tid, int lane, int wave) {
    const bf16* Qb = (const bf16*)(P.ws + WS_R2) + 2 * R2_T; const bf16* KK = Qb + R2_T; const bf16* VV = KK + R2_T;
    bf16* CAT = (bf16*)(P.ws + WS_R3);
    LAS unsigned char* kbuf = lds + LDS_SCR;
    LAS unsigned char* vbuf = lds + LDS_SCR + 32768;
    LAS float* rpbL = (LAS float*)(lds + LDS_SCR + 65536);
    const int ql = lane & 31, hf = lane >> 5;
    const float* gq = P.in[I_BQG];
    for (int u = blockIdx.x; u < 1024; u += gridDim.x) {
        const int h = u & 7, rg = (u >> 3) & 63, b = u >> 9;
        const int qr = 4 * rg + (wave >> 1), qc = 32 * (wave & 1) + ql;
        const int tq = b * SEQ + qr * GRIDW + qc;
        bf16x8 Qf[8];
        { v4u raw[8]; float ss = 0.f;
#pragma unroll
          for (int s = 0; s < 8; ++s) { raw[s] = *(const GAS v4u*)(Qb + (size_t)tq * 1024 + h * 128 + 16 * s + 8 * hf);
              const float a0 = bf_lo(raw[s].x), a1 = bf_hi(raw[s].x), a2 = bf_lo(raw[s].y), a3 = bf_hi(raw[s].y), a4 = bf_lo(raw[s].z), a5 = bf_hi(raw[s].z), a6 = bf_lo(raw[s].w), a7 = bf_hi(raw[s].w);
              ss += (a0 * a0 + a1 * a1) + (a2 * a2 + a3 * a3) + (a4 * a4 + a5 * a5) + (a6 * a6 + a7 * a7); }
          ss += __shfl_xor(ss, 32);
          const float qs = (1.0f / sqrtf(ss * (1.0f / 128.0f) + EPS)) * (0.08838834764831845f * LOG2E);
#pragma unroll
          for (int s = 0; s < 8; ++s) { const f32x4 g0 = *(const f32x4*)(gq + 16 * s + 8 * hf), g1 = *(const f32x4*)(gq + 16 * s + 8 * hf + 4);
              v4u o; o.x = pk2(bf_lo(raw[s].x) * qs * g0.x, bf_hi(raw[s].x) * qs * g0.y); o.y = pk2(bf_lo(raw[s].y) * qs * g0.z, bf_hi(raw[s].y) * qs * g0.w);
              o.z = pk2(bf_lo(raw[s].z) * qs * g1.x, bf_hi(raw[s].z) * qs * g1.y); o.w = pk2(bf_lo(raw[s].w) * qs * g1.z, bf_hi(raw[s].w) * qs * g1.w);
              Qf[s] = __builtin_bit_cast(bf16x8, o); } }
        if (tid < 465) rpbL[tid] = P.in[I_RPB][h * 465 + tid] * LOG2E;
        const int rs_q = min(max(qr - 4, 0), NROWS - 8);
        const int krlo = min(max(4 * rg - 4, 0), NROWS - 8), krhi = min(max(4 * rg + 3 - 4, 0), NROWS - 8) + 7, ntl = krhi - krlo + 1, T = ntl + 4;
        const int cs = min(max(qc - 8, 0), GRIDW - 16);
        f32x16 O[4];
#pragma unroll
        for (int db = 0; db < 4; ++db)
#pragma unroll
            for (int i = 0; i < 16; ++i) O[db][i] = 0.f;
        float m_run = -1e30f, l_run = 0.f;
        v4u kreg[2], vreg[2];
#define ATT_LOAD(t) do { const int _tb = (t) < ntl ? b * SEQ + (krlo + (t)) * GRIDW : NT + b * CTXL + 64 * ((t) - ntl); \
        _Pragma("unroll") for (int _i = 0; _i < 2; ++_i) { const int _c = tid + 512 * _i, _key = _c >> 4, _ch = _c & 15; const size_t _o = (size_t)(_tb + _key) * 1024 + h * 128 + _ch * 8; \
            kreg[_i] = *(const GAS v4u*)(KK + _o); vreg[_i] = *(const GAS v4u*)(VV + _o); } } while (0)
#define ATT_STORE(buf) do { _Pragma("unroll") for (int _i = 0; _i < 2; ++_i) { const int _c = tid + 512 * _i, _key = _c >> 4, _ch = _c & 15; const unsigned _o = (buf) * 16384 + (_key >> 5) * 8192 + off_b(_key & 31, _ch); \
            *(LAS v4u*)(kbuf + _o) = kreg[_i]; *(LAS v4u*)(vbuf + _o) = vreg[_i]; } } while (0)
        ATT_LOAD(0); ATT_STORE(0);
        __syncthreads();
        for (int t = 0; t < T; ++t) {
            if (t + 1 < T) ATT_LOAD(t + 1);
            const bool local = t < ntl; const int kr = krlo + t;
            const bool active = !local || (kr >= rs_q && kr <= rs_q + 7);
            if (active) {
                const LAS unsigned char* kb_ = kbuf + (t & 1) * 16384; const LAS unsigned char* vb_ = vbuf + (t & 1) * 16384;
                f32x16 S0, S1;
#pragma unroll
                for (int i = 0; i < 16; ++i) { S0[i] = 0.f; S1[i] = 0.f; }
#pragma unroll
                for (int s = 0; s < 8; ++s) { const bf16x8 a0 = row_frag(kb_, lane, s), a1 = row_frag(kb_ + 8192, lane, s); S0 = MFMA32(a0, Qf[s], S0); S1 = MFMA32(a1, Qf[s], S1); }
                if (local) {
                    const int dr = kr - qr + 7;
#pragma unroll
                    for (int r = 0; r < 16; ++r) { const int kc0 = crow(r, hf), kc1 = 32 + kc0;
                        { const bool ok = (unsigned)(kc0 - cs) < 16u; const int ci = min(max(kc0 - qc + 15, 0), 30); const float bia = rpbL[dr * 31 + ci]; S0[r] = ok ? S0[r] + bia : -1e30f; }
                        { const bool ok = (unsigned)(kc1 - cs) < 16u; const int ci = min(max(kc1 - qc + 15, 0), 30); const float bia = rpbL[dr * 31 + ci]; S1[r] = ok ? S1[r] + bia : -1e30f; } }
                }
                float mt = S0[0];
#pragma unroll
                for (int r = 1; r < 16; ++r) mt = fmaxf(mt, S0[r]);
#pragma unroll
                for (int r = 0; r < 16; ++r) mt = fmaxf(mt, S1[r]);
                mt = fmaxf(mt, __shfl_xor(mt, 32));
                const float m_new = fmaxf(m_run, mt), alpha = fast_exp2(m_run - m_new);
                m_run = m_new;
                float ps = 0.f;
#pragma unroll
                for (int r = 0; r < 16; ++r) { S0[r] = fast_exp2(S0[r] - m_new); S1[r] = fast_exp2(S1[r] - m_new); ps += S0[r] + S1[r]; }
                l_run = l_run * alpha + ps;
#pragma unroll
                for (int db = 0; db < 4; ++db)
#pragma unroll
                    for (int i = 0; i < 16; ++i) O[db][i] *= alpha;
#pragma unroll
                for (int kb = 0; kb < 2; ++kb)
#pragma unroll
                    for (int s2 = 0; s2 < 2; ++s2) {
                        v4u pp;
                        if (kb == 0) { pp.x = pk2(S0[8 * s2 + 0], S0[8 * s2 + 1]); pp.y = pk2(S0[8 * s2 + 2], S0[8 * s2 + 3]); pp.z = pk2(S0[8 * s2 + 4], S0[8 * s2 + 5]); pp.w = pk2(S0[8 * s2 + 6], S0[8 * s2 + 7]); }
                        else         { pp.x = pk2(S1[8 * s2 + 0], S1[8 * s2 + 1]); pp.y = pk2(S1[8 * s2 + 2], S1[8 * s2 + 3]); pp.z = pk2(S1[8 * s2 + 4], S1[8 * s2 + 5]); pp.w = pk2(S1[8 * s2 + 6], S1[8 * s2 + 7]); }
                        const bf16x8 pf = __builtin_bit_cast(bf16x8, pp);
#pragma unroll
                        for (int db = 0; db < 4; ++db) { const bf16x8 a = tr_frag<true>(vb_ + kb * 8192, lane, db, s2); O[db] = MFMA32(a, pf, O[db]); }
                    }
            }
            if (t + 1 < T) ATT_STORE((t + 1) & 1);
            __syncthreads();
        }
#undef ATT_LOAD
#undef ATT_STORE
        const float inv = 1.0f / (l_run + __shfl_xor(l_run, 32));
        bf16* orow = CAT + (size_t)tq * D + 1024 + h * 128;
#pragma unroll
        for (int db = 0; db < 4; ++db)
#pragma unroll
            for (int rq = 0; rq < 4; ++rq) { v2u o; o.x = pk2(O[db][4 * rq + 0] * inv, O[db][4 * rq + 1] * inv); o.y = pk2(O[db][4 * rq + 2] * inv, O[db][4 * rq + 3] * inv);
                *(GAS v2u*)(orow + 32 * db + 8 * rq + 4 * hf) = o; }
    }
}

DI void phase_conv(const Params& P, int lane, int wave) {
    const bf16* BG = (const bf16*)(P.ws + WS_R2); const bf16* CZ = BG + (size_t)NT * D; bf16* WC = (bf16*)(P.ws + WS_R3);
    const float* cw = P.in[I_CONVW];
    const int gw = blockIdx.x * NWAVES + wave, NGW = gridDim.x * NWAVES;
    for (int tok = gw; tok < NT; tok += NGW) {
        const int n = tok & (SEQ - 1); const bool hasm = n > 0, hasp = n < SEQ - 1;
        const GAS v2u* bg = (const GAS v2u*)(BG + (size_t)tok * D) + lane; const GAS v2u* z0 = (const GAS v2u*)(CZ + (size_t)tok * D) + lane;
        const GAS v2u* zm = (const GAS v2u*)(CZ + (size_t)(tok - (hasm ? 1 : 0)) * D) + lane; const GAS v2u* zp = (const GAS v2u*)(CZ + (size_t)(tok + (hasp ? 1 : 0)) * D) + lane;
        GAS v2u* o = (GAS v2u*)(WC + (size_t)tok * D) + lane;
        const float fm = hasm ? 1.f : 0.f, fp = hasp ? 1.f : 0.f;
#pragma unroll
        for (int j = 0; j < 8; ++j) { const int c = 256 * j + 4 * lane;
            const f32x4 w0 = *(const f32x4*)(cw + c) * fm, w1 = *(const f32x4*)(cw + D + c), w2 = *(const f32x4*)(cw + 2 * D + c) * fp;
            const v2u b_ = bg[64 * j], a = zm[64 * j], m = z0[64 * j], p = zp[64 * j];
            const float r0 = bf_lo(b_.x) * (w0.x * bf_lo(a.x) + w1.x * bf_lo(m.x) + w2.x * bf_lo(p.x));
            const float r1 = bf_hi(b_.x) * (w0.y * bf_hi(a.x) + w1.y * bf_hi(m.x) + w2.y * bf_hi(p.x));
            const float r2 = bf_lo(b_.y) * (w0.z * bf_lo(a.y) + w1.z * bf_lo(m.y) + w2.z * bf_lo(p.y));
            const float r3 = bf_hi(b_.y) * (w0.w * bf_hi(a.y) + w1.w * bf_hi(m.y) + w2.w * bf_hi(p.y));
            v2u w; w.x = pk2(r0, r1); w.y = pk2(r2, r3); o[64 * j] = w; }
    }
}

constexpr int NPHASE = 21;
__global__ void __launch_bounds__(NWAVES * 64, 2) mega_fwd(Params P) {
    extern __shared__ __attribute__((aligned(16))) unsigned char lds_raw[];
    LAS unsigned char* lds = (LAS unsigned char*)lds_raw;
    volatile LAS unsigned* MISC = (volatile LAS unsigned*)(lds + MISC_OFF);
    const int tid = threadIdx.x, lane = tid & 63, wave = __builtin_amdgcn_readfirstlane(tid >> 6);
    for (int u = tid; u < (LDS_BYTES - LDSCTL_OFF) / 4; u += NWAVES * 64) ((LAS unsigned*)(lds + LDSCTL_OFF))[u] = 0u;
    __syncthreads();
    unsigned* barw = (unsigned*)(P.ws + WS_CTL + CTL_BAR) + (size_t)P.li * XCD_BAR_WORDS;
    XcdBarrier bar; bar.bar = barw; bar.x = 0; bar.st = nullptr;
    const int lo = P.ph_lo, hi = P.ph_hi;
    if (hi - lo > 1) bar = xcd_barrier_post(barw, MISC + 8);
#define IN(k) (lo <= (k) && (k) < hi)
#define RUN(k, ...) do { if (IN(k)) { __VA_ARGS__; if constexpr ((k) == MK_DUP) { __VA_ARGS__; } } } while (0)
#define SEAM(k) do { if (IN(k) && IN((k) + 1)) xcd_barrier(bar); } while (0)
    unsigned char* ws = P.ws;
    const int G = gridDim.x, cid = blockIdx.x;
    const float* MOD = (const float*)(ws + WS_MOD);

    RUN(0, phase_prologue(P, lds, tid, lane, wave); __syncthreads()); SEAM(0);
    RUN(1, phase_norm1_l0(P, lane, wave)); SEAM(1);
#define GEMM_IN0() do { pg8::Gemm g{(const bf16*)(ws + WS_H), (const bf16*)(ws + WS_WIN0), MTOT, 5120, D}; pg8::StaticOrder<false> S; S.init(MTOT, 5120, G, cid); \
        EpiIn0 E{(bf16*)(ws + WS_R2)}; pg8::gemm_phase<EpiIn0, pg8::StaticOrder<false>, true, true>(lds, g, S, E); } while (0)
    RUN(2, GEMM_IN0()); SEAM(2);
    if (IN(3)) phase_knorm(P, lane, wave);
    RUN(3, phase_gmlp(P, lds, tid, lane, wave)); SEAM(3);
    RUN(4, phase_attn(P, lds, tid, lane, wave)); SEAM(4);
#define GEMM_OUT0() do { pg8::Gemm g{(const bf16*)(ws + WS_R3), (const bf16*)(ws + WS_WOUT0), NT, D, D}; pg8::StaticOrder<false> S; S.init(NT, D, G, cid); \
        EpiResid E{P.in[I_X], P.out, MOD + 2 * 2048}; pg8::gemm_phase<EpiResid, pg8::StaticOrder<false>, true, true>(lds, g, S, E); } while (0)
    RUN(5, GEMM_OUT0()); SEAM(5);
#define GEMM_GU(L) do { constexpr bool F8 = F8L(L); pg8::Gemm g{(const bf16*)(ws + WS_R2), (const bf16*)(ws + WS_GU) + (size_t)(L) * 16 * 2048 * 2048, 65536, 2048, F8 ? D / 2 : D}; pg8::StaticOrder<true> S; S.init(65536, 2048, G, cid); \
        EpiSwiglu<F8> E{(void*)((bf16*)(ws + WS_R2) + (size_t)65536 * D)}; pg8::gemm_phase<EpiSwiglu<F8>, pg8::StaticOrder<true>, true, true, F8>(lds, g, S, E); } while (0)
#define GEMM_DN(L) do { constexpr bool F8 = F8L(L); pg8::Gemm g{(const bf16*)(ws + WS_R2) + (size_t)65536 * D, (const bf16*)(ws + WS_DN) + (size_t)(L) * 16 * 2048 * 1024, 65536, 2048, F8 ? FF / 2 : FF}; pg8::StaticOrder<true> S; S.init(65536, 2048, G, cid); \
        EpiPlain E{(bf16*)(ws + WS_R3), D, F8 ? F8_WINV : 1.0f}; pg8::gemm_phase<EpiPlain, pg8::StaticOrder<true>, true, true, F8>(lds, g, S, E); } while (0)
#define MOE_PHASES(L, base) \
    RUN(base + 0, phase_norm2_router(P, L, lds, tid, lane, wave)); SEAM(base + 0); \
    if (IN(base + 1)) { phase_topk(P, L, lds, tid, lane, wave); } SEAM(base + 1); \
    RUN(base + 2, phase_gather<F8L(L)>(P, lane, wave)); SEAM(base + 2); \
    RUN(base + 3, GEMM_GU(L)); SEAM(base + 3); \
    RUN(base + 4, GEMM_DN(L)); SEAM(base + 4);
    MOE_PHASES(0, 6)
    if (IN(11)) { phase_combine<true>(P, 0, lane, wave); } SEAM(11);
#define GEMM_CIN() do { pg8::Gemm g{(const bf16*)(ws + WS_H), (const bf16*)(ws + WS_WCIN), NT, 6144, D}; pg8::StaticOrder<false> S; S.init(NT, 6144, G, cid); \
        EpiCin E{(bf16*)(ws + WS_R2), (bf16*)(ws + WS_R2) + (size_t)NT * D}; pg8::gemm_phase<EpiCin, pg8::StaticOrder<false>, true, true>(lds, g, S, E); } while (0)
    RUN(12, GEMM_CIN()); SEAM(12);
    RUN(13, phase_conv(P, lane, wave)); SEAM(13);
    if (IN(14)) {
        pg8::Gemm g{(const bf16*)(ws + WS_R3), (const bf16*)(ws + WS_WCOUT), NT, D, D}; pg8::StaticOrder<false> S; S.init(NT, D, G, cid);
        EpiResid E{P.out, P.out, MOD + 3 * 12288 + 2 * 2048};
        pg8::gemm_phase<EpiResid, pg8::StaticOrder<false>, true, true>(lds, g, S, E);
    } SEAM(14);
    MOE_PHASES(1, 15)
    if (IN(20)) { phase_combine<false>(P, 1, lane, wave); }
#undef IN
#undef SEAM
}

extern "C" void kernel_launch(void* const* d_in, const int* in_sizes, int n_in, void* d_out, int out_size, void* d_ws, size_t ws_size, hipStream_t stream) {
    static int grid = 0;
    if (grid == 0) {
        if (n_in != 23 || out_size != NT * D || ws_size < WS_END) { fprintf(stderr, "kernel_launch: unexpected shapes (n_in %d out %d ws %zu)\n", n_in, out_size, ws_size); grid = -1; return; }
        int dev = 0, cus = 0, per_cu = 0;
        if (hipGetDevice(&dev) != hipSuccess || hipDeviceGetAttribute(&cus, hipDeviceAttributeMultiprocessorCount, dev) != hipSuccess) { grid = -1; return; }
        if (hipFuncSetAttribute((const void*)mega_fwd, hipFuncAttributeMaxDynamicSharedMemorySize, LDS_BYTES) != hipSuccess) { fprintf(stderr, "kernel_launch: hipFuncSetAttribute failed\n"); grid = -1; return; }
        if (hipOccupancyMaxActiveBlocksPerMultiprocessor(&per_cu, (const void*)mega_fwd, NWAVES * 64, LDS_BYTES) != hipSuccess || per_cu < 1) { fprintf(stderr, "kernel_launch: occupancy query says %d\n", per_cu); }
        (void)hipGetLastError();
        grid = cus;
    }
    if (grid < 0) return;
    (void)hipMemsetAsync((char*)d_ws + WS_CTL, 0, CTL_ZERO_BYTES, stream);
    Params p{};
    for (int i = 0; i < 23; ++i) p.in[i] = (const float*)d_in[i];
    p.out = (float*)d_out; p.ws = (unsigned char*)d_ws; p.pad = 0;
    const int last = MK_STOP < NPHASE - 1 ? MK_STOP : NPHASE - 1;
#if MK_SPLIT
    for (int k = 0; k <= last; ++k) { p.ph_lo = k; p.ph_hi = k + 1; p.li = 0; hipLaunchKernelGGL(mega_fwd, dim3(grid), dim3(NWAVES * 64), LDS_BYTES, stream, p); }
#else
    p.ph_lo = 0; p.ph_hi = last + 1; p.li = 0;
    hipLaunchKernelGGL(mega_fwd, dim3(grid), dim3(NWAVES * 64), LDS_BYTES, stream, p);
#endif
}
```

```cpp
#include <hip/hip_runtime.h>
#include <cstdio>
#include <cstdint>

#ifndef MK_SPLIT
#define MK_SPLIT 0
#endif
#ifndef MK_STOP
#define MK_STOP 99
#endif
#ifndef MK_FP8_L0
#define MK_FP8_L0 1
#endif
#ifndef MK_FP8_L1
#define MK_FP8_L1 1
#endif
#ifndef MK_DUP
#define MK_DUP -1
#endif

namespace pg8 {
#define PG8_LAS __attribute__((address_space(3)))
typedef unsigned short bf16_t;
typedef short bf16x8 __attribute__((ext_vector_type(8)));
typedef float f32x4 __attribute__((ext_vector_type(4)));
typedef unsigned u32x4 __attribute__((ext_vector_type(4)));
constexpr int BM = 256, BK = 64, HALF = 128, HTB = HALF * BK * 2, STAGE_BYTES = 8 * HTB, NXCD = 8, WGM = 8;

__host__ __device__ __forceinline__ int lds_byte(int r, int c) { const int st = (r >> 4) * 2 + (c >> 5), rr = r & 15, cc = c & 31, ob = rr * 64 + cc * 2; return st * 1024 + (ob ^ (((ob >> 9) & 1) << 5)); }
__host__ __device__ __forceinline__ void stage_rc(int b, int& R, int& C) { const int st = b / 1024, sb = b % 1024, swz = sb ^ (((sb >> 9) & 1) << 5); R = (st >> 1) * 16 + swz / 64; C = (st & 1) * 32 + (swz % 64) / 2; }
__host__ __device__ __forceinline__ int perm32(int rho) { const int n = rho >> 4, i = rho & 15; return 8 * (i >> 2) + 4 * n + (i & 3); }

struct Unit { int pm, pn, pb; };
struct Gemm { const bf16_t* A; const bf16_t* Bt; int M, N, K; };

template <bool GROUPED>
struct StaticOrder {
    int nM, nN, nwg, G, c, hot;
    __host__ __device__ void init(int M, int N, int G_, int c_) { nM = M / BM; nN = N / BM; nwg = nM * nN; G = G_; c = c_; hot = 0; }
    __host__ __device__ bool next(int i, Unit& u) const {
        const long L = (long)i * G + c; if (L >= nwg) return false;
        int wgid = (int)L; { const int q = nwg / NXCD, r = nwg % NXCD, xcd = wgid % NXCD, off = wgid / NXCD; wgid = (xcd < r ? xcd * (q + 1) : r * (q + 1) + (xcd - r) * q) + off; }
        const int nig = WGM * nN, gid = wgid / nig, fm = gid * WGM, gsz = (nM - fm) < WGM ? (nM - fm) : WGM;
        u.pm = fm + ((wgid % nig) % gsz); u.pn = (wgid % nig) / gsz;
        u.pb = GROUPED ? ((u.pm >> 4) * 8 + u.pn) : u.pn;
        if (hot) { u.pm = 0; u.pn = 0; u.pb = 0; }
        return true;
    }
    __device__ __forceinline__ void a_ready(const Unit&) const {}
    __device__ __forceinline__ void done(const Unit&) const {}
};

__device__ __forceinline__ unsigned cvt_pk_bf16(float lo, float hi) { unsigned r; asm volatile("v_cvt_pk_bf16_f32 %0, %1, %2" : "=v"(r) : "v"(lo), "v"(hi)); return r; }

typedef int i32x4 __attribute__((ext_vector_type(4)));
typedef int i32x8 __attribute__((ext_vector_type(8)));
__device__ __forceinline__ i32x8 cat8(bf16x8 lo, bf16x8 hi) { return __builtin_shufflevector(__builtin_bit_cast(i32x4, lo), __builtin_bit_cast(i32x4, hi), 0, 1, 2, 3, 4, 5, 6, 7); }
template <class Epi, class Sched, bool ALIGN_EPI = false, bool SP2 = false, bool FP8 = false>
__device__ __forceinline__ void gemm_phase(PG8_LAS unsigned char* lds, const Gemm g, const Sched& S, const Epi& E) {
    const int tid = threadIdx.x, wid = __builtin_amdgcn_readfirstlane(tid >> 6), lane = tid & 63, wr = wid >> 2, wc = wid & 3, fr = lane & 15, fq = lane >> 4;
    const int K = g.K, nt = K / BK;
    unsigned voffA[2], voffB[2];
#pragma unroll
    for (int i = 0; i < 2; ++i) { int R, C; stage_rc(tid * 16 + i * 8192, R, C); const int Rb = Epi::PERM ? ((R & ~31) + perm32(R & 31)) : R;
        voffA[i] = (unsigned)(R * K + C) * 2u; voffB[i] = (unsigned)(Rb * K + C) * 2u; }
    const size_t kstep = (size_t)(BK * 2);
    const size_t hstep = (size_t)HALF * K * 2;
    const size_t tstep = 2 * hstep;
    const unsigned ldsw = (unsigned)wid * 1024u;
    const int aoff = lds_byte(wr * 64 + fr, fq * 8), boff = lds_byte(wc * 32 + fr, fq * 8);
#define PG8_SA(b, h) (((b) * 2 + (h)) * HTB)
#define PG8_SB(b, h) ((4 + (b) * 2 + (h)) * HTB)
#define PG8_STAGE(bufoff, gbase, voff) do { _Pragma("unroll") for (int _i = 0; _i < 2; ++_i) \
        __builtin_amdgcn_global_load_lds((const unsigned*)((const char*)(gbase) + (voff)[_i]), (PG8_LAS unsigned*)(lds + (bufoff) + ldsw + _i * 8192), 16, 0, 0); } while (0)
#define PG8_LDA(dst, b, h) do { _Pragma("unroll") for (int m = 0; m < 4; ++m) _Pragma("unroll") for (int k = 0; k < 2; ++k) dst[m][k] = *(const PG8_LAS bf16x8*)(lds + PG8_SA(b, h) + aoff + m * 2048 + k * 1024); } while (0)
#define PG8_LDB(dst, b, h) do { _Pragma("unroll") for (int n = 0; n < 2; ++n) _Pragma("unroll") for (int k = 0; k < 2; ++k) dst[n][k] = *(const PG8_LAS bf16x8*)(lds + PG8_SB(b, h) + boff + n * 2048 + k * 1024); } while (0)
#define PG8_MMA(ai, bj, At, Bt) do { __builtin_amdgcn_s_setprio(1); _Pragma("unroll") for (int m = 0; m < 4; ++m) _Pragma("unroll") for (int n = 0; n < 2; ++n) { \
        if constexpr (FP8) { const i32x8 _a = cat8(Bt[n][0], Bt[n][1]), _b = cat8(At[m][0], At[m][1]); asm volatile("v_mfma_f32_16x16x128_f8f6f4 %0, %1, %2, %0" : "+v"(acc[ai][bj][m][n]) : "v"(_a), "v"(_b)); } \
        else { _Pragma("unroll") for (int k = 0; k < 2; ++k) acc[ai][bj][m][n] = __builtin_amdgcn_mfma_f32_16x16x32_bf16(Bt[n][k], At[m][k], acc[ai][bj][m][n], 0, 0, 0); } } \
        __builtin_amdgcn_s_setprio(0); } while (0)
#define PG8_WAIT_V(n) asm volatile("s_waitcnt vmcnt(" #n ")" ::: "memory")
#define PG8_WAIT_L(n) asm volatile("s_waitcnt lgkmcnt(" #n ")" ::: "memory")
#define PG8_BAR __builtin_amdgcn_s_barrier()
#define PG8_SCHED __builtin_amdgcn_sched_barrier(0)
    Unit cur, nxt; int ui = 0;
    if (!S.next(0, cur)) return;
    f32x4 acc[2][2][4][2];
#pragma unroll
    for (int a = 0; a < 2; ++a)
#pragma unroll
        for (int b = 0; b < 2; ++b)
#pragma unroll
            for (int m = 0; m < 4; ++m)
#pragma unroll
                for (int n = 0; n < 2; ++n) acc[a][b][m][n] = (f32x4){0.f, 0.f, 0.f, 0.f};
    bf16x8 At[4][2], B0[2][2], B1[2][2];
    const char* cA = (const char*)g.A + (size_t)cur.pm * tstep; const char* cB = (const char*)g.Bt + (size_t)cur.pb * tstep;
    S.a_ready(cur);
    if constexpr (SP2) {
        PG8_STAGE(PG8_SB(0, 0), cB, voffB); PG8_STAGE(PG8_SB(0, 1), cB + hstep, voffB); PG8_STAGE(PG8_SA(0, 0), cA, voffA); PG8_STAGE(PG8_SA(0, 1), cA + hstep, voffA);
        if (wr == 1) PG8_BAR;
        PG8_WAIT_V(2); PG8_BAR;
        PG8_STAGE(PG8_SB(1, 0), cB + kstep, voffB); PG8_STAGE(PG8_SA(1, 0), cA + kstep, voffA); PG8_STAGE(PG8_SB(1, 1), cB + hstep + kstep, voffB);
        PG8_WAIT_V(6); PG8_BAR;
    } else {
        PG8_STAGE(PG8_SB(0, 0), cB, voffB); PG8_STAGE(PG8_SA(0, 0), cA, voffA); PG8_STAGE(PG8_SB(0, 1), cB + hstep, voffB); PG8_STAGE(PG8_SA(0, 1), cA + hstep, voffA);
        if (wr == 1) PG8_BAR;
        PG8_WAIT_V(4); PG8_BAR;
        PG8_STAGE(PG8_SB(1, 0), cB + kstep, voffB); PG8_STAGE(PG8_SA(1, 0), cA + kstep, voffA); PG8_STAGE(PG8_SB(1, 1), cB + hstep + kstep, voffB);
        PG8_WAIT_V(6); PG8_BAR;
    }
    for (;;) {
        const bool has_next = S.next(ui + 1, nxt);
        const char* nA = has_next ? (const char*)g.A + (size_t)nxt.pm * tstep : cA; const char* nB = has_next ? (const char*)g.Bt + (size_t)nxt.pb * tstep : cB;
        for (int t = 0; t < nt; t += 2) {
            const bool last = (t == nt - 2);
            const char* a1 = cA + (size_t)(t + 1) * kstep;
            const char* a2 = last ? nA : cA + (size_t)(t + 2) * kstep; const char* b2 = last ? nB : cB + (size_t)(t + 2) * kstep;
            const char* a3 = a2 + kstep; const char* b3 = b2 + kstep;
            if (last && has_next) S.a_ready(nxt);
            if constexpr (SP2) {
            PG8_LDB(B0, 0, 0); PG8_LDB(B1, 0, 1); PG8_SCHED; PG8_LDA(At, 0, 0); PG8_STAGE(PG8_SA(1, 1), a1 + hstep, voffA);
            PG8_WAIT_V(8); PG8_WAIT_L(0); PG8_BAR; PG8_MMA(0, 0, At, B0); PG8_MMA(0, 1, At, B1); PG8_BAR; PG8_SCHED;
            PG8_LDA(At, 0, 1); PG8_STAGE(PG8_SB(0, 0), b2, voffB); PG8_STAGE(PG8_SB(0, 1), b2 + hstep, voffB); PG8_STAGE(PG8_SA(0, 0), a2, voffA);
            PG8_WAIT_V(8); PG8_WAIT_L(0); PG8_BAR; PG8_MMA(1, 0, At, B0); PG8_MMA(1, 1, At, B1); PG8_BAR; PG8_SCHED;
            PG8_LDB(B0, 1, 0); PG8_LDB(B1, 1, 1); PG8_SCHED; PG8_LDA(At, 1, 0); PG8_STAGE(PG8_SA(0, 1), a2 + hstep, voffA);
            PG8_WAIT_V(8); PG8_WAIT_L(0); PG8_BAR; PG8_MMA(0, 0, At, B0); PG8_MMA(0, 1, At, B1); PG8_BAR; PG8_SCHED;
            PG8_LDA(At, 1, 1); PG8_STAGE(PG8_SB(1, 0), b3, voffB); PG8_STAGE(PG8_SB(1, 1), b3 + hstep, voffB); PG8_STAGE(PG8_SA(1, 0), a3, voffA);
            PG8_WAIT_V(8); PG8_WAIT_L(0); PG8_BAR; PG8_MMA(1, 0, At, B0); PG8_MMA(1, 1, At, B1); PG8_BAR; PG8_SCHED;
            } else {
            PG8_LDB(B0, 0, 0); PG8_SCHED; PG8_LDA(At, 0, 0); PG8_STAGE(PG8_SA(1, 1), a1 + hstep, voffA);
            PG8_WAIT_L(8); PG8_BAR; PG8_WAIT_L(0); PG8_MMA(0, 0, At, B0); PG8_BAR; PG8_SCHED;
            PG8_LDB(B1, 0, 1); PG8_STAGE(PG8_SB(0, 0), b2, voffB);
            PG8_BAR; PG8_WAIT_L(0); PG8_MMA(0, 1, At, B1); PG8_BAR;
            PG8_LDA(At, 0, 1); PG8_STAGE(PG8_SA(0, 0), a2, voffA);
            PG8_BAR; PG8_WAIT_L(0); PG8_MMA(1, 0, At, B0); PG8_BAR; PG8_SCHED;
            PG8_STAGE(PG8_SB(0, 1), b2 + hstep, voffB);
            PG8_WAIT_V(6); PG8_BAR; PG8_MMA(1, 1, At, B1); PG8_BAR;
            PG8_LDB(B0, 1, 0); PG8_SCHED; PG8_LDA(At, 1, 0); PG8_STAGE(PG8_SA(0, 1), a2 + hstep, voffA);
            PG8_WAIT_L(8); PG8_BAR; PG8_WAIT_L(0); PG8_MMA(0, 0, At, B0); PG8_BAR; PG8_SCHED;
            PG8_LDB(B1, 1, 1); PG8_STAGE(PG8_SB(1, 0), b3, voffB);
            PG8_BAR; PG8_WAIT_L(0); PG8_MMA(0, 1, At, B1); PG8_BAR;
            PG8_LDA(At, 1, 1); PG8_STAGE(PG8_SA(1, 0), a3, voffA);
            PG8_BAR; PG8_WAIT_L(0); PG8_MMA(1, 0, At, B0); PG8_BAR; PG8_SCHED;
            PG8_STAGE(PG8_SB(1, 1), b3 + hstep, voffB);
            PG8_WAIT_V(6); PG8_BAR; PG8_MMA(1, 1, At, B1); PG8_BAR;
            }
        }
        if constexpr (ALIGN_EPI) { if (wr == 0) PG8_BAR; }
        if constexpr (FP8) asm volatile("s_nop 7\n\ts_nop 7\n\ts_nop 7" ::: "memory");
        E(acc, cur, wr, wc, fr, fq);
        if (!has_next) break;
#pragma unroll
        for (int a = 0; a < 2; ++a)
#pragma unroll
            for (int b = 0; b < 2; ++b)
#pragma unroll
                for (int m = 0; m < 4; ++m)
#pragma unroll
                    for (int n = 0; n < 2; ++n) acc[a][b][m][n] = (f32x4){0.f, 0.f, 0.f, 0.f};
        cur = nxt; cA = nA; cB = nB; ++ui;
        if constexpr (ALIGN_EPI) { if (wr == 1) PG8_BAR; }
    }
    PG8_WAIT_V(0);
    if constexpr (!ALIGN_EPI) { if (wr == 0) PG8_BAR; }
    PG8_BAR;
#undef PG8_SA
#undef PG8_SB
#undef PG8_STAGE
#undef PG8_LDA
#undef PG8_LDB
#undef PG8_MMA
#undef PG8_WAIT_V
#undef PG8_WAIT_L
#undef PG8_BAR
#undef PG8_SCHED
}
}

constexpr int D = 2048, NB = 2, SEQ = 16384, NT = NB * SEQ, CTXL = 256, NCTX = NB * CTXL, MTOT = NT + NCTX;
constexpr int NEXP = 16, CAP = 2048, FF = 1024, GRIDW = 64, NROWS = 256;
constexpr float EPS = 1e-6f;
constexpr float LOG2E = 1.4426950408889634f;
constexpr int NWAVES = 8;

constexpr size_t MiB = 1u << 20;
constexpr size_t WS_CTL = 0, CTL_ZERO_BYTES = 1 * MiB;
constexpr size_t CTL_TOKCNT0 = 262144, CTL_TOKCNT1 = 393216, CTL_BAR = 524288;
constexpr size_t WS_MOD = 1 * MiB;
constexpr size_t WS_AFF = 2 * MiB;
constexpr size_t WS_IDX = 4 * MiB;
constexpr size_t WS_TOKLIST = 5 * MiB;
constexpr size_t WS_WSB = 9 * MiB;
constexpr size_t WS_WIN0 = 10 * MiB, WS_WOUT0 = 30 * MiB, WS_WCIN = 38 * MiB, WS_WCOUT = 62 * MiB;
constexpr size_t WS_GU = 70 * MiB;
constexpr size_t WS_DN = 326 * MiB;
constexpr size_t WS_H = 454 * MiB;
constexpr size_t WS_R2 = 584 * MiB;
constexpr size_t WS_R3 = 968 * MiB;
constexpr size_t WS_H8 = 1224 * MiB;
constexpr size_t WS_END = 1289 * MiB;
constexpr size_t WS_WIN0F8 = WS_WIN0 + 8 * MiB;
constexpr size_t R2_T = (size_t)MTOT * 1024;

constexpr int LDS_SCR = 0;
constexpr int LDSCTL_OFF = 135168, MISC_OFF = LDSCTL_OFF + 320;
constexpr int LDS_BYTES = 147456;

#define GAS __attribute__((address_space(1)))
#define LAS __attribute__((address_space(3)))
#define DI __device__ __forceinline__
typedef unsigned short bf16;
typedef unsigned v4u __attribute__((ext_vector_type(4)));
typedef unsigned v2u __attribute__((ext_vector_type(2)));
typedef float f32x4 __attribute__((ext_vector_type(4)));
typedef float f32x16 __attribute__((ext_vector_type(16)));
typedef short bf16x8 __attribute__((ext_vector_type(8)));
typedef short s16x4 __attribute__((ext_vector_type(4)));
typedef GAS unsigned gu32;
#define RLX_AGENT __ATOMIC_RELAXED, __HIP_MEMORY_SCOPE_AGENT
#define LDS_WAIT() asm volatile("s_waitcnt lgkmcnt(0)" ::: "memory")
#define VM_WAIT() asm volatile("s_waitcnt vmcnt(0)" ::: "memory")
DI float bf_lo(unsigned u) { return __uint_as_float(u << 16); }
DI float bf_hi(unsigned u) { return __uint_as_float(u & 0xffff0000u); }
DI unsigned pk2(float lo, float hi) { return pg8::cvt_pk_bf16(lo, hi); }
constexpr float F8_WSCALE = 64.0f, F8_WINV = 1.0f / 64.0f;
DI float clamp448(float x) { return __builtin_amdgcn_fmed3f(x, -448.0f, 448.0f); }
DI unsigned pk4_fp8(float a, float b, float c, float d) { int p = __builtin_amdgcn_cvt_pk_fp8_f32(clamp448(a), clamp448(b), 0, false); p = __builtin_amdgcn_cvt_pk_fp8_f32(clamp448(c), clamp448(d), p, true); return (unsigned)p; }
DI float wave_sum(float v) {
#pragma unroll
    for (int o = 1; o < 64; o <<= 1) v += __shfl_xor(v, o);
    return v;
}
DI int wave_sum_i(int v) {
#pragma unroll
    for (int o = 1; o < 64; o <<= 1) v += __shfl_xor(v, o);
    return v;
}
DI float fast_rcp(float x) { return __builtin_amdgcn_rcpf(x); }
DI float fast_exp2(float x) { return __builtin_amdgcn_exp2f(x); }
DI float sigmoidf_(float z) { return fast_rcp(1.0f + fast_exp2(-z * LOG2E)); }
DI float gelu_tanh(float x) { const float z = 1.5957691216057308f * (x + 0.044715f * x * x * x); return x * sigmoidf_(z); }
DI float siluf_(float x) { return x * sigmoidf_(x); }

#define XB_TMO      128
#define XB_XCNT(j)  (256  + 64 * (j))
#define XB_XSUB(j)  (1280 + 64 * (j))
#define XB_XGEN(j)  (2304 + 64 * (j))
#define XB_TOP      3328
#define XB_TOPGEN   3392
#define XCD_BAR_WORDS 3456
#define XB_SPIN_CAP (1u << 18)

__device__ __forceinline__ unsigned xb_ld(unsigned* p)              { return __hip_atomic_load(p, __ATOMIC_RELAXED, __HIP_MEMORY_SCOPE_AGENT); }
__device__ __forceinline__ unsigned xb_add(unsigned* p, unsigned v) { return __hip_atomic_fetch_add(p, v, __ATOMIC_RELAXED, __HIP_MEMORY_SCOPE_AGENT); }
__device__ __forceinline__ unsigned xb_xcc_id() { return (unsigned)__builtin_amdgcn_s_getreg((3 << 11) | 20) & 0xFu; }
#define XB_SPIN(cond, bar) do { unsigned _sp = 0; while (cond) { __builtin_amdgcn_s_sleep(1); \
    if ((++_sp & 255u) == 0u) { if (xb_ld(&(bar)[XB_TMO])) break; if (_sp > XB_SPIN_CAP) { atomicAdd(&(bar)[XB_TMO], 1u); break; } } } } while (0)

struct XcdBarrier {
    unsigned* bar; unsigned x;
    volatile LAS unsigned* st;
};
__device__ __forceinline__ XcdBarrier xcd_barrier_post(unsigned* bar, volatile LAS unsigned* st) {
    XcdBarrier b; b.bar = bar; b.x = xb_xcc_id(); b.st = st;
    if (threadIdx.x == 0) (void)xb_add(&bar[XB_XCNT(b.x)], 1u);
    return b;
}
__device__ __forceinline__ void xcd_barrier_complete(unsigned* bar, unsigned x, unsigned& nloc, unsigned& nx) {
    const unsigned G = gridDim.x * gridDim.y * gridDim.z;
    unsigned sum, cnt, mine, sp = 0u;
    for (;;) {
        sum = 0u; cnt = 0u; mine = 0u;
#pragma unroll
        for (unsigned j = 0; j < 16; ++j) { const unsigned c = xb_ld(&bar[XB_XCNT(j)]); sum += c; cnt += (c > 0u) ? 1u : 0u; mine = (j == x) ? c : mine; }
        if (sum == G) break;
        __builtin_amdgcn_s_sleep(1);
        if ((++sp & 255u) == 0u) { if (xb_ld(&bar[XB_TMO])) break; if (sp > XB_SPIN_CAP) { atomicAdd(&bar[XB_TMO], 1u); break; } }
    }
    nloc = mine > 0u ? mine : 1u; nx = cnt > 0u ? cnt : 1u;
}
__device__ __forceinline__ void xcd_barrier(const XcdBarrier& b) {
    asm volatile("s_waitcnt vmcnt(0)" ::: "memory");
    __syncthreads();
    if (threadIdx.x == 0) {
        unsigned* bar = b.bar;
        __builtin_amdgcn_s_waitcnt(0);
        unsigned nloc = b.st[0], nx = b.st[1];
        if (nloc == 0u) { xcd_barrier_complete(bar, b.x, nloc, nx); b.st[0] = nloc; b.st[1] = nx; }
        const unsigned old = xb_add(&bar[XB_XSUB(b.x)], 1u);
        const unsigned gen = old / nloc;
        if (old + 1u == (gen + 1u) * nloc) {
            __builtin_amdgcn_fence(__ATOMIC_RELEASE, "agent");
            asm volatile("s_waitcnt vmcnt(0)" ::: "memory");
            const unsigned og = xb_add(&bar[XB_TOP], 1u);
            const unsigned tg = og / nx;
            if (og + 1u == (tg + 1u) * nx) xb_add(&bar[XB_TOPGEN], 1u);
            else XB_SPIN(xb_ld(&bar[XB_TOPGEN]) == tg, bar);
            __builtin_amdgcn_fence(__ATOMIC_ACQUIRE, "agent");
            xb_add(&bar[XB_XGEN(b.x)], 1u);
            asm volatile("s_waitcnt vmcnt(0)" ::: "memory");
        } else {
            XB_SPIN(xb_ld(&bar[XB_XGEN(b.x)]) == gen, bar);
            __builtin_amdgcn_fence(__ATOMIC_ACQUIRE, "agent");
            asm volatile("s_waitcnt vmcnt(0)" ::: "memory");
        }
    }
    __syncthreads();
}

using pg8::Unit; using pg8::BM; using pg8::HALF;
struct EpiIn0 {
    static constexpr bool PERM = true;
    bf16* O; int tbase; float sc;
    DI void operator()(const f32x4 (&acc)[2][2][4][2], const Unit& u, int wr, int wc, int fr, int fq) const {
        const int row0 = u.pm * BM + wr * 64 + fr; const int t = tbase + (u.pn >> 2); const int colt = (u.pn & 3) * BM;
        bf16* base = O + (size_t)t * R2_T; const int col0 = colt + wc * 32 + 8 * fq; const bool act = t < 2;
#pragma unroll
        for (int ai = 0; ai < 2; ++ai)
#pragma unroll
            for (int m = 0; m < 4; ++m) { bf16* rowp = base + (size_t)(row0 + ai * HALF + m * 16) * 1024 + col0;
#pragma unroll
                for (int bj = 0; bj < 2; ++bj) { f32x4 v0 = acc[ai][bj][m][0] * sc, v1 = acc[ai][bj][m][1] * sc;
                    if (act) {
#pragma unroll
                        for (int j = 0; j < 4; ++j) { v0[j] = gelu_tanh(v0[j]); v1[j] = gelu_tanh(v1[j]); } }
                    v4u w; w.x = pk2(v0[0], v0[1]); w.y = pk2(v0[2], v0[3]); w.z = pk2(v1[0], v1[1]); w.w = pk2(v1[2], v1[3]);
                    *(v4u*)(rowp + bj * HALF) = w; } }
    }
};
struct OneUnit {
    int pm, pn;
    __device__ bool next(int i, Unit& u) const { if (i != 0) return false; u.pm = pm; u.pn = pn; u.pb = pn; return true; }
    DI void a_ready(const Unit&) const {}
    DI void done(const Unit&) const {}
};
struct EpiResid {
    static constexpr bool PERM = false;
    const float* base; float* out; const float* gate0;
    DI void operator()(const f32x4 (&acc)[2][2][4][2], const Unit& u, int wr, int wc, int fr, int fq) const {
        const int row0 = u.pm * BM + wr * 64 + fr, col0 = u.pn * BM + wc * 32 + 4 * fq;
        const float* gate = gate0 + (size_t)((u.pm * BM) >> 14) * 12288;
        f32x4 gv[2][2];
#pragma unroll
        for (int bj = 0; bj < 2; ++bj)
#pragma unroll
            for (int n = 0; n < 2; ++n) gv[bj][n] = *(const f32x4*)(gate + col0 + bj * HALF + n * 16);
#pragma unroll
        for (int ai = 0; ai < 2; ++ai)
#pragma unroll
            for (int m = 0; m < 4; ++m) { const size_t off = (size_t)(row0 + ai * HALF + m * 16) * D + col0;
#pragma unroll
                for (int bj = 0; bj < 2; ++bj)
#pragma unroll
                    for (int n = 0; n < 2; ++n) { const f32x4 bs = *(const f32x4*)(base + off + bj * HALF + n * 16);
                        *(f32x4*)(out + off + bj * HALF + n * 16) = bs + gv[bj][n] * acc[ai][bj][m][n]; } }
    }
};
template <bool F8>
struct EpiSwiglu {
    static constexpr bool PERM = true;
    void* O;
    DI void operator()(const f32x4 (&acc)[2][2][4][2], const Unit& u, int wr, int wc, int fr, int fq) const {
        const int row0 = u.pm * BM + wr * 64 + fr, col0 = u.pn * HALF + wc * 32 + 8 * fq;
        const float sc = F8 ? F8_WINV : 1.0f;
#pragma unroll
        for (int ai = 0; ai < 2; ++ai)
#pragma unroll
            for (int m = 0; m < 4; ++m) { const size_t eo = (size_t)(row0 + ai * HALF + m * 16) * FF + col0;
                f32x4 g0 = acc[ai][0][m][0] * sc, g1 = acc[ai][0][m][1] * sc; const f32x4 u0 = acc[ai][1][m][0] * sc, u1 = acc[ai][1][m][1] * sc;
#pragma unroll
                for (int j = 0; j < 4; ++j) { g0[j] = siluf_(g0[j]) * u0[j]; g1[j] = siluf_(g1[j]) * u1[j]; }
                if constexpr (F8) { v2u w; w.x = pk4_fp8(g0[0], g0[1], g0[2], g0[3]); w.y = pk4_fp8(g1[0], g1[1], g1[2], g1[3]); *(v2u*)((unsigned char*)O + eo) = w; }
                else { v4u w; w.x = pk2(g0[0], g0[1]); w.y = pk2(g0[2], g0[3]); w.z = pk2(g1[0], g1[1]); w.w = pk2(g1[2], g1[3]); *(v4u*)((bf16*)O + eo) = w; } }
    }
};
struct EpiPlain {
    static constexpr bool PERM = true;
    bf16* O; int ldc; float sc;
    DI void operator()(const f32x4 (&acc)[2][2][4][2], const Unit& u, int wr, int wc, int fr, int fq) const {
        const int row0 = u.pm * BM + wr * 64 + fr, col0 = u.pn * BM + wc * 32 + 8 * fq;
#pragma unroll
        for (int ai = 0; ai < 2; ++ai)
#pragma unroll
            for (int m = 0; m < 4; ++m) { bf16* rowp = O + (size_t)(row0 + ai * HALF + m * 16) * ldc + col0;
#pragma unroll
                for (int bj = 0; bj < 2; ++bj) { const f32x4 v0 = acc[ai][bj][m][0] * sc, v1 = acc[ai][bj][m][1] * sc;
                    v4u w; w.x = pk2(v0[0], v0[1]); w.y = pk2(v0[2], v0[3]); w.z = pk2(v1[0], v1[1]); w.w = pk2(v1[2], v1[3]);
                    *(v4u*)(rowp + bj * HALF) = w; } }
    }
};
struct EpiCin {
    static constexpr bool PERM = true;
    bf16* BG; bf16* CZ; int nostore;
    DI void operator()(const f32x4 (&acc)[2][2][4][2], const Unit& u, int wr, int wc, int fr, int fq) const {
        if (nostore) return;
        const int row0 = u.pm * BM + wr * 64 + fr;
        if (u.pn < 8) {
            const int col0 = u.pn * BM + wc * 32 + 8 * fq;
#pragma unroll
            for (int ai = 0; ai < 2; ++ai)
#pragma unroll
                for (int m = 0; m < 4; ++m) { bf16* rowp = BG + (size_t)(row0 + ai * HALF + m * 16) * D + col0;
#pragma unroll
                    for (int bj = 0; bj < 2; ++bj) { const f32x4 v0 = acc[ai][bj][m][0], v1 = acc[ai][bj][m][1];
                        v4u w; w.x = pk2(v0[0], v0[1]); w.y = pk2(v0[2], v0[3]); w.z = pk2(v1[0], v1[1]); w.w = pk2(v1[2], v1[3]);
                        *(v4u*)(rowp + bj * HALF) = w; } }
        } else {
            const int col0 = (u.pn - 8) * HALF + wc * 32 + 8 * fq;
#pragma unroll
            for (int ai = 0; ai < 2; ++ai)
#pragma unroll
                for (int m = 0; m < 4; ++m) { bf16* rowp = CZ + (size_t)(row0 + ai * HALF + m * 16) * D + col0;
                    const f32x4 p0 = acc[ai][0][m][0] * acc[ai][1][m][0], p1 = acc[ai][0][m][1] * acc[ai][1][m][1];
                    v4u w; w.x = pk2(p0[0], p0[1]); w.y = pk2(p0[2], p0[3]); w.z = pk2(p1[0], p1[1]); w.w = pk2(p1[2], p1[3]);
                    *(v4u*)rowp = w; }
        }
    }
};

DI unsigned off_b(unsigned row, unsigned ch) { return 256u * row + 16u * (ch ^ (((row & 3) << 2) | ((row >> 2) & 3))); }
DI bf16x8 row_frag(const LAS unsigned char* img, int lane, int s) { return *(const LAS bf16x8*)(img + off_b(lane & 31, 2 * s + (lane >> 5))); }
template <bool KROW>
DI bf16x8 tr_frag(const LAS unsigned char* img, int lane, int c, int ks) {
    const unsigned h = lane >> 5, blk = (lane >> 4) & 1, q = (lane & 15) >> 2, p = lane & 3;
    const unsigned r0 = KROW ? (16 * ks + 4 * h + q) : (16 * ks + 8 * h + q), r1 = KROW ? (r0 + 8) : (r0 + 4);
    const unsigned ch = 4 * c + 2 * blk + (p >> 1), sub = 8 * (p & 1);
    const s16x4 lo = __builtin_amdgcn_ds_read_tr16_b64_v4i16((LAS s16x4*)(img + off_b(r0, ch) + sub));
    const s16x4 hi = __builtin_amdgcn_ds_read_tr16_b64_v4i16((LAS s16x4*)(img + off_b(r1, ch) + sub));
    return __builtin_shufflevector(lo, hi, 0, 1, 2, 3, 4, 5, 6, 7);
}
DI int crow(int reg, int h) { return (reg & 3) + 8 * (reg >> 2) + 4 * h; }
#define MFMA32(a, b, c) __builtin_amdgcn_mfma_f32_32x32x16_bf16((a), (b), (c), 0, 0, 0)

struct Params { const float* in[23]; float* out; unsigned char* ws; int ph_lo, ph_hi, li, pad; };
enum { I_X = 0, I_C, I_CTX, I_CCTX, I_ADAW, I_ADAB, I_N1G, I_N2G, I_ABWIN, I_ABWOUT, I_AWS, I_ABS, I_AVG, I_BQG, I_BKG, I_RPB, I_CWIN, I_CONVW, I_CWOUT, I_ROUTER, I_WGATE, I_WUP, I_WDOWN };

template <bool F8>
DI void xpose_item(const float* __restrict__ W, int N, bf16* __restrict__ WT, int Kd, int k0, int n0, int dstrow0, LAS float* scr, int lane) {
    const GAS f32x4* src = (const GAS f32x4*)(W + (size_t)k0 * N + n0);
    const int lr = lane >> 4, lc = lane & 15;
    f32x4 v[16];
#pragma unroll
    for (int i = 0; i < 16; ++i) v[i] = src[(size_t)(lr + 4 * i) * (N / 4) + lc];
#pragma unroll
    for (int i = 0; i < 16; ++i) { LAS float* d = scr + (lr + 4 * i) * 65 + 4 * lc; d[0] = v[i].x; d[1] = v[i].y; d[2] = v[i].z; d[3] = v[i].w; }
    LDS_WAIT(); asm volatile("" ::: "memory");
    if constexpr (F8) {
        const int c = lane & 3;
#pragma unroll
        for (int i = 0; i < 4; ++i) { const int n = 16 * i + (lane >> 2); const LAS float* s = scr + (16 * c) * 65 + n;
            v4u o;
            o.x = pk4_fp8(s[0 * 65] * F8_WSCALE, s[1 * 65] * F8_WSCALE, s[2 * 65] * F8_WSCALE, s[3 * 65] * F8_WSCALE); o.y = pk4_fp8(s[4 * 65] * F8_WSCALE, s[5 * 65] * F8_WSCALE, s[6 * 65] * F8_WSCALE, s[7 * 65] * F8_WSCALE);
            o.z = pk4_fp8(s[8 * 65] * F8_WSCALE, s[9 * 65] * F8_WSCALE, s[10 * 65] * F8_WSCALE, s[11 * 65] * F8_WSCALE); o.w = pk4_fp8(s[12 * 65] * F8_WSCALE, s[13 * 65] * F8_WSCALE, s[14 * 65] * F8_WSCALE, s[15 * 65] * F8_WSCALE);
            *(GAS v4u*)((unsigned char*)WT + (size_t)(dstrow0 + n) * Kd + k0 + 16 * c) = o; }
    } else {
    const int c = lane & 7;
#pragma unroll
    for (int i = 0; i < 8; ++i) { const int n = 8 * i + (lane >> 3); const LAS float* s = scr + (8 * c) * 65 + n;
        v4u o; o.x = pk2(s[0 * 65], s[1 * 65]); o.y = pk2(s[2 * 65], s[3 * 65]); o.z = pk2(s[4 * 65], s[5 * 65]); o.w = pk2(s[6 * 65], s[7 * 65]);
        *(GAS v4u*)(WT + (size_t)(dstrow0 + n) * Kd + k0 + 8 * c) = o; }
    }
    LDS_WAIT(); asm volatile("" ::: "memory");
}
DI int ilv_row(int j, int hv) { return ((j >> 7) << 8) + hv * 128 + (j & 127); }

#define F8L(l) ((l) == 0 ? (MK_FP8_L0 != 0) : (MK_FP8_L1 != 0))
DI void phase_prologue(const Params& P, LAS unsigned char* lds, int tid, int lane, int wave) {
    unsigned char* ws = P.ws;
    for (int u = blockIdx.x; u < 192; u += gridDim.x) {
        const int l = u / 96, cb = u % 96;
        LAS float* sv = (LAS float*)(lds + LDS_SCR);
        LAS float* part = (LAS float*)(lds + LDS_SCR + 24576);
        for (int i = tid; i < 3 * 2048; i += 512) { const int r = i >> 11, k = i & 2047; const float c = r < 2 ? P.in[I_C][r * 2048 + k] : P.in[I_CCTX][k]; sv[i] = c / (1.0f + __expf(-c)); }
        __syncthreads();
        const int col4 = tid & 31, ks = tid >> 5;
        const GAS f32x4* w = (const GAS f32x4*)(P.in[I_ADAW] + (size_t)l * 2048 * 12288 + (size_t)(ks * 128) * 12288 + cb * 128) + col4;
        f32x4 a0 = {0.f, 0.f, 0.f, 0.f}, a1 = a0, a2 = a0;
#pragma unroll 8
        for (int k = 0; k < 128; ++k) { const f32x4 wv = w[(size_t)k * (12288 / 4)]; const int kk = ks * 128 + k;
            a0 += wv * sv[kk]; a1 += wv * sv[2048 + kk]; a2 += wv * sv[4096 + kk]; }
        *(LAS f32x4*)(part + (ks * 3 + 0) * 128 + 4 * col4) = a0; *(LAS f32x4*)(part + (ks * 3 + 1) * 128 + 4 * col4) = a1; *(LAS f32x4*)(part + (ks * 3 + 2) * 128 + 4 * col4) = a2;
        __syncthreads();
        if (tid < 384) { const int r = tid >> 7, cc = tid & 127; float s = P.in[I_ADAB][l * 12288 + cb * 128 + cc];
#pragma unroll
            for (int q = 0; q < 16; ++q) s += part[(q * 3 + r) * 128 + cc];
            ((float*)(ws + WS_MOD))[(size_t)(l * 3 + r) * 12288 + cb * 128 + cc] = s; }
        __syncthreads();
    }
    { const float* src = P.in[I_AWS]; bf16* dst = (bf16*)(ws + WS_WSB);
      for (int i = blockIdx.x * 512 + tid; i < 8 * 128 * 128 / 2; i += gridDim.x * 512) { const float a = src[2 * i], b = src[2 * i + 1]; ((unsigned*)dst)[i] = pk2(a, b); } }
    LAS float* scr = (LAS float*)(lds + LDS_SCR + wave * 16640);
    const int gw = blockIdx.x * NWAVES + wave, NGW = gridDim.x * NWAVES;
    constexpr int I0 = 32 * 80, I1 = 32 * 32, I2 = 32 * 96, I3 = 32 * 32, IM = 512, I4 = 32 * IM, NITEMS = I0 + I1 + I2 + I3 + 3 * I4;
    for (int it = gw; it < NITEMS; it += NGW) {
        int r = it;
        if (r < I0) { const int kb = r / 80, nb = r % 80;
            if (nb < 32) xpose_item<false>(P.in[I_ABWIN], 5120, (bf16*)(ws + WS_WIN0), 2048, kb * 64, nb * 64, nb * 64, scr, lane);
            else xpose_item<true>(P.in[I_ABWIN], 5120, (bf16*)(ws + WS_WIN0F8), 2048, kb * 64, nb * 64, nb * 64 - 2048, scr, lane);
            continue; } r -= I0;
        if (r < I1) { const int kb = r / 32, nb = r % 32; xpose_item<false>(P.in[I_ABWOUT], 2048, (bf16*)(ws + WS_WOUT0), 2048, kb * 64, nb * 64, nb * 64, scr, lane); continue; } r -= I1;
        if (r < I2) { const int kb = r / 96, nb = r % 96; const int n0 = nb * 64;
            const int drow = n0 < 2048 ? n0 : (n0 < 4096 ? 2048 + ilv_row(n0 - 2048, 0) : 2048 + ilv_row(n0 - 4096, 1));
            xpose_item<false>(P.in[I_CWIN], 6144, (bf16*)(ws + WS_WCIN), 2048, kb * 64, n0, drow, scr, lane); continue; } r -= I2;
        if (r < I3) { const int kb = r / 32, nb = r % 32; xpose_item<false>(P.in[I_CWOUT], 2048, (bf16*)(ws + WS_WCOUT), 2048, kb * 64, nb * 64, nb * 64, scr, lane); continue; } r -= I3;
        if (r < I4) { const int mt = r / IM, q = r % IM, kb = q / 16, nb = q % 16;
            if (F8L(mt >> 4)) xpose_item<true>(P.in[I_WGATE] + (size_t)mt * 2048 * 1024, 1024, (bf16*)(ws + WS_GU + (size_t)(mt >> 4) * 16 * 2048 * 2048 * 2 + (size_t)(mt & 15) * 2048 * 2048), 2048, kb * 64, nb * 64, ilv_row(nb * 64, 0), scr, lane);
            else xpose_item<false>(P.in[I_WGATE] + (size_t)mt * 2048 * 1024, 1024, (bf16*)(ws + WS_GU) + (size_t)mt * 2048 * 2048, 2048, kb * 64, nb * 64, ilv_row(nb * 64, 0), scr, lane);
            continue; } r -= I4;
        if (r < I4) { const int mt = r / IM, q = r % IM, kb = q / 16, nb = q % 16;
            if (F8L(mt >> 4)) xpose_item<true>(P.in[I_WUP] + (size_t)mt * 2048 * 1024, 1024, (bf16*)(ws + WS_GU + (size_t)(mt >> 4) * 16 * 2048 * 2048 * 2 + (size_t)(mt & 15) * 2048 * 2048), 2048, kb * 64, nb * 64, ilv_row(nb * 64, 1), scr, lane);
            else xpose_item<false>(P.in[I_WUP] + (size_t)mt * 2048 * 1024, 1024, (bf16*)(ws + WS_GU) + (size_t)mt * 2048 * 2048, 2048, kb * 64, nb * 64, ilv_row(nb * 64, 1), scr, lane);
            continue; } r -= I4;
        { const int mt = r / IM, q = r % IM, kb = q / 32, nb = q % 32;
            if (F8L(mt >> 4)) xpose_item<true>(P.in[I_WDOWN] + (size_t)mt * 1024 * 2048, 2048, (bf16*)(ws + WS_DN + (size_t)(mt >> 4) * 16 * 2048 * 1024 * 2 + (size_t)(mt & 15) * 2048 * 1024), 1024, kb * 64, nb * 64, nb * 64, scr, lane);
            else xpose_item<false>(P.in[I_WDOWN] + (size_t)mt * 1024 * 2048, 2048, (bf16*)(ws + WS_DN) + (size_t)mt * 2048 * 1024, 1024, kb * 64, nb * 64, nb * 64, scr, lane); }
    }
}

DI void norm_mod_row(f32x4 (&v)[8], const float* __restrict__ g, const float* __restrict__ shift, const float* __restrict__ scale, int lane) {
    float ss = 0.f;
#pragma unroll
    for (int j = 0; j < 8; ++j) ss += (v[j].x * v[j].x + v[j].y * v[j].y) + (v[j].z * v[j].z + v[j].w * v[j].w);
    const float rstd = 1.0f / sqrtf(wave_sum(ss) * (1.0f / D) + EPS);
#pragma unroll
    for (int j = 0; j < 8; ++j) { const int c = 256 * j + 4 * lane; const f32x4 gg = *(const f32x4*)(g + c), sc = *(const f32x4*)(scale + c), sh = *(const f32x4*)(shift + c);
        v[j] = (v[j] * rstd * gg) * (1.0f + sc) + sh; }
}
DI void store_row_bf16(bf16* __restrict__ orow, const f32x4 (&v)[8], int lane) {
    GAS v2u* o = (GAS v2u*)orow + lane;
#pragma unroll
    for (int j = 0; j < 8; ++j) { v2u w; w.x = pk2(v[j].x, v[j].y); w.y = pk2(v[j].z, v[j].w); o[64 * j] = w; }
}
DI void store_row_fp8(unsigned char* __restrict__ orow, const f32x4 (&v)[8], int lane) {
    GAS unsigned* o = (GAS unsigned*)orow + lane;
#pragma unroll
    for (int j = 0; j < 8; ++j) o[64 * j] = pk4_fp8(v[j].x, v[j].y, v[j].z, v[j].w);
}
DI void load_row_f32(f32x4 (&v)[8], const float* __restrict__ xrow, int lane) {
    const GAS f32x4* xr = (const GAS f32x4*)xrow + lane;
#pragma unroll
    for (int j = 0; j < 8; ++j) v[j] = xr[64 * j];
}

DI void phase_norm1_l0(const Params& P, LAS unsigned char* lds, int tid, int lane, int wave) {
    const float* mod = (const float*)(P.ws + WS_MOD); bf16* H = (bf16*)(P.ws + WS_H); unsigned char* H8 = P.ws + WS_H8;
    const bool ctxwg = (gridDim.x >= 64) && (blockIdx.x < 16);
    if (ctxwg) {
        const int pmc = blockIdx.x >> 3, pnc = blockIdx.x & 7;
        const float* m = mod + (size_t)2 * 12288;
        for (int rr = wave; rr < 256; rr += NWAVES) { const int row = NT + pmc * 256 + rr;
            f32x4 v[8]; load_row_f32(v, P.in[I_CTX] + (size_t)(row - NT) * D, lane);
            norm_mod_row(v, P.in[I_N1G], m + 0 * 2048, m + 1 * 2048, lane);
            store_row_fp8(H8 + (size_t)row * D, v, lane); }
        VM_WAIT(); __syncthreads();
        __builtin_amdgcn_fence(__ATOMIC_ACQUIRE, "agent"); VM_WAIT(); __syncthreads();
        pg8::Gemm g{(const bf16*)H8, (const bf16*)(P.ws + WS_WIN0F8), MTOT, 3072, D / 2}; OneUnit S{128 + pmc, 4 + pnc};
        EpiIn0 E{(bf16*)(P.ws + WS_R2), 2, F8_WINV};
        pg8::gemm_phase<EpiIn0, OneUnit, true, true, true>(lds, g, S, E);
        return;
    }
    const int nskip = (gridDim.x >= 64) ? 16 : 0;
    const int gw = (blockIdx.x - nskip) * NWAVES + wave, NGW = (gridDim.x - nskip) * NWAVES;
    const int nrows = (gridDim.x >= 64) ? NT : MTOT;
    for (int row = gw; row < nrows; row += NGW) {
        const float* src = row < NT ? P.in[I_X] + (size_t)row * D : P.in[I_CTX] + (size_t)(row - NT) * D;
        const int r = row < NT ? (row >> 14) : 2;
        const float* m = mod + (size_t)r * 12288;
        f32x4 v[8]; load_row_f32(v, src, lane);
#if MK_STOP < 5
        if (row < NT) { GAS f32x4* o = (GAS f32x4*)(P.out + (size_t)row * D) + lane;
#pragma unroll
            for (int j = 0; j < 8; ++j) o[64 * j] = v[j]; }
#endif
        norm_mod_row(v, P.in[I_N1G], m + 0 * 2048, m + 1 * 2048, lane);
        if (row < NT) store_row_bf16(H + (size_t)row * D, v, lane);
        store_row_fp8(H8 + (size_t)row * D, v, lane);
    }
}

DI void phase_norm2_router(const Params& P, int layer, LAS unsigned char* lds, int tid, int lane, int wave) {
    const float* mod = (const float*)(P.ws + WS_MOD) + (size_t)layer * 3 * 12288; bf16* H = (bf16*)(P.ws + WS_H);
    float* AFF = (float*)(P.ws + WS_AFF);
    LAS float* wrt = (LAS float*)(lds + LDS_SCR);
    { const GAS f32x4* wr = (const GAS f32x4*)(P.in[I_ROUTER] + (size_t)layer * 2048 * 16);
      for (int i = tid; i < 2048 * 4; i += 512) { const f32x4 w = wr[i]; const int k = i >> 2, e0 = (i & 3) * 4;
          wrt[(e0 + 0) * 2048 + k] = w.x; wrt[(e0 + 1) * 2048 + k] = w.y; wrt[(e0 + 2) * 2048 + k] = w.z; wrt[(e0 + 3) * 2048 + k] = w.w; } }
    __syncthreads();
    const int gw = blockIdx.x * NWAVES + wave, NGW = gridDim.x * NWAVES;
    const float* n2g = P.in[I_N2G] + (size_t)layer * D;
    for (int row = gw; row < NT; row += NGW) {
        const int b = row >> 14, n = row & 16383;
        const float* m = mod + (size_t)b * 12288;
        f32x4 v[8]; load_row_f32(v, P.out + (size_t)row * D, lane);
        norm_mod_row(v, n2g, m + 3 * 2048, m + 4 * 2048, lane);
        if (F8L(layer)) store_row_fp8((unsigned char*)H + (size_t)row * D, v, lane); else store_row_bf16(H + (size_t)row * D, v, lane);
        asm volatile("" ::: "memory");
        float lg[16];
#pragma unroll
        for (int e = 0; e < 16; ++e) lg[e] = 0.f;
#pragma unroll
        for (int j = 0; j < 8; ++j) {
#pragma unroll
            for (int e = 0; e < 16; ++e) { const f32x4 w = *(const LAS f32x4*)(wrt + e * 2048 + 256 * j + 4 * lane);
                lg[e] += (v[j].x * w.x + v[j].y * w.y) + (v[j].z * w.z + v[j].w * w.w); } }
#pragma unroll
        for (int e = 0; e < 16; ++e) lg[e] = wave_sum(lg[e]);
        float mx = lg[0];
#pragma unroll
        for (int e = 1; e < 16; ++e) mx = fmaxf(mx, lg[e]);
        float sum = 0.f;
#pragma unroll
        for (int e = 0; e < 16; ++e) { lg[e] = __expf(lg[e] - mx); sum += lg[e]; }
        const float inv = 1.0f / sum;
        float mine = 0.f;
#pragma unroll
        for (int e = 0; e < 16; ++e) mine = (lane == e) ? lg[e] * inv : mine;
        if (lane < 16) AFF[((size_t)(b * 16 + lane)) * SEQ + n] = mine;
    }
    __syncthreads();
}

DI void phase_topk(const Params& P, int layer, LAS unsigned char* lds, int tid, int lane, int wave) {
    LAS unsigned* vals = (LAS unsigned*)(lds + LDS_SCR);
    LAS int* red = (LAS int*)(lds + LDS_SCR + 65536);
    LAS int* slotctr = (LAS int*)(lds + LDS_SCR + 65536 + 64);
    const unsigned* AFF = (const unsigned*)(P.ws + WS_AFF);
    int* IDX = (int*)(P.ws + WS_IDX);
    unsigned* tokcnt = (unsigned*)(P.ws + (layer ? CTL_TOKCNT1 : CTL_TOKCNT0));
    unsigned long long* toklist = (unsigned long long*)(P.ws + WS_TOKLIST);
    for (int j = blockIdx.x; j < 32; j += gridDim.x) {
        const int b = j >> 4, e = j & 15;
        const unsigned* src = AFF + (size_t)j * SEQ;
#pragma unroll 8
        for (int i = 0; i < 32; ++i) vals[tid + 512 * i] = src[tid + 512 * i];
        if (tid == 0) slotctr[0] = 0;
        __syncthreads();
        int par = 0;
#define TK_COUNT(pred, total) do { int _c = 0; _Pragma("unroll 8") for (int i = 0; i < 32; ++i) { const int idx = tid + 512 * i; const unsigned v = vals[idx]; (void)idx; _c += (pred) ? 1 : 0; } \
        _c = wave_sum_i(_c); if (lane == 0) red[par * 8 + wave] = _c; __syncthreads(); total = 0; _Pragma("unroll") for (int w = 0; w < 8; ++w) total += red[par * 8 + w]; par ^= 1; } while (0)
        unsigned T = 0u;
        for (int bit = 30; bit >= 0; --bit) { const unsigned cand = T | (1u << bit); int total; TK_COUNT(v >= cand, total); if (total >= CAP) T = cand; }
        int ngt; TK_COUNT(v > T, ngt);
        const int need = CAP - ngt;
        int lo = 0, hi = SEQ - 1;
        while (lo < hi) { const int mid = (lo + hi) >> 1; int c; TK_COUNT(v == T && idx <= mid, c); if (c >= need) hi = mid; else lo = mid + 1; }
        const int J = lo;
#undef TK_COUNT
        for (int i = 0; i < 32; ++i) { const int idx = tid + 512 * i; const unsigned v = vals[idx];
            if (v > T || (v == T && idx <= J)) {
                const int slot = __hip_atomic_fetch_add(slotctr, 1, __ATOMIC_RELAXED, __HIP_MEMORY_SCOPE_WORKGROUP);
                IDX[j * CAP + slot] = idx;
                const int tok = b * SEQ + idx; const unsigned rowid = (unsigned)(e * 4096 + b * 2048 + slot);
                const unsigned p = __hip_atomic_fetch_add(tokcnt + tok, 1u, RLX_AGENT);
                toklist[(size_t)tok * 16 + (p & 15u)] = ((unsigned long long)v << 32) | rowid; } }
        __syncthreads();
    }
}

template <bool F8>
DI void phase_gather(const Params& P, int lane, int wave) {
    const int* IDX = (const int*)(P.ws + WS_IDX); const unsigned char* H = (const unsigned char*)(P.ws + WS_H); unsigned char* XS = (unsigned char*)(P.ws + WS_R2);
    const int gw = blockIdx.x * NWAVES + wave, NGW = gridDim.x * NWAVES;
    constexpr int RB = F8 ? D : 2 * D, NV = RB / 1024;
    for (int rowid = gw; rowid < 65536; rowid += NGW) {
        const int e = rowid >> 12, b = (rowid >> 11) & 1, slot = rowid & 2047;
        const int n = IDX[(b * 16 + e) * CAP + slot];
        const GAS v4u* s = (const GAS v4u*)(H + (size_t)(b * SEQ + n) * RB) + lane; GAS v4u* d = (GAS v4u*)(XS + (size_t)rowid * RB) + lane;
        v4u t[NV];
#pragma unroll
        for (int j = 0; j < NV; ++j) t[j] = s[64 * j];
#pragma unroll
        for (int j = 0; j < NV; ++j) d[64 * j] = t[j];
    }
}

template <bool NEXT_NORM>
DI void phase_combine(const Params& P, int layer, int lane, int wave) {
    const float* mod = (const float*)(P.ws + WS_MOD) + (size_t)layer * 3 * 12288;
    const float* modn = (const float*)(P.ws + WS_MOD) + (size_t)(layer + 1) * 3 * 12288;
    const unsigned* tokcnt = (const unsigned*)(P.ws + (layer ? CTL_TOKCNT1 : CTL_TOKCNT0));
    const unsigned long long* toklist = (const unsigned long long*)(P.ws + WS_TOKLIST);
    const bf16* YB = (const bf16*)(P.ws + WS_R3); bf16* H = (bf16*)(P.ws + WS_H);
    const int gw = blockIdx.x * NWAVES + wave, NGW = gridDim.x * NWAVES;
    for (int tok = gw; tok < NT; tok += NGW) {
        const int b = tok >> 14;
        f32x4 v[8]; load_row_f32(v, P.out + (size_t)tok * D, lane);
        int cnt = (int)tokcnt[tok]; cnt = __builtin_amdgcn_readfirstlane(cnt); cnt = cnt > 16 ? 16 : cnt;
        f32x4 a[8];
#pragma unroll
        for (int j = 0; j < 8; ++j) a[j] = (f32x4){0.f, 0.f, 0.f, 0.f};
        for (int p = 0; p < cnt; ++p) {
            const unsigned long long ent = toklist[(size_t)tok * 16 + p];
            const unsigned rowid = (unsigned)__builtin_amdgcn_readfirstlane((int)(unsigned)ent); const float gate = __uint_as_float((unsigned)__builtin_amdgcn_readfirstlane((int)(unsigned)(ent >> 32)));
            const GAS v2u* y = (const GAS v2u*)(YB + (size_t)rowid * D) + lane;
#pragma unroll
            for (int j = 0; j < 8; ++j) { const v2u w = y[64 * j]; a[j].x += gate * bf_lo(w.x); a[j].y += gate * bf_hi(w.x); a[j].z += gate * bf_lo(w.y); a[j].w += gate * bf_hi(w.y); }
        }
        const float* g2 = mod + (size_t)b * 12288 + 5 * 2048;
        GAS f32x4* o = (GAS f32x4*)(P.out + (size_t)tok * D) + lane;
#pragma unroll
        for (int j = 0; j < 8; ++j) { const f32x4 gg = *(const f32x4*)(g2 + 256 * j + 4 * lane); v[j] += gg * a[j]; o[64 * j] = v[j]; }
        if constexpr (NEXT_NORM) {
            const float* m = modn + (size_t)b * 12288;
            norm_mod_row(v, P.in[I_N1G] + (size_t)(layer + 1) * D, m + 0 * 2048, m + 1 * 2048, lane);
            store_row_bf16(H + (size_t)tok * D, v, lane);
        }
    }
}

DI void phase_knorm(const Params& P, int lane, int wave) {
    bf16* KK = (bf16*)(P.ws + WS_R2) + 3 * R2_T; const float* gk = P.in[I_BKG];
    const int gw = blockIdx.x * NWAVES + wave, NGW = gridDim.x * NWAVES;
    const int d0 = (lane & 7) * 16;
    float gkr[16];
#pragma unroll
    for (int i = 0; i < 16; ++i) gkr[i] = gk[d0 + i];
    for (int row = gw; row < MTOT; row += NGW) {
        GAS v4u* p = (GAS v4u*)(KK + (size_t)row * 1024) + 2 * lane;
        const v4u w0 = p[0], w1 = p[1];
        float f[16];
        f[0] = bf_lo(w0.x); f[1] = bf_hi(w0.x); f[2] = bf_lo(w0.y); f[3] = bf_hi(w0.y); f[4] = bf_lo(w0.z); f[5] = bf_hi(w0.z); f[6] = bf_lo(w0.w); f[7] = bf_hi(w0.w);
        f[8] = bf_lo(w1.x); f[9] = bf_hi(w1.x); f[10] = bf_lo(w1.y); f[11] = bf_hi(w1.y); f[12] = bf_lo(w1.z); f[13] = bf_hi(w1.z); f[14] = bf_lo(w1.w); f[15] = bf_hi(w1.w);
        float ss = 0.f;
#pragma unroll
        for (int i = 0; i < 16; ++i) ss += f[i] * f[i];
        ss += __shfl_xor(ss, 1); ss += __shfl_xor(ss, 2); ss += __shfl_xor(ss, 4);
        const float rstd = 1.0f / sqrtf(ss * (1.0f / 128.0f) + EPS);
#pragma unroll
        for (int i = 0; i < 16; ++i) f[i] = f[i] * rstd * gkr[i];
        v4u o0, o1; o0.x = pk2(f[0], f[1]); o0.y = pk2(f[2], f[3]); o0.z = pk2(f[4], f[5]); o0.w = pk2(f[6], f[7]); o1.x = pk2(f[8], f[9]); o1.y = pk2(f[10], f[11]); o1.z = pk2(f[12], f[13]); o1.w = pk2(f[14], f[15]);
        p[0] = o0; p[1] = o1;
    }
}

DI void phase_gmlp(const Params& P, LAS unsigned char* lds, int tid, int lane, int wave) {
    const bf16* U = (const bf16*)(P.ws + WS_R2); const bf16* V = U + R2_T; const bf16* WSB = (const bf16*)(P.ws + WS_WSB);
    bf16* CAT = (bf16*)(P.ws + WS_R3);
    LAS unsigned char* wimg = lds + LDS_SCR;
    LAS unsigned char* vimg = lds + LDS_SCR + 32768;
    const int ql = lane & 31, hf = lane >> 5;
    for (int u = blockIdx.x; u < 2048; u += gridDim.x) {
        const int g = u & 7, cn = (u >> 3) & 127, b = u >> 10;
        const int tok0 = b * SEQ + cn * 128;
        const float* gv = P.in[I_AVG] + g * 128;
#pragma unroll
        for (int i = 0; i < 4; ++i) { const int cidx = tid + 512 * i, q = cidx >> 4, ch = cidx & 15;
            const v4u raw = *(const GAS v4u*)(V + (size_t)(tok0 + q) * 1024 + g * 128 + ch * 8);
            float f[8]; f[0] = bf_lo(raw.x); f[1] = bf_hi(raw.x); f[2] = bf_lo(raw.y); f[3] = bf_hi(raw.y); f[4] = bf_lo(raw.z); f[5] = bf_hi(raw.z); f[6] = bf_lo(raw.w); f[7] = bf_hi(raw.w);
            float ss = 0.f;
#pragma unroll
            for (int k = 0; k < 8; ++k) ss += f[k] * f[k];
            ss += __shfl_xor(ss, 1); ss += __shfl_xor(ss, 2); ss += __shfl_xor(ss, 4); ss += __shfl_xor(ss, 8);
            const float rstd = 1.0f / sqrtf(ss * (1.0f / 128.0f) + EPS);
            const f32x4 g0 = *(const f32x4*)(gv + ch * 8), g1 = *(const f32x4*)(gv + ch * 8 + 4);
            v4u o; o.x = pk2(f[0] * rstd * g0.x, f[1] * rstd * g0.y); o.y = pk2(f[2] * rstd * g0.z, f[3] * rstd * g0.w); o.z = pk2(f[4] * rstd * g1.x, f[5] * rstd * g1.y); o.w = pk2(f[6] * rstd * g1.z, f[7] * rstd * g1.w);
            *(LAS v4u*)(vimg + (q >> 5) * 8192 + off_b(q & 31, ch)) = o;
            const v4u wraw = *(const GAS v4u*)(WSB + (size_t)(g * 128 + q) * 128 + ch * 8);
            *(LAS v4u*)(wimg + (q >> 5) * 8192 + off_b(q & 31, ch)) = wraw; }
        __syncthreads();
        const int cb = wave & 3, pb0 = 2 * (wave >> 2);
        f32x16 acc0, acc1;
#pragma unroll
        for (int i = 0; i < 16; ++i) { acc0[i] = 0.f; acc1[i] = 0.f; }
#pragma unroll
        for (int ks = 0; ks < 8; ++ks) {
            const bf16x8 a = tr_frag<false>(vimg + (ks >> 1) * 8192, lane, cb, ks & 1);
            const bf16x8 b0 = row_frag(wimg + (pb0 + 0) * 8192, lane, ks), b1 = row_frag(wimg + (pb0 + 1) * 8192, lane, ks);
            acc0 = MFMA32(a, b0, acc0); acc1 = MFMA32(a, b1, acc1);
        }
#pragma unroll
        for (int x = 0; x < 2; ++x) { const int p = 32 * (pb0 + x) + ql; const int tok = tok0 + p; const float bs = P.in[I_ABS][g * 128 + p];
#pragma unroll
            for (int rq = 0; rq < 4; ++rq) { const int c = 32 * cb + 8 * rq + 4 * hf;
                const v2u uu = *(const GAS v2u*)(U + (size_t)tok * 1024 + g * 128 + c);
                const float s0 = (x ? acc1[4 * rq + 0] : acc0[4 * rq + 0]) + bs, s1 = (x ? acc1[4 * rq + 1] : acc0[4 * rq + 1]) + bs, s2 = (x ? acc1[4 * rq + 2] : acc0[4 * rq + 2]) + bs, s3 = (x ? acc1[4 * rq + 3] : acc0[4 * rq + 3]) + bs;
                v2u o; o.x = pk2(bf_lo(uu.x) * s0, bf_hi(uu.x) * s1); o.y = pk2(bf_lo(uu.y) * s2, bf_hi(uu.y) * s3);
                *(GAS v2u*)(CAT + (size_t)tok * D + g * 128 + c) = o; } }
        __syncthreads();
    }
}

DI void phase_attn(const Params& P, LAS unsigned char* lds, int tid, int lane, int wave) {
    const bf16* Qb = (const bf16*)(P.ws + WS_R2) + 2 * R2_T; const bf16* KK = Qb + R2_T; const bf16* VV = KK + R2_T;
    bf16* CAT = (bf16*)(P.ws + WS_R3);
    LAS unsigned char* kbuf = lds + LDS_SCR;
    LAS unsigned char* vbuf = lds + LDS_SCR + 32768;
    LAS float* rpbL = (LAS float*)(lds + LDS_SCR + 65536);
    const int ql = lane & 31, hf = lane >> 5;
    const float* gq = P.in[I_BQG];
    for (int u = blockIdx.x; u < 1024; u += gridDim.x) {
        const int h = u & 7, rg = (u >> 3) & 63, b = u >> 9;
        const int qr = 4 * rg + (wave >> 1), qc = 32 * (wave & 1) + ql;
        const int tq = b * SEQ + qr * GRIDW + qc;
        bf16x8 Qf[8];
        { v4u raw[8]; float ss = 0.f;
#pragma unroll
          for (int s = 0; s < 8; ++s) { raw[s] = *(const GAS v4u*)(Qb + (size_t)tq * 1024 + h * 128 + 16 * s + 8 * hf);
              const float a0 = bf_lo(raw[s].x), a1 = bf_hi(raw[s].x), a2 = bf_lo(raw[s].y), a3 = bf_hi(raw[s].y), a4 = bf_lo(raw[s].z), a5 = bf_hi(raw[s].z), a6 = bf_lo(raw[s].w), a7 = bf_hi(raw[s].w);
              ss += (a0 * a0 + a1 * a1) + (a2 * a2 + a3 * a3) + (a4 * a4 + a5 * a5) + (a6 * a6 + a7 * a7); }
          ss += __shfl_xor(ss, 32);
          const float qs = (1.0f / sqrtf(ss * (1.0f / 128.0f) + EPS)) * (0.08838834764831845f * LOG2E);
#pragma unroll
          for (int s = 0; s < 8; ++s) { const f32x4 g0 = *(const f32x4*)(gq + 16 * s + 8 * hf), g1 = *(const f32x4*)(gq + 16 * s + 8 * hf + 4);
              v4u o; o.x = pk2(bf_lo(raw[s].x) * qs * g0.x, bf_hi(raw[s].x) * qs * g0.y); o.y = pk2(bf_lo(raw[s].y) * qs * g0.z, bf_hi(raw[s].y) * qs * g0.w);
              o.z = pk2(bf_lo(raw[s].z) * qs * g1.x, bf_hi(raw[s].z) * qs * g1.y); o.w = pk2(bf_lo(raw[s].w) * qs * g1.z, bf_hi(raw[s].w) * qs * g1.w);
              Qf[s] = __builtin_bit_cast(bf16x8, o); } }
        if (tid < 465) rpbL[tid] = P.in[I_RPB][h * 465 + tid] * LOG2E;
        const int rs_q = min(max(qr - 4, 0), NROWS - 8);
        const int krlo = min(max(4 * rg - 4, 0), NROWS - 8), krhi = min(max(4 * rg + 3 - 4, 0), NROWS - 8) + 7, ntl = krhi - krlo + 1, T = ntl + 4;
        const int cs = min(max(qc - 8, 0), GRIDW - 16);
        f32x16 O[4];
#pragma unroll
        for (int db = 0; db < 4; ++db)
#pragma unroll
            for (int i = 0; i < 16; ++i) O[db][i] = 0.f;
        float m_run = -1e30f, l_run = 0.f;
        v4u kreg[2], vreg[2];
#define ATT_LOAD(t) do { const int _tb = (t) < ntl ? b * SEQ + (krlo + (t)) * GRIDW : NT + b * CTXL + 64 * ((t) - ntl); \
        _Pragma("unroll") for (int _i = 0; _i < 2; ++_i) { const int _c = tid + 512 * _i, _key = _c >> 4, _ch = _c & 15; const size_t _o = (size_t)(_tb + _key) * 1024 + h * 128 + _ch * 8; \
            kreg[_i] = *(const GAS v4u*)(KK + _o); vreg[_i] = *(const GAS v4u*)(VV + _o); } } while (0)
#define ATT_STORE(buf) do { _Pragma("unroll") for (int _i = 0; _i < 2; ++_i) { const int _c = tid + 512 * _i, _key = _c >> 4, _ch = _c & 15; const unsigned _o = (buf) * 16384 + (_key >> 5) * 8192 + off_b(_key & 31, _ch); \
            *(LAS v4u*)(kbuf + _o) = kreg[_i]; *(LAS v4u*)(vbuf + _o) = vreg[_i]; } } while (0)
        ATT_LOAD(0); ATT_STORE(0);
        __syncthreads();
        for (int t = 0; t < T; ++t) {
            if (t + 1 < T) ATT_LOAD(t + 1);
            const bool local = t < ntl; const int kr = krlo + t;
            const bool active = !local || (kr >= rs_q && kr <= rs_q + 7);
            if (active) {
                const LAS unsigned char* kb_ = kbuf + (t & 1) * 16384; const LAS unsigned char* vb_ = vbuf + (t & 1) * 16384;
                f32x16 S0, S1;
#pragma unroll
                for (int i = 0; i < 16; ++i) { S0[i] = 0.f; S1[i] = 0.f; }
#pragma unroll
                for (int s = 0; s < 8; ++s) { const bf16x8 a0 = row_frag(kb_, lane, s), a1 = row_frag(kb_ + 8192, lane, s); S0 = MFMA32(a0, Qf[s], S0); S1 = MFMA32(a1, Qf[s], S1); }
                if (local) {
                    const int dr = kr - qr + 7;
#pragma unroll
                    for (int r = 0; r < 16; ++r) { const int kc0 = crow(r, hf), kc1 = 32 + kc0;
                        { const bool ok = (unsigned)(kc0 - cs) < 16u; const int ci = min(max(kc0 - qc + 15, 0), 30); const float bia = rpbL[dr * 31 + ci]; S0[r] = ok ? S0[r] + bia : -1e30f; }
                        { const bool ok = (unsigned)(kc1 - cs) < 16u; const int ci = min(max(kc1 - qc + 15, 0), 30); const float bia = rpbL[dr * 31 + ci]; S1[r] = ok ? S1[r] + bia : -1e30f; } }
                }
                float mt = S0[0];
#pragma unroll
                for (int r = 1; r < 16; ++r) mt = fmaxf(mt, S0[r]);
#pragma unroll
                for (int r = 0; r < 16; ++r) mt = fmaxf(mt, S1[r]);
                mt = fmaxf(mt, __shfl_xor(mt, 32));
                const float m_new = fmaxf(m_run, mt), alpha = fast_exp2(m_run - m_new);
                m_run = m_new;
                float ps = 0.f;
#pragma unroll
                for (int r = 0; r < 16; ++r) { S0[r] = fast_exp2(S0[r] - m_new); S1[r] = fast_exp2(S1[r] - m_new); ps += S0[r] + S1[r]; }
                l_run = l_run * alpha + ps;
#pragma unroll
                for (int db = 0; db < 4; ++db)
#pragma unroll
                    for (int i = 0; i < 16; ++i) O[db][i] *= alpha;
#pragma unroll
                for (int kb = 0; kb < 2; ++kb)
#pragma unroll
                    for (int s2 = 0; s2 < 2; ++s2) {
                        v4u pp;
                        if (kb == 0) { pp.x = pk2(S0[8 * s2 + 0], S0[8 * s2 + 1]); pp.y = pk2(S0[8 * s2 + 2], S0[8 * s2 + 3]); pp.z = pk2(S0[8 * s2 + 4], S0[8 * s2 + 5]); pp.w = pk2(S0[8 * s2 + 6], S0[8 * s2 + 7]); }
                        else         { pp.x = pk2(S1[8 * s2 + 0], S1[8 * s2 + 1]); pp.y = pk2(S1[8 * s2 + 2], S1[8 * s2 + 3]); pp.z = pk2(S1[8 * s2 + 4], S1[8 * s2 + 5]); pp.w = pk2(S1[8 * s2 + 6], S1[8 * s2 + 7]); }
                        const bf16x8 pf = __builtin_bit_cast(bf16x8, pp);
#pragma unroll
                        for (int db = 0; db < 4; ++db) { const bf16x8 a = tr_frag<true>(vb_ + kb * 8192, lane, db, s2); O[db] = MFMA32(a, pf, O[db]); }
                    }
            }
            if (t + 1 < T) ATT_STORE((t + 1) & 1);
            __syncthreads();
        }
#undef ATT_LOAD
#undef ATT_STORE
        const float inv = 1.0f / (l_run + __shfl_xor(l_run, 32));
        bf16* orow = CAT + (size_t)tq * D + 1024 + h * 128;
#pragma unroll
        for (int db = 0; db < 4; ++db)
#pragma unroll
            for (int rq = 0; rq < 4; ++rq) { v2u o; o.x = pk2(O[db][4 * rq + 0] * inv, O[db][4 * rq + 1] * inv); o.y = pk2(O[db][4 * rq + 2] * inv, O[db][4 * rq + 3] * inv);
                *(GAS v2u*)(orow + 32 * db + 8 * rq + 4 * hf) = o; }
    }
}

DI void phase_conv(const Params& P, int lane, int wave) {
    const bf16* BG = (const bf16*)(P.ws + WS_R2); const bf16* CZ = BG + (size_t)NT * D; bf16* WC = (bf16*)(P.ws + WS_R3);
    const float* cw = P.in[I_CONVW];
    const int gw = blockIdx.x * NWAVES + wave, NGW = gridDim.x * NWAVES;
    for (int tok = gw; tok < NT; tok += NGW) {
        const int n = tok & (SEQ - 1); const bool hasm = n > 0, hasp = n < SEQ - 1;
        const GAS v2u* bg = (const GAS v2u*)(BG + (size_t)tok * D) + lane; const GAS v2u* z0 = (const GAS v2u*)(CZ + (size_t)tok * D) + lane;
        const GAS v2u* zm = (const GAS v2u*)(CZ + (size_t)(tok - (hasm ? 1 : 0)) * D) + lane; const GAS v2u* zp = (const GAS v2u*)(CZ + (size_t)(tok + (hasp ? 1 : 0)) * D) + lane;
        GAS v2u* o = (GAS v2u*)(WC + (size_t)tok * D) + lane;
        const float fm = hasm ? 1.f : 0.f, fp = hasp ? 1.f : 0.f;
#pragma unroll
        for (int j = 0; j < 8; ++j) { const int c = 256 * j + 4 * lane;
            const f32x4 w0 = *(const f32x4*)(cw + c) * fm, w1 = *(const f32x4*)(cw + D + c), w2 = *(const f32x4*)(cw + 2 * D + c) * fp;
            const v2u b_ = bg[64 * j], a = zm[64 * j], m = z0[64 * j], p = zp[64 * j];
            const float r0 = bf_lo(b_.x) * (w0.x * bf_lo(a.x) + w1.x * bf_lo(m.x) + w2.x * bf_lo(p.x));
            const float r1 = bf_hi(b_.x) * (w0.y * bf_hi(a.x) + w1.y * bf_hi(m.x) + w2.y * bf_hi(p.x));
            const float r2 = bf_lo(b_.y) * (w0.z * bf_lo(a.y) + w1.z * bf_lo(m.y) + w2.z * bf_lo(p.y));
            const float r3 = bf_hi(b_.y) * (w0.w * bf_hi(a.y) + w1.w * bf_hi(m.y) + w2.w * bf_hi(p.y));
            v2u w; w.x = pk2(r0, r1); w.y = pk2(r2, r3); o[64 * j] = w; }
    }
}

constexpr int NPHASE = 21;
__global__ void __launch_bounds__(NWAVES * 64, 2) mega_fwd(Params P) {
    extern __shared__ __attribute__((aligned(16))) unsigned char lds_raw[];
    LAS unsigned char* lds = (LAS unsigned char*)lds_raw;
    volatile LAS unsigned* MISC = (volatile LAS unsigned*)(lds + MISC_OFF);
    const int tid = threadIdx.x, lane = tid & 63, wave = __builtin_amdgcn_readfirstlane(tid >> 6);
    for (int u = tid; u < (LDS_BYTES - LDSCTL_OFF) / 4; u += NWAVES * 64) ((LAS unsigned*)(lds + LDSCTL_OFF))[u] = 0u;
    __syncthreads();
    unsigned* barw = (unsigned*)(P.ws + WS_CTL + CTL_BAR) + (size_t)P.li * XCD_BAR_WORDS;
    XcdBarrier bar; bar.bar = barw; bar.x = 0; bar.st = nullptr;
    const int lo = P.ph_lo, hi = P.ph_hi;
    if (hi - lo > 1) bar = xcd_barrier_post(barw, MISC + 8);
#define IN(k) (lo <= (k) && (k) < hi)
#define RUN(k, ...) do { if (IN(k)) { __VA_ARGS__; if constexpr ((k) == MK_DUP) { __VA_ARGS__; } } } while (0)
#define SEAM(k) do { if (IN(k) && IN((k) + 1)) xcd_barrier(bar); } while (0)
    unsigned char* ws = P.ws;
    const int G = gridDim.x, cid = blockIdx.x;
    const float* MOD = (const float*)(ws + WS_MOD);

    RUN(0, phase_prologue(P, lds, tid, lane, wave); __syncthreads()); SEAM(0);
    RUN(1, phase_norm1_l0(P, lds, tid, lane, wave)); SEAM(1);
#define GEMM_IN0() do { { pg8::Gemm g{(const bf16*)(ws + WS_H), (const bf16*)(ws + WS_WIN0), NT, 2048, D}; pg8::StaticOrder<false> S; S.init(NT, 2048, G, cid); \
        EpiIn0 E{(bf16*)(ws + WS_R2), 0, 1.0f}; pg8::gemm_phase<EpiIn0, pg8::StaticOrder<false>, true, true>(lds, g, S, E); } \
      { const bool withctx = G < 64; pg8::Gemm g{(const bf16*)(ws + WS_H8), (const bf16*)(ws + WS_WIN0F8), withctx ? MTOT : NT, 3072, D / 2}; pg8::StaticOrder<false> S; S.init(withctx ? MTOT : NT, 3072, G, cid); \
        EpiIn0 E{(bf16*)(ws + WS_R2), 2, F8_WINV}; pg8::gemm_phase<EpiIn0, pg8::StaticOrder<false>, true, true, true>(lds, g, S, E); } } while (0)
    RUN(2, GEMM_IN0()); SEAM(2);
    if (IN(3)) phase_knorm(P, lane, wave);
    RUN(3, phase_gmlp(P, lds, tid, lane, wave)); SEAM(3);
    RUN(4, phase_attn(P, lds, tid, lane, wave)); SEAM(4);
#define GEMM_OUT0() do { pg8::Gemm g{(const bf16*)(ws + WS_R3), (const bf16*)(ws + WS_WOUT0), NT, D, D}; pg8::StaticOrder<false> S; S.init(NT, D, G, cid); \
        EpiResid E{P.in[I_X], P.out, MOD + 2 * 2048}; pg8::gemm_phase<EpiResid, pg8::StaticOrder<false>, true, true>(lds, g, S, E); } while (0)
    RUN(5, GEMM_OUT0()); SEAM(5);
#define GEMM_GU(L) do { constexpr bool F8 = F8L(L); pg8::Gemm g{(const bf16*)(ws + WS_R2), (const bf16*)(ws + WS_GU) + (size_t)(L) * 16 * 2048 * 2048, 65536, 2048, F8 ? D / 2 : D}; pg8::StaticOrder<true> S; S.init(65536, 2048, G, cid); \
        EpiSwiglu<F8> E{(void*)((bf16*)(ws + WS_R2) + (size_t)65536 * D)}; pg8::gemm_phase<EpiSwiglu<F8>, pg8::StaticOrder<true>, true, true, F8>(lds, g, S, E); } while (0)
#define GEMM_DN(L) do { constexpr bool F8 = F8L(L); pg8::Gemm g{(const bf16*)(ws + WS_R2) + (size_t)65536 * D, (const bf16*)(ws + WS_DN) + (size_t)(L) * 16 * 2048 * 1024, 65536, 2048, F8 ? FF / 2 : FF}; pg8::StaticOrder<true> S; S.init(65536, 2048, G, cid); \
        EpiPlain E{(bf16*)(ws + WS_R3), D, F8 ? F8_WINV : 1.0f}; pg8::gemm_phase<EpiPlain, pg8::StaticOrder<true>, true, true, F8>(lds, g, S, E); } while (0)
#define MOE_PHASES(L, base) \
    RUN(base + 0, phase_norm2_router(P, L, lds, tid, lane, wave)); SEAM(base + 0); \
    if (IN(base + 1)) { phase_topk(P, L, lds, tid, lane, wave); } SEAM(base + 1); \
    RUN(base + 2, phase_gather<F8L(L)>(P, lane, wave)); SEAM(base + 2); \
    RUN(base + 3, GEMM_GU(L)); SEAM(base + 3); \
    RUN(base + 4, GEMM_DN(L)); SEAM(base + 4);
    MOE_PHASES(0, 6)
    if (IN(11)) { phase_combine<true>(P, 0, lane, wave); } SEAM(11);
#define GEMM_CIN() do { pg8::Gemm g{(const bf16*)(ws + WS_H), (const bf16*)(ws + WS_WCIN), NT, 6144, D}; pg8::StaticOrder<false> S; S.init(NT, 6144, G, cid); S.hot = NOST; \
        EpiCin E{(bf16*)(ws + WS_R2), (bf16*)(ws + WS_R2) + (size_t)NT * D, NOST}; pg8::gemm_phase<EpiCin, pg8::StaticOrder<false>, true, true>(lds, g, S, E); } while (0)
#define NOST 0
    RUN(12, GEMM_CIN()); SEAM(12);
#undef NOST
#if MK_DUP == 112
#define NOST (P.pad + 1)
    if (IN(12)) { GEMM_CIN(); }
#undef NOST
#endif
    RUN(13, phase_conv(P, lane, wave)); SEAM(13);
    if (IN(14)) {
        pg8::Gemm g{(const bf16*)(ws + WS_R3), (const bf16*)(ws + WS_WCOUT), NT, D, D}; pg8::StaticOrder<false> S; S.init(NT, D, G, cid);
        EpiResid E{P.out, P.out, MOD + 3 * 12288 + 2 * 2048};
        pg8::gemm_phase<EpiResid, pg8::StaticOrder<false>, true, true>(lds, g, S, E);
    } SEAM(14);
    MOE_PHASES(1, 15)
    if (IN(20)) { phase_combine<false>(P, 1, lane, wave); }
#undef IN
#undef SEAM
}

extern "C" void kernel_launch(void* const* d_in, const int* in_sizes, int n_in, void* d_out, int out_size, void* d_ws, size_t ws_size, hipStream_t stream) {
    static int grid = 0;
    if (grid == 0) {
        if (n_in != 23 || out_size != NT * D || ws_size < WS_END) { fprintf(stderr, "kernel_launch: unexpected shapes (n_in %d out %d ws %zu)\n", n_in, out_size, ws_size); grid = -1; return; }
        int dev = 0, cus = 0, per_cu = 0;
        if (hipGetDevice(&dev) != hipSuccess || hipDeviceGetAttribute(&cus, hipDeviceAttributeMultiprocessorCount, dev) != hipSuccess) { grid = -1; return; }
        if (hipFuncSetAttribute((const void*)mega_fwd, hipFuncAttributeMaxDynamicSharedMemorySize, LDS_BYTES) != hipSuccess) { fprintf(stderr, "kernel_launch: hipFuncSetAttribute failed\n"); grid = -1; return; }
        if (hipOccupancyMaxActiveBlocksPerMultiprocessor(&per_cu, (const void*)mega_fwd, NWAVES * 64, LDS_BYTES) != hipSuccess || per_cu < 1) { fprintf(stderr, "kernel_launch: occupancy query says %d\n", per_cu); }
        (void)hipGetLastError();
        grid = cus;
    }
    if (grid < 0) return;
    (void)hipMemsetAsync((char*)d_ws + WS_CTL, 0, CTL_ZERO_BYTES, stream);
    Params p{};
    for (int i = 0; i < 23; ++i) p.in[i] = (const float*)d_in[i];
    p.out = (float*)d_out; p.ws = (unsigned char*)d_ws; p.pad = 0;
    const int last = MK_STOP < NPHASE - 1 ? MK_STOP : NPHASE - 1;
#if MK_SPLIT
    for (int k = 0; k <= last; ++k) { p.ph_lo = k; p.ph_hi = k + 1; p.li = 0; hipLaunchKernelGGL(mega_fwd, dim3(grid), dim3(NWAVES * 64), LDS_BYTES, stream, p); }
#else
    p.ph_lo = 0; p.ph_hi = last + 1; p.li = 0;
    hipLaunchKernelGGL(mega_fwd, dim3(grid), dim3(NWAVES * 64), LDS_BYTES, stream, p);
#endif
}
```

```cpp
#include <hip/hip_runtime.h>
#include <cstdio>
#include <cstdint>

#ifndef MK_SPLIT
#define MK_SPLIT 0
#endif
#ifndef MK_STOP
#define MK_STOP 99
#endif
#ifndef MK_FP8_L0
#define MK_FP8_L0 1
#endif
#ifndef MK_FP8_L1
#define MK_FP8_L1 1
#endif
#ifndef MK_DUP
#define MK_DUP -1
#endif

namespace pg8 {
#define PG8_LAS __attribute__((address_space(3)))
typedef unsigned short bf16_t;
typedef short bf16x8 __attribute__((ext_vector_type(8)));
typedef float f32x4 __attribute__((ext_vector_type(4)));
typedef unsigned u32x4 __attribute__((ext_vector_type(4)));
constexpr int BM = 256, BK = 64, HALF = 128, HTB = HALF * BK * 2, STAGE_BYTES = 8 * HTB, NXCD = 8, WGM = 8;

__host__ __device__ __forceinline__ int lds_byte(int r, int c) { const int st = (r >> 4) * 2 + (c >> 5), rr = r & 15, cc = c & 31, ob = rr * 64 + cc * 2; return st * 1024 + (ob ^ (((ob >> 9) & 1) << 5)); }
__host__ __device__ __forceinline__ void stage_rc(int b, int& R, int& C) { const int st = b / 1024, sb = b % 1024, swz = sb ^ (((sb >> 9) & 1) << 5); R = (st >> 1) * 16 + swz / 64; C = (st & 1) * 32 + (swz % 64) / 2; }
__host__ __device__ __forceinline__ int perm32(int rho) { const int n = rho >> 4, i = rho & 15; return 8 * (i >> 2) + 4 * n + (i & 3); }

struct Unit { int pm, pn, pb; };
struct Gemm { const bf16_t* A; const bf16_t* Bt; int M, N, K; };

template <bool GROUPED>
struct StaticOrder {
    int nM, nN, nwg, G, c, hot;
    __host__ __device__ void init(int M, int N, int G_, int c_) { nM = M / BM; nN = N / BM; nwg = nM * nN; G = G_; c = c_; hot = 0; }
    __host__ __device__ __forceinline__ bool next(int i, Unit& u) const {
        const long L = (long)i * G + c; if (L >= nwg) return false;
        int wgid = (int)L; { const int q = nwg / NXCD, r = nwg % NXCD, xcd = wgid % NXCD, off = wgid / NXCD; wgid = (xcd < r ? xcd * (q + 1) : r * (q + 1) + (xcd - r) * q) + off; }
        const int nig = WGM * nN, gid = wgid / nig, fm = gid * WGM, gsz = (nM - fm) < WGM ? (nM - fm) : WGM;
        u.pm = fm + ((wgid % nig) % gsz); u.pn = (wgid % nig) / gsz;
        u.pb = GROUPED ? ((u.pm >> 4) * 8 + u.pn) : u.pn;
        if (hot) { u.pm = 0; u.pn = 0; u.pb = 0; }
        return true;
    }
    __device__ __forceinline__ void a_ready(const Unit&) const {}
    __device__ __forceinline__ void done(const Unit&) const {}
};

__device__ __forceinline__ unsigned cvt_pk_bf16(float lo, float hi) { unsigned r; asm volatile("v_cvt_pk_bf16_f32 %0, %1, %2" : "=v"(r) : "v"(lo), "v"(hi)); return r; }

typedef int i32x4 __attribute__((ext_vector_type(4)));
typedef int i32x8 __attribute__((ext_vector_type(8)));
__device__ __forceinline__ i32x8 cat8(bf16x8 lo, bf16x8 hi) { return __builtin_shufflevector(__builtin_bit_cast(i32x4, lo), __builtin_bit_cast(i32x4, hi), 0, 1, 2, 3, 4, 5, 6, 7); }
template <class Epi, class Sched, bool ALIGN_EPI = false, bool SP2 = false, bool FP8 = false>
__device__ __forceinline__ void gemm_phase(PG8_LAS unsigned char* lds, const Gemm g, const Sched& S, const Epi& E) {
    const int tid = threadIdx.x, wid = __builtin_amdgcn_readfirstlane(tid >> 6), lane = tid & 63, wr = wid >> 2, wc = wid & 3, fr = lane & 15, fq = lane >> 4;
    const int K = g.K, nt = K / BK;
    unsigned voffA[2], voffB[2];
#pragma unroll
    for (int i = 0; i < 2; ++i) { int R, C; stage_rc(tid * 16 + i * 8192, R, C); const int Rb = Epi::PERM ? ((R & ~31) + perm32(R & 31)) : R;
        voffA[i] = (unsigned)(R * K + C) * 2u; voffB[i] = (unsigned)(Rb * K + C) * 2u; }
    const size_t kstep = (size_t)(BK * 2);
    const size_t hstep = (size_t)HALF * K * 2;
    const size_t tstep = 2 * hstep;
    const unsigned ldsw = (unsigned)wid * 1024u;
    const int aoff = lds_byte(wr * 64 + fr, fq * 8), boff = lds_byte(wc * 32 + fr, fq * 8);
#define PG8_SA(b, h) (((b) * 2 + (h)) * HTB)
#define PG8_SB(b, h) ((4 + (b) * 2 + (h)) * HTB)
#define PG8_STAGE(bufoff, gbase, voff) do { _Pragma("unroll") for (int _i = 0; _i < 2; ++_i) \
        __builtin_amdgcn_global_load_lds((const unsigned*)((const char*)(gbase) + (voff)[_i]), (PG8_LAS unsigned*)(lds + (bufoff) + ldsw + _i * 8192), 16, 0, 0); } while (0)
#define PG8_LDA(dst, b, h) do { _Pragma("unroll") for (int m = 0; m < 4; ++m) _Pragma("unroll") for (int k = 0; k < 2; ++k) dst[m][k] = *(const PG8_LAS bf16x8*)(lds + PG8_SA(b, h) + aoff + m * 2048 + k * 1024); } while (0)
#define PG8_LDB(dst, b, h) do { _Pragma("unroll") for (int n = 0; n < 2; ++n) _Pragma("unroll") for (int k = 0; k < 2; ++k) dst[n][k] = *(const PG8_LAS bf16x8*)(lds + PG8_SB(b, h) + boff + n * 2048 + k * 1024); } while (0)
#define PG8_MMA(ai, bj, At, Bt) do { __builtin_amdgcn_s_setprio(1); _Pragma("unroll") for (int m = 0; m < 4; ++m) _Pragma("unroll") for (int n = 0; n < 2; ++n) { \
        if constexpr (FP8) { const i32x8 _a = cat8(Bt[n][0], Bt[n][1]), _b = cat8(At[m][0], At[m][1]); asm volatile("v_mfma_f32_16x16x128_f8f6f4 %0, %1, %2, %0" : "+v"(acc[ai][bj][m][n]) : "v"(_a), "v"(_b)); } \
        else { _Pragma("unroll") for (int k = 0; k < 2; ++k) acc[ai][bj][m][n] = __builtin_amdgcn_mfma_f32_16x16x32_bf16(Bt[n][k], At[m][k], acc[ai][bj][m][n], 0, 0, 0); } } \
        __builtin_amdgcn_s_setprio(0); } while (0)
#define PG8_WAIT_V(n) asm volatile("s_waitcnt vmcnt(" #n ")" ::: "memory")
#define PG8_WAIT_L(n) asm volatile("s_waitcnt lgkmcnt(" #n ")" ::: "memory")
#define PG8_BAR __builtin_amdgcn_s_barrier()
#define PG8_SCHED __builtin_amdgcn_sched_barrier(0)
    Unit cur, nxt; int ui = 0;
    if (!S.next(0, cur)) return;
    f32x4 acc[2][2][4][2];
#pragma unroll
    for (int a = 0; a < 2; ++a)
#pragma unroll
        for (int b = 0; b < 2; ++b)
#pragma unroll
            for (int m = 0; m < 4; ++m)
#pragma unroll
                for (int n = 0; n < 2; ++n) acc[a][b][m][n] = (f32x4){0.f, 0.f, 0.f, 0.f};
    bf16x8 At[4][2], B0[2][2], B1[2][2];
    const char* cA = (const char*)g.A + (size_t)cur.pm * tstep; const char* cB = (const char*)g.Bt + (size_t)cur.pb * tstep;
    S.a_ready(cur);
    if constexpr (SP2) {
        PG8_STAGE(PG8_SB(0, 0), cB, voffB); PG8_STAGE(PG8_SB(0, 1), cB + hstep, voffB); PG8_STAGE(PG8_SA(0, 0), cA, voffA); PG8_STAGE(PG8_SA(0, 1), cA + hstep, voffA);
        if (wr == 1) PG8_BAR;
        PG8_WAIT_V(2); PG8_BAR;
        PG8_STAGE(PG8_SB(1, 0), cB + kstep, voffB); PG8_STAGE(PG8_SA(1, 0), cA + kstep, voffA); PG8_STAGE(PG8_SB(1, 1), cB + hstep + kstep, voffB);
        PG8_WAIT_V(6); PG8_BAR;
    } else {
        PG8_STAGE(PG8_SB(0, 0), cB, voffB); PG8_STAGE(PG8_SA(0, 0), cA, voffA); PG8_STAGE(PG8_SB(0, 1), cB + hstep, voffB); PG8_STAGE(PG8_SA(0, 1), cA + hstep, voffA);
        if (wr == 1) PG8_BAR;
        PG8_WAIT_V(4); PG8_BAR;
        PG8_STAGE(PG8_SB(1, 0), cB + kstep, voffB); PG8_STAGE(PG8_SA(1, 0), cA + kstep, voffA); PG8_STAGE(PG8_SB(1, 1), cB + hstep + kstep, voffB);
        PG8_WAIT_V(6); PG8_BAR;
    }
    for (;;) {
        const bool has_next = S.next(ui + 1, nxt);
        const char* nA = has_next ? (const char*)g.A + (size_t)nxt.pm * tstep : cA; const char* nB = has_next ? (const char*)g.Bt + (size_t)nxt.pb * tstep : cB;
        for (int t = 0; t < nt; t += 2) {
            const bool last = (t == nt - 2);
            const char* a1 = cA + (size_t)(t + 1) * kstep;
            const char* a2 = last ? nA : cA + (size_t)(t + 2) * kstep; const char* b2 = last ? nB : cB + (size_t)(t + 2) * kstep;
            const char* a3 = a2 + kstep; const char* b3 = b2 + kstep;
            if (last && has_next) S.a_ready(nxt);
            if constexpr (SP2) {
            PG8_LDB(B0, 0, 0); PG8_LDB(B1, 0, 1); PG8_SCHED; PG8_LDA(At, 0, 0); PG8_STAGE(PG8_SA(1, 1), a1 + hstep, voffA);
            PG8_WAIT_V(8); PG8_WAIT_L(0); PG8_BAR; PG8_MMA(0, 0, At, B0); PG8_MMA(0, 1, At, B1); PG8_BAR; PG8_SCHED;
            PG8_LDA(At, 0, 1); PG8_STAGE(PG8_SB(0, 0), b2, voffB); PG8_STAGE(PG8_SB(0, 1), b2 + hstep, voffB); PG8_STAGE(PG8_SA(0, 0), a2, voffA);
            PG8_WAIT_V(8); PG8_WAIT_L(0); PG8_BAR; PG8_MMA(1, 0, At, B0); PG8_MMA(1, 1, At, B1); PG8_BAR; PG8_SCHED;
            PG8_LDB(B0, 1, 0); PG8_LDB(B1, 1, 1); PG8_SCHED; PG8_LDA(At, 1, 0); PG8_STAGE(PG8_SA(0, 1), a2 + hstep, voffA);
            PG8_WAIT_V(8); PG8_WAIT_L(0); PG8_BAR; PG8_MMA(0, 0, At, B0); PG8_MMA(0, 1, At, B1); PG8_BAR; PG8_SCHED;
            PG8_LDA(At, 1, 1); PG8_STAGE(PG8_SB(1, 0), b3, voffB); PG8_STAGE(PG8_SB(1, 1), b3 + hstep, voffB); PG8_STAGE(PG8_SA(1, 0), a3, voffA);
            PG8_WAIT_V(8); PG8_WAIT_L(0); PG8_BAR; PG8_MMA(1, 0, At, B0); PG8_MMA(1, 1, At, B1); PG8_BAR; PG8_SCHED;
            } else {
            PG8_LDB(B0, 0, 0); PG8_SCHED; PG8_LDA(At, 0, 0); PG8_STAGE(PG8_SA(1, 1), a1 + hstep, voffA);
            PG8_WAIT_L(8); PG8_BAR; PG8_WAIT_L(0); PG8_MMA(0, 0, At, B0); PG8_BAR; PG8_SCHED;
            PG8_LDB(B1, 0, 1); PG8_STAGE(PG8_SB(0, 0), b2, voffB);
            PG8_BAR; PG8_WAIT_L(0); PG8_MMA(0, 1, At, B1); PG8_BAR;
            PG8_LDA(At, 0, 1); PG8_STAGE(PG8_SA(0, 0), a2, voffA);
            PG8_BAR; PG8_WAIT_L(0); PG8_MMA(1, 0, At, B0); PG8_BAR; PG8_SCHED;
            PG8_STAGE(PG8_SB(0, 1), b2 + hstep, voffB);
            PG8_WAIT_V(6); PG8_BAR; PG8_MMA(1, 1, At, B1); PG8_BAR;
            PG8_LDB(B0, 1, 0); PG8_SCHED; PG8_LDA(At, 1, 0); PG8_STAGE(PG8_SA(0, 1), a2 + hstep, voffA);
            PG8_WAIT_L(8); PG8_BAR; PG8_WAIT_L(0); PG8_MMA(0, 0, At, B0); PG8_BAR; PG8_SCHED;
            PG8_LDB(B1, 1, 1); PG8_STAGE(PG8_SB(1, 0), b3, voffB);
            PG8_BAR; PG8_WAIT_L(0); PG8_MMA(0, 1, At, B1); PG8_BAR;
            PG8_LDA(At, 1, 1); PG8_STAGE(PG8_SA(1, 0), a3, voffA);
            PG8_BAR; PG8_WAIT_L(0); PG8_MMA(1, 0, At, B0); PG8_BAR; PG8_SCHED;
            PG8_STAGE(PG8_SB(1, 1), b3 + hstep, voffB);
            PG8_WAIT_V(6); PG8_BAR; PG8_MMA(1, 1, At, B1); PG8_BAR;
            }
        }
        if constexpr (ALIGN_EPI) { if (wr == 0) PG8_BAR; }
        if constexpr (FP8) asm volatile("s_nop 7\n\ts_nop 7\n\ts_nop 7" ::: "memory");
        E(acc, cur, wr, wc, fr, fq);
        if (!has_next) break;
#pragma unroll
        for (int a = 0; a < 2; ++a)
#pragma unroll
            for (int b = 0; b < 2; ++b)
#pragma unroll
                for (int m = 0; m < 4; ++m)
#pragma unroll
                    for (int n = 0; n < 2; ++n) acc[a][b][m][n] = (f32x4){0.f, 0.f, 0.f, 0.f};
        cur = nxt; cA = nA; cB = nB; ++ui;
        if constexpr (ALIGN_EPI) { if (wr == 1) PG8_BAR; }
    }
    PG8_WAIT_V(0);
    if constexpr (!ALIGN_EPI) { if (wr == 0) PG8_BAR; }
    PG8_BAR;
#undef PG8_SA
#undef PG8_SB
#undef PG8_STAGE
#undef PG8_LDA
#undef PG8_LDB
#undef PG8_MMA
#undef PG8_WAIT_V
#undef PG8_WAIT_L
#undef PG8_BAR
#undef PG8_SCHED
}

template <class Epi, class Sched>
__device__ __forceinline__ void gemm_phase_gather_f8(PG8_LAS unsigned char* lds, const Gemm g, const Sched& S, const Epi& E, const PG8_LAS int* tbl) {
    const int tid = threadIdx.x, wid = __builtin_amdgcn_readfirstlane(tid >> 6), lane = tid & 63, wr = wid >> 2, wc = wid & 3, fr = lane & 15, fq = lane >> 4;
    const int K = g.K, nt = K / BK;
    const unsigned rowb = (unsigned)K * 2u;
    unsigned voffB[2]; int RA[2]; unsigned CA[2];
#pragma unroll
    for (int i = 0; i < 2; ++i) { int R, C; stage_rc(tid * 16 + i * 8192, R, C); const int Rb = Epi::PERM ? ((R & ~31) + perm32(R & 31)) : R;
        RA[i] = R; CA[i] = (unsigned)C * 2u; voffB[i] = (unsigned)(Rb * K + C) * 2u; }
    const size_t kstep = (size_t)(BK * 2);
    const size_t hstep = (size_t)HALF * K * 2;
    const size_t tstep = 2 * hstep;
    const unsigned ldsw = (unsigned)wid * 1024u;
    const int aoff = lds_byte(wr * 64 + fr, fq * 8), boff = lds_byte(wc * 32 + fr, fq * 8);
#define PG8_SA(b, h) (((b) * 2 + (h)) * HTB)
#define PG8_SB(b, h) ((4 + (b) * 2 + (h)) * HTB)
#define PG8_STAGE(bufoff, gbase, voff) do { _Pragma("unroll") for (int _i = 0; _i < 2; ++_i) \
        __builtin_amdgcn_global_load_lds((const unsigned*)((const char*)(gbase) + (voff)[_i]), (PG8_LAS unsigned*)(lds + (bufoff) + ldsw + _i * 8192), 16, 0, 0); } while (0)
#define PG8_STAGE_G(bufoff, koff, o0, o1) do { \
        __builtin_amdgcn_global_load_lds((const unsigned*)(gA + (koff) + (o0)), (PG8_LAS unsigned*)(lds + (bufoff) + ldsw), 16, 0, 0); \
        __builtin_amdgcn_global_load_lds((const unsigned*)(gA + (koff) + (o1)), (PG8_LAS unsigned*)(lds + (bufoff) + ldsw + 8192), 16, 0, 0); } while (0)
#define PG8_LDA(dst, b, h) do { _Pragma("unroll") for (int m = 0; m < 4; ++m) _Pragma("unroll") for (int k = 0; k < 2; ++k) dst[m][k] = *(const PG8_LAS bf16x8*)(lds + PG8_SA(b, h) + aoff + m * 2048 + k * 1024); } while (0)
#define PG8_LDB(dst, b, h) do { _Pragma("unroll") for (int n = 0; n < 2; ++n) _Pragma("unroll") for (int k = 0; k < 2; ++k) dst[n][k] = *(const PG8_LAS bf16x8*)(lds + PG8_SB(b, h) + boff + n * 2048 + k * 1024); } while (0)
#define PG8_MMA(ai, bj, At, Bt) do { __builtin_amdgcn_s_setprio(1); _Pragma("unroll") for (int m = 0; m < 4; ++m) _Pragma("unroll") for (int n = 0; n < 2; ++n) { \
        const i32x8 _a = cat8(Bt[n][0], Bt[n][1]), _b = cat8(At[m][0], At[m][1]); asm volatile("v_mfma_f32_16x16x128_f8f6f4 %0, %1, %2, %0" : "+v"(acc[ai][bj][m][n]) : "v"(_a), "v"(_b)); } \
        __builtin_amdgcn_s_setprio(0); } while (0)
#define PG8_WAIT_V(n) asm volatile("s_waitcnt vmcnt(" #n ")" ::: "memory")
#define PG8_WAIT_L(n) asm volatile("s_waitcnt lgkmcnt(" #n ")" ::: "memory")
#define PG8_BAR __builtin_amdgcn_s_barrier()
#define PG8_SCHED __builtin_amdgcn_sched_barrier(0)
#define PG8_OFFS(dst, ui_) do { _Pragma("unroll") for (int _h = 0; _h < 2; ++_h) _Pragma("unroll") for (int _i = 0; _i < 2; ++_i) \
        dst[_h][_i] = (unsigned)tbl[(ui_) * 256 + _h * HALF + RA[_i]] * rowb + CA[_i]; } while (0)
    Unit cur, nxt; int ui = 0;
    if (!S.next(0, cur)) return;
    const char* gA = (const char*)g.A;
    unsigned oc[2][2], on[2][2];
    PG8_OFFS(oc, 0);
    f32x4 acc[2][2][4][2];
#pragma unroll
    for (int a = 0; a < 2; ++a)
#pragma unroll
        for (int b = 0; b < 2; ++b)
#pragma unroll
            for (int m = 0; m < 4; ++m)
#pragma unroll
                for (int n = 0; n < 2; ++n) acc[a][b][m][n] = (f32x4){0.f, 0.f, 0.f, 0.f};
    bf16x8 At[4][2], B0[2][2], B1[2][2];
    const char* cB = (const char*)g.Bt + (size_t)cur.pb * tstep;
    PG8_STAGE(PG8_SB(0, 0), cB, voffB); PG8_STAGE(PG8_SB(0, 1), cB + hstep, voffB); PG8_STAGE_G(PG8_SA(0, 0), 0, oc[0][0], oc[0][1]); PG8_STAGE_G(PG8_SA(0, 1), 0, oc[1][0], oc[1][1]);
    if (wr == 1) PG8_BAR;
    PG8_WAIT_V(2); PG8_BAR;
    PG8_STAGE(PG8_SB(1, 0), cB + kstep, voffB); PG8_STAGE_G(PG8_SA(1, 0), kstep, oc[0][0], oc[0][1]); PG8_STAGE(PG8_SB(1, 1), cB + hstep + kstep, voffB);
    PG8_WAIT_V(6); PG8_BAR;
    for (;;) {
        const bool has_next = S.next(ui + 1, nxt);
        const char* nB = has_next ? (const char*)g.Bt + (size_t)nxt.pb * tstep : cB;
        if (has_next) PG8_OFFS(on, ui + 1);
        else {
#pragma unroll
            for (int _h = 0; _h < 2; ++_h)
#pragma unroll
                for (int _i = 0; _i < 2; ++_i) on[_h][_i] = oc[_h][_i]; }
        for (int t = 0; t < nt; t += 2) {
            const bool last = (t == nt - 2);
            const size_t k1 = (size_t)(t + 1) * kstep, k2 = last ? 0 : (size_t)(t + 2) * kstep, k3 = k2 + kstep;
            const char* b2 = last ? nB : cB + (size_t)(t + 2) * kstep; const char* b3 = b2 + kstep;
            const unsigned o00 = last ? on[0][0] : oc[0][0], o01 = last ? on[0][1] : oc[0][1], o10 = last ? on[1][0] : oc[1][0], o11 = last ? on[1][1] : oc[1][1];
            PG8_LDB(B0, 0, 0); PG8_LDB(B1, 0, 1); PG8_SCHED; PG8_LDA(At, 0, 0); PG8_STAGE_G(PG8_SA(1, 1), k1, oc[1][0], oc[1][1]);
            PG8_WAIT_V(8); PG8_WAIT_L(0); PG8_BAR; PG8_MMA(0, 0, At, B0); PG8_MMA(0, 1, At, B1); PG8_BAR; PG8_SCHED;
            PG8_LDA(At, 0, 1); PG8_STAGE(PG8_SB(0, 0), b2, voffB); PG8_STAGE(PG8_SB(0, 1), b2 + hstep, voffB); PG8_STAGE_G(PG8_SA(0, 0), k2, o00, o01);
            PG8_WAIT_V(8); PG8_WAIT_L(0); PG8_BAR; PG8_MMA(1, 0, At, B0); PG8_MMA(1, 1, At, B1); PG8_BAR; PG8_SCHED;
            PG8_LDB(B0, 1, 0); PG8_LDB(B1, 1, 1); PG8_SCHED; PG8_LDA(At, 1, 0); PG8_STAGE_G(PG8_SA(0, 1), k2, o10, o11);
            PG8_WAIT_V(8); PG8_WAIT_L(0); PG8_BAR; PG8_MMA(0, 0, At, B0); PG8_MMA(0, 1, At, B1); PG8_BAR; PG8_SCHED;
            PG8_LDA(At, 1, 1); PG8_STAGE(PG8_SB(1, 0), b3, voffB); PG8_STAGE(PG8_SB(1, 1), b3 + hstep, voffB); PG8_STAGE_G(PG8_SA(1, 0), k3, o00, o01);
            PG8_WAIT_V(8); PG8_WAIT_L(0); PG8_BAR; PG8_MMA(1, 0, At, B0); PG8_MMA(1, 1, At, B1); PG8_BAR; PG8_SCHED;
        }
        if (wr == 0) PG8_BAR;
        asm volatile("s_nop 7\n\ts_nop 7\n\ts_nop 7" ::: "memory");
        E(acc, cur, wr, wc, fr, fq);
        if (!has_next) break;
#pragma unroll
        for (int a = 0; a < 2; ++a)
#pragma unroll
            for (int b = 0; b < 2; ++b)
#pragma unroll
                for (int m = 0; m < 4; ++m)
#pragma unroll
                    for (int n = 0; n < 2; ++n) acc[a][b][m][n] = (f32x4){0.f, 0.f, 0.f, 0.f};
        cur = nxt; cB = nB; ++ui;
#pragma unroll
        for (int _h = 0; _h < 2; ++_h)
#pragma unroll
            for (int _i = 0; _i < 2; ++_i) oc[_h][_i] = on[_h][_i];
        if (wr == 1) PG8_BAR;
    }
    PG8_WAIT_V(0);
    PG8_BAR;
#undef PG8_SA
#undef PG8_SB
#undef PG8_STAGE
#undef PG8_STAGE_G
#undef PG8_LDA
#undef PG8_LDB
#undef PG8_MMA
#undef PG8_WAIT_V
#undef PG8_WAIT_L
#undef PG8_BAR
#undef PG8_SCHED
#undef PG8_OFFS
}
}

constexpr int D = 2048, NB = 2, SEQ = 16384, NT = NB * SEQ, CTXL = 256, NCTX = NB * CTXL, MTOT = NT + NCTX;
constexpr int NEXP = 16, CAP = 2048, FF = 1024, GRIDW = 64, NROWS = 256;
constexpr float EPS = 1e-6f;
constexpr float LOG2E = 1.4426950408889634f;
constexpr int NWAVES = 8;

constexpr size_t MiB = 1u << 20;
constexpr size_t WS_CTL = 0, CTL_ZERO_BYTES = 1 * MiB;
constexpr size_t CTL_TOKCNT0 = 262144, CTL_TOKCNT1 = 393216, CTL_BAR = 524288;
constexpr size_t WS_MOD = 1 * MiB;
constexpr size_t WS_AFF = 2 * MiB;
constexpr size_t WS_IDX = 4 * MiB;
constexpr size_t WS_TOKLIST = 5 * MiB;
constexpr size_t WS_WSB = 9 * MiB;
constexpr size_t WS_WIN0 = 10 * MiB, WS_WOUT0 = 30 * MiB, WS_WCIN = 38 * MiB, WS_WCOUT = 62 * MiB;
constexpr size_t WS_GU = 70 * MiB;
constexpr size_t WS_DN = 326 * MiB;
constexpr size_t WS_H = 454 * MiB;
constexpr size_t WS_R2 = 584 * MiB;
constexpr size_t WS_R3 = 968 * MiB;
constexpr size_t WS_H8 = 1224 * MiB;
constexpr size_t WS_END = 1289 * MiB;
constexpr size_t WS_WIN0F8 = WS_WIN0 + 8 * MiB;
constexpr size_t WS_XLB = WS_R2 + 256 * MiB;
constexpr size_t WS_HID = WS_R2 + 128 * MiB;
static_assert(MK_FP8_L0 && MK_FP8_L1, "the workspace map assumes fp8 MoE activations");
constexpr size_t R2_T = (size_t)MTOT * 1024;

constexpr int LDS_SCR = 0;
constexpr int LDSCTL_OFF = 135168, MISC_OFF = LDSCTL_OFF + 320;
constexpr int LDS_GTBL = 139264;
constexpr int LDS_BYTES = 147456;

#define GAS __attribute__((address_space(1)))
#define LAS __attribute__((address_space(3)))
#define DI __device__ __forceinline__
typedef unsigned short bf16;
typedef unsigned v4u __attribute__((ext_vector_type(4)));
typedef unsigned v2u __attribute__((ext_vector_type(2)));
typedef float f32x4 __attribute__((ext_vector_type(4)));
typedef float f32x16 __attribute__((ext_vector_type(16)));
typedef short bf16x8 __attribute__((ext_vector_type(8)));
typedef short s16x4 __attribute__((ext_vector_type(4)));
typedef GAS unsigned gu32;
#define RLX_AGENT __ATOMIC_RELAXED, __HIP_MEMORY_SCOPE_AGENT
#define LDS_WAIT() asm volatile("s_waitcnt lgkmcnt(0)" ::: "memory")
#define VM_WAIT() asm volatile("s_waitcnt vmcnt(0)" ::: "memory")
DI float bf_lo(unsigned u) { return __uint_as_float(u << 16); }
DI float bf_hi(unsigned u) { return __uint_as_float(u & 0xffff0000u); }
DI unsigned pk2(float lo, float hi) { return pg8::cvt_pk_bf16(lo, hi); }
constexpr float F8_WSCALE = 64.0f, F8_WINV = 1.0f / 64.0f;
DI float clamp448(float x) { return __builtin_amdgcn_fmed3f(x, -448.0f, 448.0f); }
DI unsigned pk4_fp8(float a, float b, float c, float d) { int p = __builtin_amdgcn_cvt_pk_fp8_f32(clamp448(a), clamp448(b), 0, false); p = __builtin_amdgcn_cvt_pk_fp8_f32(clamp448(c), clamp448(d), p, true); return (unsigned)p; }
DI float wave_sum(float v) {
#pragma unroll
    for (int o = 1; o < 64; o <<= 1) v += __shfl_xor(v, o);
    return v;
}
DI int wave_sum_i(int v) {
#pragma unroll
    for (int o = 1; o < 64; o <<= 1) v += __shfl_xor(v, o);
    return v;
}
DI float fast_rcp(float x) { return __builtin_amdgcn_rcpf(x); }
DI float fast_exp2(float x) { return __builtin_amdgcn_exp2f(x); }
DI float sigmoidf_(float z) { return fast_rcp(1.0f + fast_exp2(-z * LOG2E)); }
DI float gelu_tanh(float x) { const float z = 1.5957691216057308f * (x + 0.044715f * x * x * x); return x * sigmoidf_(z); }
DI float siluf_(float x) { return x * sigmoidf_(x); }

#define XB_TMO      128
#define XB_XCNT(j)  (256  + 64 * (j))
#define XB_XSUB(j)  (1280 + 64 * (j))
#define XB_XGEN(j)  (2304 + 64 * (j))
#define XB_TOP      3328
#define XB_TOPGEN   3392
#define XCD_BAR_WORDS 3456
#define XB_SPIN_CAP (1u << 18)

__device__ __forceinline__ unsigned xb_ld(unsigned* p)              { return __hip_atomic_load(p, __ATOMIC_RELAXED, __HIP_MEMORY_SCOPE_AGENT); }
__device__ __forceinline__ unsigned xb_add(unsigned* p, unsigned v) { return __hip_atomic_fetch_add(p, v, __ATOMIC_RELAXED, __HIP_MEMORY_SCOPE_AGENT); }
__device__ __forceinline__ unsigned xb_xcc_id() { return (unsigned)__builtin_amdgcn_s_getreg((3 << 11) | 20) & 0xFu; }
#define XB_SPIN(cond, bar) do { unsigned _sp = 0; while (cond) { __builtin_amdgcn_s_sleep(1); \
    if ((++_sp & 255u) == 0u) { if (xb_ld(&(bar)[XB_TMO])) break; if (_sp > XB_SPIN_CAP) { atomicAdd(&(bar)[XB_TMO], 1u); break; } } } } while (0)

struct XcdBarrier {
    unsigned* bar; unsigned x;
    volatile LAS unsigned* st;
};
__device__ __forceinline__ XcdBarrier xcd_barrier_post(unsigned* bar, volatile LAS unsigned* st) {
    XcdBarrier b; b.bar = bar; b.x = xb_xcc_id(); b.st = st;
    if (threadIdx.x == 0) (void)xb_add(&bar[XB_XCNT(b.x)], 1u);
    return b;
}
__device__ __forceinline__ void xcd_barrier_complete(unsigned* bar, unsigned x, unsigned& nloc, unsigned& nx) {
    const unsigned G = gridDim.x * gridDim.y * gridDim.z;
    unsigned sum, cnt, mine, sp = 0u;
    for (;;) {
        sum = 0u; cnt = 0u; mine = 0u;
#pragma unroll
        for (unsigned j = 0; j < 16; ++j) { const unsigned c = xb_ld(&bar[XB_XCNT(j)]); sum += c; cnt += (c > 0u) ? 1u : 0u; mine = (j == x) ? c : mine; }
        if (sum == G) break;
        __builtin_amdgcn_s_sleep(1);
        if ((++sp & 255u) == 0u) { if (xb_ld(&bar[XB_TMO])) break; if (sp > XB_SPIN_CAP) { atomicAdd(&bar[XB_TMO], 1u); break; } }
    }
    nloc = mine > 0u ? mine : 1u; nx = cnt > 0u ? cnt : 1u;
}
__device__ __forceinline__ void xcd_barrier(const XcdBarrier& b) {
    asm volatile("s_waitcnt vmcnt(0)" ::: "memory");
    __syncthreads();
    if (threadIdx.x == 0) {
        unsigned* bar = b.bar;
        __builtin_amdgcn_s_waitcnt(0);
        unsigned nloc = b.st[0], nx = b.st[1];
        if (nloc == 0u) { xcd_barrier_complete(bar, b.x, nloc, nx); b.st[0] = nloc; b.st[1] = nx; }
        const unsigned old = xb_add(&bar[XB_XSUB(b.x)], 1u);
        const unsigned gen = old / nloc;
        if (old + 1u == (gen + 1u) * nloc) {
            __builtin_amdgcn_fence(__ATOMIC_RELEASE, "agent");
            asm volatile("s_waitcnt vmcnt(0)" ::: "memory");
            const unsigned og = xb_add(&bar[XB_TOP], 1u);
            const unsigned tg = og / nx;
            if (og + 1u == (tg + 1u) * nx) xb_add(&bar[XB_TOPGEN], 1u);
            else XB_SPIN(xb_ld(&bar[XB_TOPGEN]) == tg, bar);
            __builtin_amdgcn_fence(__ATOMIC_ACQUIRE, "agent");
            xb_add(&bar[XB_XGEN(b.x)], 1u);
            asm volatile("s_waitcnt vmcnt(0)" ::: "memory");
        } else {
            XB_SPIN(xb_ld(&bar[XB_XGEN(b.x)]) == gen, bar);
            __builtin_amdgcn_fence(__ATOMIC_ACQUIRE, "agent");
            asm volatile("s_waitcnt vmcnt(0)" ::: "memory");
        }
    }
    __syncthreads();
}

using pg8::Unit; using pg8::BM; using pg8::HALF;
struct EpiIn0 {
    static constexpr bool PERM = true;
    bf16* O; int tbase; float sc;
    DI void operator()(const f32x4 (&acc)[2][2][4][2], const Unit& u, int wr, int wc, int fr, int fq) const {
        const int row0 = u.pm * BM + wr * 64 + fr; const int t = tbase + (u.pn >> 2); const int colt = (u.pn & 3) * BM;
        bf16* base = O + (size_t)t * R2_T; const int col0 = colt + wc * 32 + 8 * fq; const bool act = t < 2;
#pragma unroll
        for (int ai = 0; ai < 2; ++ai)
#pragma unroll
            for (int m = 0; m < 4; ++m) { bf16* rowp = base + (size_t)(row0 + ai * HALF + m * 16) * 1024 + col0;
#pragma unroll
                for (int bj = 0; bj < 2; ++bj) { f32x4 v0 = acc[ai][bj][m][0] * sc, v1 = acc[ai][bj][m][1] * sc;
                    if (act) {
#pragma unroll
                        for (int j = 0; j < 4; ++j) { v0[j] = gelu_tanh(v0[j]); v1[j] = gelu_tanh(v1[j]); } }
                    v4u w; w.x = pk2(v0[0], v0[1]); w.y = pk2(v0[2], v0[3]); w.z = pk2(v1[0], v1[1]); w.w = pk2(v1[2], v1[3]);
                    *(v4u*)(rowp + bj * HALF) = w; } }
    }
};
struct OneUnit {
    int pm, pn;
    __device__ __forceinline__ bool next(int i, Unit& u) const { if (i != 0) return false; u.pm = pm; u.pn = pn; u.pb = pn; return true; }
    DI void a_ready(const Unit&) const {}
    DI void done(const Unit&) const {}
};
template <bool BASE_F32>
struct EpiResid {
    static constexpr bool PERM = true;
    const void* base; bf16* out; const float* gate0;
    DI void operator()(const f32x4 (&acc)[2][2][4][2], const Unit& u, int wr, int wc, int fr, int fq) const {
        const int row0 = u.pm * BM + wr * 64 + fr, col0 = u.pn * BM + wc * 32 + 8 * fq;
        const float* gate = gate0 + (size_t)((u.pm * BM) >> 14) * 12288;
        f32x4 gv[2][2];
#pragma unroll
        for (int bj = 0; bj < 2; ++bj)
#pragma unroll
            for (int n = 0; n < 2; ++n) gv[bj][n] = *(const f32x4*)(gate + col0 + bj * HALF + n * 4);
#pragma unroll
        for (int ai = 0; ai < 2; ++ai)
#pragma unroll
            for (int m = 0; m < 4; ++m) { const size_t off = (size_t)(row0 + ai * HALF + m * 16) * D + col0;
#pragma unroll
                for (int bj = 0; bj < 2; ++bj) { f32x4 b0, b1;
                    if constexpr (BASE_F32) { b0 = *(const f32x4*)((const float*)base + off + bj * HALF); b1 = *(const f32x4*)((const float*)base + off + bj * HALF + 4); }
                    else { const v4u w = *(const v4u*)((const bf16*)base + off + bj * HALF); b0 = (f32x4){bf_lo(w.x), bf_hi(w.x), bf_lo(w.y), bf_hi(w.y)}; b1 = (f32x4){bf_lo(w.z), bf_hi(w.z), bf_lo(w.w), bf_hi(w.w)}; }
                    const f32x4 v0 = b0 + gv[bj][0] * acc[ai][bj][m][0], v1 = b1 + gv[bj][1] * acc[ai][bj][m][1];
                    v4u o; o.x = pk2(v0[0], v0[1]); o.y = pk2(v0[2], v0[3]); o.z = pk2(v1[0], v1[1]); o.w = pk2(v1[2], v1[3]);
                    *(v4u*)(out + off + bj * HALF) = o; } }
    }
};
template <bool F8>
struct EpiSwiglu {
    static constexpr bool PERM = true;
    void* O;
    DI void operator()(const f32x4 (&acc)[2][2][4][2], const Unit& u, int wr, int wc, int fr, int fq) const {
        const int row0 = u.pm * BM + wr * 64 + fr, col0 = u.pn * HALF + wc * 32 + 8 * fq;
        const float sc = F8 ? F8_WINV : 1.0f;
#pragma unroll
        for (int ai = 0; ai < 2; ++ai)
#pragma unroll
            for (int m = 0; m < 4; ++m) { const size_t eo = (size_t)(row0 + ai * HALF + m * 16) * FF + col0;
                f32x4 g0 = acc[ai][0][m][0] * sc, g1 = acc[ai][0][m][1] * sc; const f32x4 u0 = acc[ai][1][m][0] * sc, u1 = acc[ai][1][m][1] * sc;
#pragma unroll
                for (int j = 0; j < 4; ++j) { g0[j] = siluf_(g0[j]) * u0[j]; g1[j] = siluf_(g1[j]) * u1[j]; }
                if constexpr (F8) { v2u w; w.x = pk4_fp8(g0[0], g0[1], g0[2], g0[3]); w.y = pk4_fp8(g1[0], g1[1], g1[2], g1[3]); *(v2u*)((unsigned char*)O + eo) = w; }
                else { v4u w; w.x = pk2(g0[0], g0[1]); w.y = pk2(g0[2], g0[3]); w.z = pk2(g1[0], g1[1]); w.w = pk2(g1[2], g1[3]); *(v4u*)((bf16*)O + eo) = w; } }
    }
};
struct EpiPlain {
    static constexpr bool PERM = true;
    bf16* O; int ldc; float sc;
    DI void operator()(const f32x4 (&acc)[2][2][4][2], const Unit& u, int wr, int wc, int fr, int fq) const {
        const int row0 = u.pm * BM + wr * 64 + fr, col0 = u.pn * BM + wc * 32 + 8 * fq;
#pragma unroll
        for (int ai = 0; ai < 2; ++ai)
#pragma unroll
            for (int m = 0; m < 4; ++m) { bf16* rowp = O + (size_t)(row0 + ai * HALF + m * 16) * ldc + col0;
#pragma unroll
                for (int bj = 0; bj < 2; ++bj) { const f32x4 v0 = acc[ai][bj][m][0] * sc, v1 = acc[ai][bj][m][1] * sc;
                    v4u w; w.x = pk2(v0[0], v0[1]); w.y = pk2(v0[2], v0[3]); w.z = pk2(v1[0], v1[1]); w.w = pk2(v1[2], v1[3]);
                    *(v4u*)(rowp + bj * HALF) = w; } }
    }
};
struct EpiCin {
    static constexpr bool PERM = true;
    bf16* BG; bf16* CZ; int nostore;
    DI void operator()(const f32x4 (&acc)[2][2][4][2], const Unit& u, int wr, int wc, int fr, int fq) const {
        if (nostore) return;
        const int row0 = u.pm * BM + wr * 64 + fr;
        if (u.pn < 8) {
            const int col0 = u.pn * BM + wc * 32 + 8 * fq;
#pragma unroll
            for (int ai = 0; ai < 2; ++ai)
#pragma unroll
                for (int m = 0; m < 4; ++m) { bf16* rowp = BG + (size_t)(row0 + ai * HALF + m * 16) * D + col0;
#pragma unroll
                    for (int bj = 0; bj < 2; ++bj) { const f32x4 v0 = acc[ai][bj][m][0], v1 = acc[ai][bj][m][1];
                        v4u w; w.x = pk2(v0[0], v0[1]); w.y = pk2(v0[2], v0[3]); w.z = pk2(v1[0], v1[1]); w.w = pk2(v1[2], v1[3]);
                        *(v4u*)(rowp + bj * HALF) = w; } }
        } else {
            const int col0 = (u.pn - 8) * HALF + wc * 32 + 8 * fq;
#pragma unroll
            for (int ai = 0; ai < 2; ++ai)
#pragma unroll
                for (int m = 0; m < 4; ++m) { bf16* rowp = CZ + (size_t)(row0 + ai * HALF + m * 16) * D + col0;
                    const f32x4 p0 = acc[ai][0][m][0] * acc[ai][1][m][0], p1 = acc[ai][0][m][1] * acc[ai][1][m][1];
                    v4u w; w.x = pk2(p0[0], p0[1]); w.y = pk2(p0[2], p0[3]); w.z = pk2(p1[0], p1[1]); w.w = pk2(p1[2], p1[3]);
                    *(v4u*)rowp = w; }
        }
    }
};

DI unsigned off_b(unsigned row, unsigned ch) { return 256u * row + 16u * (ch ^ (((row & 3) << 2) | ((row >> 2) & 3))); }
DI bf16x8 row_frag(const LAS unsigned char* img, int lane, int s) { return *(const LAS bf16x8*)(img + off_b(lane & 31, 2 * s + (lane >> 5))); }
template <bool KROW>
DI bf16x8 tr_frag(const LAS unsigned char* img, int lane, int c, int ks) {
    const unsigned h = lane >> 5, blk = (lane >> 4) & 1, q = (lane & 15) >> 2, p = lane & 3;
    const unsigned r0 = KROW ? (16 * ks + 4 * h + q) : (16 * ks + 8 * h + q), r1 = KROW ? (r0 + 8) : (r0 + 4);
    const unsigned ch = 4 * c + 2 * blk + (p >> 1), sub = 8 * (p & 1);
    const s16x4 lo = __builtin_amdgcn_ds_read_tr16_b64_v4i16((LAS s16x4*)(img + off_b(r0, ch) + sub));
    const s16x4 hi = __builtin_amdgcn_ds_read_tr16_b64_v4i16((LAS s16x4*)(img + off_b(r1, ch) + sub));
    return __builtin_shufflevector(lo, hi, 0, 1, 2, 3, 4, 5, 6, 7);
}
DI int crow(int reg, int h) { return (reg & 3) + 8 * (reg >> 2) + 4 * h; }
#define MFMA32(a, b, c) __builtin_amdgcn_mfma_f32_32x32x16_bf16((a), (b), (c), 0, 0, 0)

struct Params { const float* in[23]; float* out; unsigned char* ws; int ph_lo, ph_hi, li, pad; };
enum { I_X = 0, I_C, I_CTX, I_CCTX, I_ADAW, I_ADAB, I_N1G, I_N2G, I_ABWIN, I_ABWOUT, I_AWS, I_ABS, I_AVG, I_BQG, I_BKG, I_RPB, I_CWIN, I_CONVW, I_CWOUT, I_ROUTER, I_WGATE, I_WUP, I_WDOWN };

template <bool F8>
DI void xpose_item(const float* __restrict__ W, int N, bf16* __restrict__ WT, int Kd, int k0, int n0, int dstrow0, LAS float* scr, int lane) {
    const GAS f32x4* src = (const GAS f32x4*)(W + (size_t)k0 * N + n0);
    const int lr = lane >> 4, lc = lane & 15;
    f32x4 v[16];
#pragma unroll
    for (int i = 0; i < 16; ++i) v[i] = src[(size_t)(lr + 4 * i) * (N / 4) + lc];
#pragma unroll
    for (int i = 0; i < 16; ++i) { LAS float* d = scr + (lr + 4 * i) * 65 + 4 * lc; d[0] = v[i].x; d[1] = v[i].y; d[2] = v[i].z; d[3] = v[i].w; }
    LDS_WAIT(); asm volatile("" ::: "memory");
    if constexpr (F8) {
        const int c = lane & 3;
#pragma unroll
        for (int i = 0; i < 4; ++i) { const int n = 16 * i + (lane >> 2); const LAS float* s = scr + (16 * c) * 65 + n;
            v4u o;
            o.x = pk4_fp8(s[0 * 65] * F8_WSCALE, s[1 * 65] * F8_WSCALE, s[2 * 65] * F8_WSCALE, s[3 * 65] * F8_WSCALE); o.y = pk4_fp8(s[4 * 65] * F8_WSCALE, s[5 * 65] * F8_WSCALE, s[6 * 65] * F8_WSCALE, s[7 * 65] * F8_WSCALE);
            o.z = pk4_fp8(s[8 * 65] * F8_WSCALE, s[9 * 65] * F8_WSCALE, s[10 * 65] * F8_WSCALE, s[11 * 65] * F8_WSCALE); o.w = pk4_fp8(s[12 * 65] * F8_WSCALE, s[13 * 65] * F8_WSCALE, s[14 * 65] * F8_WSCALE, s[15 * 65] * F8_WSCALE);
            *(GAS v4u*)((unsigned char*)WT + (size_t)(dstrow0 + n) * Kd + k0 + 16 * c) = o; }
    } else {
    const int c = lane & 7;
#pragma unroll
    for (int i = 0; i < 8; ++i) { const int n = 8 * i + (lane >> 3); const LAS float* s = scr + (8 * c) * 65 + n;
        v4u o; o.x = pk2(s[0 * 65], s[1 * 65]); o.y = pk2(s[2 * 65], s[3 * 65]); o.z = pk2(s[4 * 65], s[5 * 65]); o.w = pk2(s[6 * 65], s[7 * 65]);
        *(GAS v4u*)(WT + (size_t)(dstrow0 + n) * Kd + k0 + 8 * c) = o; }
    }
    LDS_WAIT(); asm volatile("" ::: "memory");
}
DI int ilv_row(int j, int hv) { return ((j >> 7) << 8) + hv * 128 + (j & 127); }

#define F8L(l) ((l) == 0 ? (MK_FP8_L0 != 0) : (MK_FP8_L1 != 0))
DI void phase_prologue(const Params& P, LAS unsigned char* lds, int tid, int lane, int wave) {
    unsigned char* ws = P.ws;
    for (int u = blockIdx.x; u < 192; u += gridDim.x) {
        const int l = u / 96, cb = u % 96;
        LAS float* sv = (LAS float*)(lds + LDS_SCR);
        LAS float* part = (LAS float*)(lds + LDS_SCR + 24576);
        for (int i = tid; i < 3 * 2048; i += 512) { const int r = i >> 11, k = i & 2047; const float c = r < 2 ? P.in[I_C][r * 2048 + k] : P.in[I_CCTX][k]; sv[i] = c / (1.0f + __expf(-c)); }
        __syncthreads();
        const int col4 = tid & 31, ks = tid >> 5;
        const GAS f32x4* w = (const GAS f32x4*)(P.in[I_ADAW] + (size_t)l * 2048 * 12288 + (size_t)(ks * 128) * 12288 + cb * 128) + col4;
        f32x4 a0 = {0.f, 0.f, 0.f, 0.f}, a1 = a0, a2 = a0;
#pragma unroll 8
        for (int k = 0; k < 128; ++k) { const f32x4 wv = w[(size_t)k * (12288 / 4)]; const int kk = ks * 128 + k;
            a0 += wv * sv[kk]; a1 += wv * sv[2048 + kk]; a2 += wv * sv[4096 + kk]; }
        *(LAS f32x4*)(part + (ks * 3 + 0) * 128 + 4 * col4) = a0; *(LAS f32x4*)(part + (ks * 3 + 1) * 128 + 4 * col4) = a1; *(LAS f32x4*)(part + (ks * 3 + 2) * 128 + 4 * col4) = a2;
        __syncthreads();
        if (tid < 384) { const int r = tid >> 7, cc = tid & 127; float s = P.in[I_ADAB][l * 12288 + cb * 128 + cc];
#pragma unroll
            for (int q = 0; q < 16; ++q) s += part[(q * 3 + r) * 128 + cc];
            ((float*)(ws + WS_MOD))[(size_t)(l * 3 + r) * 12288 + cb * 128 + cc] = s; }
        __syncthreads();
    }
    { const float* src = P.in[I_AWS]; bf16* dst = (bf16*)(ws + WS_WSB);
      for (int i = blockIdx.x * 512 + tid; i < 8 * 128 * 128 / 2; i += gridDim.x * 512) { const float a = src[2 * i], b = src[2 * i + 1]; ((unsigned*)dst)[i] = pk2(a, b); } }
    LAS float* scr = (LAS float*)(lds + LDS_SCR + wave * 16640);
    const int gw = blockIdx.x * NWAVES + wave, NGW = gridDim.x * NWAVES;
    constexpr int I0 = 32 * 80, I1 = 32 * 32, I2 = 32 * 96, I3 = 32 * 32, IM = 512, I4 = 32 * IM, NITEMS = I0 + I1 + I2 + I3 + 3 * I4;
    for (int it = gw; it < NITEMS; it += NGW) {
        int r = it;
        if (r < I0) { const int kb = r / 80, nb = r % 80;
            if (nb < 32) xpose_item<false>(P.in[I_ABWIN], 5120, (bf16*)(ws + WS_WIN0), 2048, kb * 64, nb * 64, nb * 64, scr, lane);
            else xpose_item<true>(P.in[I_ABWIN], 5120, (bf16*)(ws + WS_WIN0F8), 2048, kb * 64, nb * 64, nb * 64 - 2048, scr, lane);
            continue; } r -= I0;
        if (r < I1) { const int kb = r / 32, nb = r % 32; xpose_item<false>(P.in[I_ABWOUT], 2048, (bf16*)(ws + WS_WOUT0), 2048, kb * 64, nb * 64, nb * 64, scr, lane); continue; } r -= I1;
        if (r < I2) { const int kb = r / 96, nb = r % 96; const int n0 = nb * 64;
            const int drow = n0 < 2048 ? n0 : (n0 < 4096 ? 2048 + ilv_row(n0 - 2048, 0) : 2048 + ilv_row(n0 - 4096, 1));
            xpose_item<false>(P.in[I_CWIN], 6144, (bf16*)(ws + WS_WCIN), 2048, kb * 64, n0, drow, scr, lane); continue; } r -= I2;
        if (r < I3) { const int kb = r / 32, nb = r % 32; xpose_item<false>(P.in[I_CWOUT], 2048, (bf16*)(ws + WS_WCOUT), 2048, kb * 64, nb * 64, nb * 64, scr, lane); continue; } r -= I3;
        if (r < I4) { const int mt = r / IM, q = r % IM, kb = q / 16, nb = q % 16;
            if (F8L(mt >> 4)) xpose_item<true>(P.in[I_WGATE] + (size_t)mt * 2048 * 1024, 1024, (bf16*)(ws + WS_GU + (size_t)(mt >> 4) * 16 * 2048 * 2048 * 2 + (size_t)(mt & 15) * 2048 * 2048), 2048, kb * 64, nb * 64, ilv_row(nb * 64, 0), scr, lane);
            else xpose_item<false>(P.in[I_WGATE] + (size_t)mt * 2048 * 1024, 1024, (bf16*)(ws + WS_GU) + (size_t)mt * 2048 * 2048, 2048, kb * 64, nb * 64, ilv_row(nb * 64, 0), scr, lane);
            continue; } r -= I4;
        if (r < I4) { const int mt = r / IM, q = r % IM, kb = q / 16, nb = q % 16;
            if (F8L(mt >> 4)) xpose_item<true>(P.in[I_WUP] + (size_t)mt * 2048 * 1024, 1024, (bf16*)(ws + WS_GU + (size_t)(mt >> 4) * 16 * 2048 * 2048 * 2 + (size_t)(mt & 15) * 2048 * 2048), 2048, kb * 64, nb * 64, ilv_row(nb * 64, 1), scr, lane);
            else xpose_item<false>(P.in[I_WUP] + (size_t)mt * 2048 * 1024, 1024, (bf16*)(ws + WS_GU) + (size_t)mt * 2048 * 2048, 2048, kb * 64, nb * 64, ilv_row(nb * 64, 1), scr, lane);
            continue; } r -= I4;
        { const int mt = r / IM, q = r % IM, kb = q / 32, nb = q % 32;
            if (F8L(mt >> 4)) xpose_item<true>(P.in[I_WDOWN] + (size_t)mt * 1024 * 2048, 2048, (bf16*)(ws + WS_DN + (size_t)(mt >> 4) * 16 * 2048 * 1024 * 2 + (size_t)(mt & 15) * 2048 * 1024), 1024, kb * 64, nb * 64, nb * 64, scr, lane);
            else xpose_item<false>(P.in[I_WDOWN] + (size_t)mt * 1024 * 2048, 2048, (bf16*)(ws + WS_DN) + (size_t)mt * 2048 * 1024, 1024, kb * 64, nb * 64, nb * 64, scr, lane); }
    }
}

DI void norm_mod_row(f32x4 (&v)[8], const float* __restrict__ g, const float* __restrict__ shift, const float* __restrict__ scale, int lane) {
    float ss = 0.f;
#pragma unroll
    for (int j = 0; j < 8; ++j) ss += (v[j].x * v[j].x + v[j].y * v[j].y) + (v[j].z * v[j].z + v[j].w * v[j].w);
    const float rstd = 1.0f / sqrtf(wave_sum(ss) * (1.0f / D) + EPS);
#pragma unroll
    for (int j = 0; j < 8; ++j) { const int c = 256 * j + 4 * lane; const f32x4 gg = *(const f32x4*)(g + c), sc = *(const f32x4*)(scale + c), sh = *(const f32x4*)(shift + c);
        v[j] = (v[j] * rstd * gg) * (1.0f + sc) + sh; }
}
DI void store_row_bf16(bf16* __restrict__ orow, const f32x4 (&v)[8], int lane) {
    GAS v2u* o = (GAS v2u*)orow + lane;
#pragma unroll
    for (int j = 0; j < 8; ++j) { v2u w; w.x = pk2(v[j].x, v[j].y); w.y = pk2(v[j].z, v[j].w); o[64 * j] = w; }
}
DI void store_row_fp8(unsigned char* __restrict__ orow, const f32x4 (&v)[8], int lane) {
    GAS unsigned* o = (GAS unsigned*)orow + lane;
#pragma unroll
    for (int j = 0; j < 8; ++j) o[64 * j] = pk4_fp8(v[j].x, v[j].y, v[j].z, v[j].w);
}
DI void load_row_bf16(f32x4 (&v)[8], const bf16* __restrict__ xrow, int lane) {
    const GAS v2u* xr = (const GAS v2u*)xrow + lane;
#pragma unroll
    for (int j = 0; j < 8; ++j) { const v2u w = xr[64 * j]; v[j] = (f32x4){bf_lo(w.x), bf_hi(w.x), bf_lo(w.y), bf_hi(w.y)}; }
}
DI void load_row_f32(f32x4 (&v)[8], const float* __restrict__ xrow, int lane) {
    const GAS f32x4* xr = (const GAS f32x4*)xrow + lane;
#pragma unroll
    for (int j = 0; j < 8; ++j) v[j] = xr[64 * j];
}

DI void phase_norm1_l0(const Params& P, LAS unsigned char* lds, int tid, int lane, int wave) {
    const float* mod = (const float*)(P.ws + WS_MOD); bf16* H = (bf16*)(P.ws + WS_H); unsigned char* H8 = P.ws + WS_H8;
    const bool ctxwg = (gridDim.x >= 64) && (blockIdx.x < 16);
    if (ctxwg) {
        const int pmc = blockIdx.x >> 3, pnc = blockIdx.x & 7;
        const float* m = mod + (size_t)2 * 12288;
        for (int rr = wave; rr < 256; rr += NWAVES) { const int row = NT + pmc * 256 + rr;
            f32x4 v[8]; load_row_f32(v, P.in[I_CTX] + (size_t)(row - NT) * D, lane);
            norm_mod_row(v, P.in[I_N1G], m + 0 * 2048, m + 1 * 2048, lane);
            store_row_fp8(H8 + (size_t)row * D, v, lane); }
        VM_WAIT(); __syncthreads();
        __builtin_amdgcn_fence(__ATOMIC_ACQUIRE, "agent"); VM_WAIT(); __syncthreads();
        pg8::Gemm g{(const bf16*)H8, (const bf16*)(P.ws + WS_WIN0F8), MTOT, 3072, D / 2}; OneUnit S{128 + pmc, 4 + pnc};
        EpiIn0 E{(bf16*)(P.ws + WS_R2), 2, F8_WINV};
        pg8::gemm_phase<EpiIn0, OneUnit, true, true, true>(lds, g, S, E);
        return;
    }
    const int nskip = (gridDim.x >= 64) ? 16 : 0;
    const int gw = (blockIdx.x - nskip) * NWAVES + wave, NGW = (gridDim.x - nskip) * NWAVES;
    const int nrows = (gridDim.x >= 64) ? NT : MTOT;
    for (int row = gw; row < nrows; row += NGW) {
        const float* src = row < NT ? P.in[I_X] + (size_t)row * D : P.in[I_CTX] + (size_t)(row - NT) * D;
        const int r = row < NT ? (row >> 14) : 2;
        const float* m = mod + (size_t)r * 12288;
        f32x4 v[8]; load_row_f32(v, src, lane);
        norm_mod_row(v, P.in[I_N1G], m + 0 * 2048, m + 1 * 2048, lane);
        if (row < NT) store_row_bf16(H + (size_t)row * D, v, lane);
        store_row_fp8(H8 + (size_t)row * D, v, lane);
    }
}

DI void phase_norm2_router(const Params& P, int layer, LAS unsigned char* lds, int tid, int lane, int wave) {
    const float* mod = (const float*)(P.ws + WS_MOD) + (size_t)layer * 3 * 12288; bf16* H = (bf16*)(P.ws + WS_H);
    float* AFF = (float*)(P.ws + WS_AFF);
    LAS float* wrt = (LAS float*)(lds + LDS_SCR);
    { const GAS f32x4* wr = (const GAS f32x4*)(P.in[I_ROUTER] + (size_t)layer * 2048 * 16);
      for (int i = tid; i < 2048 * 4; i += 512) { const f32x4 w = wr[i]; const int k = i >> 2, e0 = (i & 3) * 4;
          wrt[(e0 + 0) * 2048 + k] = w.x; wrt[(e0 + 1) * 2048 + k] = w.y; wrt[(e0 + 2) * 2048 + k] = w.z; wrt[(e0 + 3) * 2048 + k] = w.w; } }
    __syncthreads();
    const int gw = blockIdx.x * NWAVES + wave, NGW = gridDim.x * NWAVES;
    const float* n2g = P.in[I_N2G] + (size_t)layer * D;
    for (int row = gw; row < NT; row += NGW) {
        const int b = row >> 14, n = row & 16383;
        const float* m = mod + (size_t)b * 12288;
        f32x4 v[8]; load_row_bf16(v, (const bf16*)(P.ws + WS_XLB) + (size_t)row * D, lane);
        norm_mod_row(v, n2g, m + 3 * 2048, m + 4 * 2048, lane);
        if (F8L(layer)) store_row_fp8((unsigned char*)H + (size_t)row * D, v, lane); else store_row_bf16(H + (size_t)row * D, v, lane);
        asm volatile("" ::: "memory");
        float lg[16];
#pragma unroll
        for (int e = 0; e < 16; ++e) lg[e] = 0.f;
#pragma unroll
        for (int j = 0; j < 8; ++j) {
#pragma unroll
            for (int e = 0; e < 16; ++e) { const f32x4 w = *(const LAS f32x4*)(wrt + e * 2048 + 256 * j + 4 * lane);
                lg[e] += (v[j].x * w.x + v[j].y * w.y) + (v[j].z * w.z + v[j].w * w.w); } }
#pragma unroll
        for (int e = 0; e < 16; ++e) lg[e] = wave_sum(lg[e]);
        float mx = lg[0];
#pragma unroll
        for (int e = 1; e < 16; ++e) mx = fmaxf(mx, lg[e]);
        float sum = 0.f;
#pragma unroll
        for (int e = 0; e < 16; ++e) { lg[e] = __expf(lg[e] - mx); sum += lg[e]; }
        const float inv = 1.0f / sum;
        float mine = 0.f;
#pragma unroll
        for (int e = 0; e < 16; ++e) mine = (lane == e) ? lg[e] * inv : mine;
        if (lane < 16) AFF[((size_t)(b * 16 + lane)) * SEQ + n] = mine;
    }
    __syncthreads();
}

DI void phase_topk(const Params& P, int layer, LAS unsigned char* lds, int tid, int lane, int wave) {
    LAS unsigned* vals = (LAS unsigned*)(lds + LDS_SCR);
    LAS int* red = (LAS int*)(lds + LDS_SCR + 65536);
    LAS int* slotctr = (LAS int*)(lds + LDS_SCR + 65536 + 64);
    const unsigned* AFF = (const unsigned*)(P.ws + WS_AFF);
    int* IDX = (int*)(P.ws + WS_IDX);
    unsigned* tokcnt = (unsigned*)(P.ws + (layer ? CTL_TOKCNT1 : CTL_TOKCNT0));
    unsigned long long* toklist = (unsigned long long*)(P.ws + WS_TOKLIST);
    for (int j = blockIdx.x; j < 32; j += gridDim.x) {
        const int b = j >> 4, e = j & 15;
        const unsigned* src = AFF + (size_t)j * SEQ;
#pragma unroll 8
        for (int i = 0; i < 32; ++i) vals[tid + 512 * i] = src[tid + 512 * i];
        if (tid == 0) slotctr[0] = 0;
        __syncthreads();
        int par = 0;
#define TK_COUNT(pred, total) do { int _c = 0; _Pragma("unroll 8") for (int i = 0; i < 32; ++i) { const int idx = tid + 512 * i; const unsigned v = vals[idx]; (void)idx; _c += (pred) ? 1 : 0; } \
        _c = wave_sum_i(_c); if (lane == 0) red[par * 8 + wave] = _c; __syncthreads(); total = 0; _Pragma("unroll") for (int w = 0; w < 8; ++w) total += red[par * 8 + w]; par ^= 1; } while (0)
        unsigned T = 0u;
        for (int bit = 30; bit >= 0; --bit) { const unsigned cand = T | (1u << bit); int total; TK_COUNT(v >= cand, total); if (total >= CAP) T = cand; }
        int ngt; TK_COUNT(v > T, ngt);
        const int need = CAP - ngt;
        int lo = 0, hi = SEQ - 1;
        while (lo < hi) { const int mid = (lo + hi) >> 1; int c; TK_COUNT(v == T && idx <= mid, c); if (c >= need) hi = mid; else lo = mid + 1; }
        const int J = lo;
#undef TK_COUNT
        for (int i = 0; i < 32; ++i) { const int idx = tid + 512 * i; const unsigned v = vals[idx];
            if (v > T || (v == T && idx <= J)) {
                const int slot = __hip_atomic_fetch_add(slotctr, 1, __ATOMIC_RELAXED, __HIP_MEMORY_SCOPE_WORKGROUP);
                IDX[j * CAP + slot] = idx;
                const int tok = b * SEQ + idx; const unsigned rowid = (unsigned)(e * 4096 + b * 2048 + slot);
                const unsigned p = __hip_atomic_fetch_add(tokcnt + tok, 1u, RLX_AGENT);
                toklist[(size_t)tok * 16 + (p & 15u)] = ((unsigned long long)v << 32) | rowid; } }
        __syncthreads();
    }
}

template <bool F8>
DI void phase_gather(const Params& P, int lane, int wave) {
    const int* IDX = (const int*)(P.ws + WS_IDX); const unsigned char* H = (const unsigned char*)(P.ws + WS_H); unsigned char* XS = (unsigned char*)(P.ws + WS_R2);
    const int gw = blockIdx.x * NWAVES + wave, NGW = gridDim.x * NWAVES;
    constexpr int RB = F8 ? D : 2 * D, NV = RB / 1024;
    for (int rowid = gw; rowid < 65536; rowid += NGW) {
        const int e = rowid >> 12, b = (rowid >> 11) & 1, slot = rowid & 2047;
        const int n = IDX[(b * 16 + e) * CAP + slot];
        const GAS v4u* s = (const GAS v4u*)(H + (size_t)(b * SEQ + n) * RB) + lane; GAS v4u* d = (GAS v4u*)(XS + (size_t)rowid * RB) + lane;
        v4u t[NV];
#pragma unroll
        for (int j = 0; j < NV; ++j) t[j] = s[64 * j];
#pragma unroll
        for (int j = 0; j < NV; ++j) d[64 * j] = t[j];
    }
}

template <bool NEXT_NORM>
DI void phase_combine(const Params& P, int layer, int lane, int wave) {
    const float* mod = (const float*)(P.ws + WS_MOD) + (size_t)layer * 3 * 12288;
    const float* modn = (const float*)(P.ws + WS_MOD) + (size_t)(layer + 1) * 3 * 12288;
    const unsigned* tokcnt = (const unsigned*)(P.ws + (layer ? CTL_TOKCNT1 : CTL_TOKCNT0));
    const unsigned long long* toklist = (const unsigned long long*)(P.ws + WS_TOKLIST);
    const bf16* YB = (const bf16*)(P.ws + WS_R3); bf16* H = (bf16*)(P.ws + WS_H);
    const int gw = blockIdx.x * NWAVES + wave, NGW = gridDim.x * NWAVES;
    for (int tok = gw; tok < NT; tok += NGW) {
        const int b = tok >> 14;
        f32x4 v[8]; load_row_bf16(v, (const bf16*)(P.ws + WS_XLB) + (size_t)tok * D, lane);
        int cnt = (int)tokcnt[tok]; cnt = __builtin_amdgcn_readfirstlane(cnt); cnt = cnt > 16 ? 16 : cnt;
        f32x4 a[8];
#pragma unroll
        for (int j = 0; j < 8; ++j) a[j] = (f32x4){0.f, 0.f, 0.f, 0.f};
        for (int p = 0; p < cnt; ++p) {
            const unsigned long long ent = toklist[(size_t)tok * 16 + p];
            const unsigned rowid = (unsigned)__builtin_amdgcn_readfirstlane((int)(unsigned)ent); const float gate = __uint_as_float((unsigned)__builtin_amdgcn_readfirstlane((int)(unsigned)(ent >> 32)));
            const GAS v2u* y = (const GAS v2u*)(YB + (size_t)rowid * D) + lane;
#pragma unroll
            for (int j = 0; j < 8; ++j) { const v2u w = y[64 * j]; a[j].x += gate * bf_lo(w.x); a[j].y += gate * bf_hi(w.x); a[j].z += gate * bf_lo(w.y); a[j].w += gate * bf_hi(w.y); }
        }
        const float* g2 = mod + (size_t)b * 12288 + 5 * 2048;
#pragma unroll
        for (int j = 0; j < 8; ++j) { const f32x4 gg = *(const f32x4*)(g2 + 256 * j + 4 * lane); v[j] += gg * a[j]; }
        if constexpr (NEXT_NORM) store_row_bf16((bf16*)(P.ws + WS_XLB) + (size_t)tok * D, v, lane);
        else { GAS f32x4* o = (GAS f32x4*)(P.out + (size_t)tok * D) + lane;
#pragma unroll
            for (int j = 0; j < 8; ++j) o[64 * j] = v[j]; }
        if constexpr (NEXT_NORM) {
            const float* m = modn + (size_t)b * 12288;
            norm_mod_row(v, P.in[I_N1G] + (size_t)(layer + 1) * D, m + 0 * 2048, m + 1 * 2048, lane);
            store_row_bf16(H + (size_t)tok * D, v, lane);
        }
    }
}

DI void phase_knorm(const Params& P, int lane, int wave) {
    bf16* KK = (bf16*)(P.ws + WS_R2) + 3 * R2_T; const float* gk = P.in[I_BKG];
    const int gw = blockIdx.x * NWAVES + wave, NGW = gridDim.x * NWAVES;
    const int d0 = (lane & 7) * 16;
    float gkr[16];
#pragma unroll
    for (int i = 0; i < 16; ++i) gkr[i] = gk[d0 + i];
    for (int row = gw; row < MTOT; row += NGW) {
        GAS v4u* p = (GAS v4u*)(KK + (size_t)row * 1024) + 2 * lane;
        const v4u w0 = p[0], w1 = p[1];
        float f[16];
        f[0] = bf_lo(w0.x); f[1] = bf_hi(w0.x); f[2] = bf_lo(w0.y); f[3] = bf_hi(w0.y); f[4] = bf_lo(w0.z); f[5] = bf_hi(w0.z); f[6] = bf_lo(w0.w); f[7] = bf_hi(w0.w);
        f[8] = bf_lo(w1.x); f[9] = bf_hi(w1.x); f[10] = bf_lo(w1.y); f[11] = bf_hi(w1.y); f[12] = bf_lo(w1.z); f[13] = bf_hi(w1.z); f[14] = bf_lo(w1.w); f[15] = bf_hi(w1.w);
        float ss = 0.f;
#pragma unroll
        for (int i = 0; i < 16; ++i) ss += f[i] * f[i];
        ss += __shfl_xor(ss, 1); ss += __shfl_xor(ss, 2); ss += __shfl_xor(ss, 4);
        const float rstd = 1.0f / sqrtf(ss * (1.0f / 128.0f) + EPS);
#pragma unroll
        for (int i = 0; i < 16; ++i) f[i] = f[i] * rstd * gkr[i];
        v4u o0, o1; o0.x = pk2(f[0], f[1]); o0.y = pk2(f[2], f[3]); o0.z = pk2(f[4], f[5]); o0.w = pk2(f[6], f[7]); o1.x = pk2(f[8], f[9]); o1.y = pk2(f[10], f[11]); o1.z = pk2(f[12], f[13]); o1.w = pk2(f[14], f[15]);
        p[0] = o0; p[1] = o1;
    }
}

DI void phase_gmlp(const Params& P, LAS unsigned char* lds, int tid, int lane, int wave) {
    const bf16* U = (const bf16*)(P.ws + WS_R2); const bf16* V = U + R2_T; const bf16* WSB = (const bf16*)(P.ws + WS_WSB);
    bf16* CAT = (bf16*)(P.ws + WS_R3);
    LAS unsigned char* wimg = lds + LDS_SCR;
    LAS unsigned char* vimg = lds + LDS_SCR + 32768;
    const int ql = lane & 31, hf = lane >> 5;
    for (int u = blockIdx.x; u < 2048; u += gridDim.x) {
        const int g = u & 7, cn = (u >> 3) & 127, b = u >> 10;
        const int tok0 = b * SEQ + cn * 128;
        const float* gv = P.in[I_AVG] + g * 128;
#pragma unroll
        for (int i = 0; i < 4; ++i) { const int cidx = tid + 512 * i, q = cidx >> 4, ch = cidx & 15;
            const v4u raw = *(const GAS v4u*)(V + (size_t)(tok0 + q) * 1024 + g * 128 + ch * 8);
            float f[8]; f[0] = bf_lo(raw.x); f[1] = bf_hi(raw.x); f[2] = bf_lo(raw.y); f[3] = bf_hi(raw.y); f[4] = bf_lo(raw.z); f[5] = bf_hi(raw.z); f[6] = bf_lo(raw.w); f[7] = bf_hi(raw.w);
            float ss = 0.f;
#pragma unroll
            for (int k = 0; k < 8; ++k) ss += f[k] * f[k];
            ss += __shfl_xor(ss, 1); ss += __shfl_xor(ss, 2); ss += __shfl_xor(ss, 4); ss += __shfl_xor(ss, 8);
            const float rstd = 1.0f / sqrtf(ss * (1.0f / 128.0f) + EPS);
            const f32x4 g0 = *(const f32x4*)(gv + ch * 8), g1 = *(const f32x4*)(gv + ch * 8 + 4);
            v4u o; o.x = pk2(f[0] * rstd * g0.x, f[1] * rstd * g0.y); o.y = pk2(f[2] * rstd * g0.z, f[3] * rstd * g0.w); o.z = pk2(f[4] * rstd * g1.x, f[5] * rstd * g1.y); o.w = pk2(f[6] * rstd * g1.z, f[7] * rstd * g1.w);
            *(LAS v4u*)(vimg + (q >> 5) * 8192 + off_b(q & 31, ch)) = o;
            const v4u wraw = *(const GAS v4u*)(WSB + (size_t)(g * 128 + q) * 128 + ch * 8);
            *(LAS v4u*)(wimg + (q >> 5) * 8192 + off_b(q & 31, ch)) = wraw; }
        __syncthreads();
        const int cb = wave & 3, pb0 = 2 * (wave >> 2);
        f32x16 acc0, acc1;
#pragma unroll
        for (int i = 0; i < 16; ++i) { acc0[i] = 0.f; acc1[i] = 0.f; }
#pragma unroll
        for (int ks = 0; ks < 8; ++ks) {
            const bf16x8 a = tr_frag<false>(vimg + (ks >> 1) * 8192, lane, cb, ks & 1);
            const bf16x8 b0 = row_frag(wimg + (pb0 + 0) * 8192, lane, ks), b1 = row_frag(wimg + (pb0 + 1) * 8192, lane, ks);
            acc0 = MFMA32(a, b0, acc0); acc1 = MFMA32(a, b1, acc1);
        }
#pragma unroll
        for (int x = 0; x < 2; ++x) { const int p = 32 * (pb0 + x) + ql; const int tok = tok0 + p; const float bs = P.in[I_ABS][g * 128 + p];
#pragma unroll
            for (int rq = 0; rq < 4; ++rq) { const int c = 32 * cb + 8 * rq + 4 * hf;
                const v2u uu = *(const GAS v2u*)(U + (size_t)tok * 1024 + g * 128 + c);
                const float s0 = (x ? acc1[4 * rq + 0] : acc0[4 * rq + 0]) + bs, s1 = (x ? acc1[4 * rq + 1] : acc0[4 * rq + 1]) + bs, s2 = (x ? acc1[4 * rq + 2] : acc0[4 * rq + 2]) + bs, s3 = (x ? acc1[4 * rq + 3] : acc0[4 * rq + 3]) + bs;
                v2u o; o.x = pk2(bf_lo(uu.x) * s0, bf_hi(uu.x) * s1); o.y = pk2(bf_lo(uu.y) * s2, bf_hi(uu.y) * s3);
                *(GAS v2u*)(CAT + (size_t)tok * D + g * 128 + c) = o; } }
        __syncthreads();
    }
}

DI void phase_attn(const Params& P, LAS unsigned char* lds, int tid, int lane, int wave) {
    const bf16* Qb = (const bf16*)(P.ws + WS_R2) + 2 * R2_T; const bf16* KK = Qb + R2_T; const bf16* VV = KK + R2_T;
    bf16* CAT = (bf16*)(P.ws + WS_R3);
    LAS unsigned char* kbuf = lds + LDS_SCR;
    LAS unsigned char* vbuf = lds + LDS_SCR + 32768;
    LAS float* rpbL = (LAS float*)(lds + LDS_SCR + 65536);
    const int ql = lane & 31, hf = lane >> 5;
    const float* gq = P.in[I_BQG];
    for (int u = blockIdx.x; u < 1024; u += gridDim.x) {
        const int h = u & 7, rg = (u >> 3) & 63, b = u >> 9;
        const int qr = 4 * rg + (wave >> 1), qc = 32 * (wave & 1) + ql;
        const int tq = b * SEQ + qr * GRIDW + qc;
        bf16x8 Qf[8];
        { v4u raw[8]; float ss = 0.f;
#pragma unroll
          for (int s = 0; s < 8; ++s) { raw[s] = *(const GAS v4u*)(Qb + (size_t)tq * 1024 + h * 128 + 16 * s + 8 * hf);
              const float a0 = bf_lo(raw[s].x), a1 = bf_hi(raw[s].x), a2 = bf_lo(raw[s].y), a3 = bf_hi(raw[s].y), a4 = bf_lo(raw[s].z), a5 = bf_hi(raw[s].z), a6 = bf_lo(raw[s].w), a7 = bf_hi(raw[s].w);
              ss += (a0 * a0 + a1 * a1) + (a2 * a2 + a3 * a3) + (a4 * a4 + a5 * a5) + (a6 * a6 + a7 * a7); }
          ss += __shfl_xor(ss, 32);
          const float qs = (1.0f / sqrtf(ss * (1.0f / 128.0f) + EPS)) * (0.08838834764831845f * LOG2E);
#pragma unroll
          for (int s = 0; s < 8; ++s) { const f32x4 g0 = *(const f32x4*)(gq + 16 * s + 8 * hf), g1 = *(const f32x4*)(gq + 16 * s + 8 * hf + 4);
              v4u o; o.x = pk2(bf_lo(raw[s].x) * qs * g0.x, bf_hi(raw[s].x) * qs * g0.y); o.y = pk2(bf_lo(raw[s].y) * qs * g0.z, bf_hi(raw[s].y) * qs * g0.w);
              o.z = pk2(bf_lo(raw[s].z) * qs * g1.x, bf_hi(raw[s].z) * qs * g1.y); o.w = pk2(bf_lo(raw[s].w) * qs * g1.z, bf_hi(raw[s].w) * qs * g1.w);
              Qf[s] = __builtin_bit_cast(bf16x8, o); } }
        if (tid < 465) rpbL[tid] = P.in[I_RPB][h * 465 + tid] * LOG2E;
        const int rs_q = min(max(qr - 4, 0), NROWS - 8);
        const int krlo = min(max(4 * rg - 4, 0), NROWS - 8), krhi = min(max(4 * rg + 3 - 4, 0), NROWS - 8) + 7, ntl = krhi - krlo + 1, T = ntl + 4;
        const int cs = min(max(qc - 8, 0), GRIDW - 16);
        f32x16 O[4];
#pragma unroll
        for (int db = 0; db < 4; ++db)
#pragma unroll
            for (int i = 0; i < 16; ++i) O[db][i] = 0.f;
        float m_run = -1e30f, l_run = 0.f;
        v4u kreg[2], vreg[2];
#define ATT_LOAD(t) do { const int _tb = (t) < ntl ? b * SEQ + (krlo + (t)) * GRIDW : NT + b * CTXL + 64 * ((t) - ntl); \
        _Pragma("unroll") for (int _i = 0; _i < 2; ++_i) { const int _c = tid + 512 * _i, _key = _c >> 4, _ch = _c & 15; const size_t _o = (size_t)(_tb + _key) * 1024 + h * 128 + _ch * 8; \
            kreg[_i] = *(const GAS v4u*)(KK + _o); vreg[_i] = *(const GAS v4u*)(VV + _o); } } while (0)
#define ATT_STORE(buf) do { _Pragma("unroll") for (int _i = 0; _i < 2; ++_i) { const int _c = tid + 512 * _i, _key = _c >> 4, _ch = _c & 15; const unsigned _o = (buf) * 16384 + (_key >> 5) * 8192 + off_b(_key & 31, _ch); \
            *(LAS v4u*)(kbuf + _o) = kreg[_i]; *(LAS v4u*)(vbuf + _o) = vreg[_i]; } } while (0)
        ATT_LOAD(0); ATT_STORE(0);
        __syncthreads();
        for (int t = 0; t < T; ++t) {
            if (t + 1 < T) ATT_LOAD(t + 1);
            const bool local = t < ntl; const int kr = krlo + t;
            const bool active = !local || (kr >= rs_q && kr <= rs_q + 7);
            if (active) {
                const LAS unsigned char* kb_ = kbuf + (t & 1) * 16384; const LAS unsigned char* vb_ = vbuf + (t & 1) * 16384;
                f32x16 S0, S1;
#pragma unroll
                for (int i = 0; i < 16; ++i) { S0[i] = 0.f; S1[i] = 0.f; }
#pragma unroll
                for (int s = 0; s < 8; ++s) { const bf16x8 a0 = row_frag(kb_, lane, s), a1 = row_frag(kb_ + 8192, lane, s); S0 = MFMA32(a0, Qf[s], S0); S1 = MFMA32(a1, Qf[s], S1); }
                if (local) {
                    const int dr = kr - qr + 7;
#pragma unroll
                    for (int r = 0; r < 16; ++r) { const int kc0 = crow(r, hf), kc1 = 32 + kc0;
                        { const bool ok = (unsigned)(kc0 - cs) < 16u; const int ci = min(max(kc0 - qc + 15, 0), 30); const float bia = rpbL[dr * 31 + ci]; S0[r] = ok ? S0[r] + bia : -1e30f; }
                        { const bool ok = (unsigned)(kc1 - cs) < 16u; const int ci = min(max(kc1 - qc + 15, 0), 30); const float bia = rpbL[dr * 31 + ci]; S1[r] = ok ? S1[r] + bia : -1e30f; } }
                }
                float mt = S0[0];
#pragma unroll
                for (int r = 1; r < 16; ++r) mt = fmaxf(mt, S0[r]);
#pragma unroll
                for (int r = 0; r < 16; ++r) mt = fmaxf(mt, S1[r]);
                mt = fmaxf(mt, __shfl_xor(mt, 32));
                const float m_new = fmaxf(m_run, mt), alpha = fast_exp2(m_run - m_new);
                m_run = m_new;
                float ps = 0.f;
#pragma unroll
                for (int r = 0; r < 16; ++r) { S0[r] = fast_exp2(S0[r] - m_new); S1[r] = fast_exp2(S1[r] - m_new); ps += S0[r] + S1[r]; }
                l_run = l_run * alpha + ps;
#pragma unroll
                for (int db = 0; db < 4; ++db)
#pragma unroll
                    for (int i = 0; i < 16; ++i) O[db][i] *= alpha;
#pragma unroll
                for (int kb = 0; kb < 2; ++kb)
#pragma unroll
                    for (int s2 = 0; s2 < 2; ++s2) {
                        v4u pp;
                        if (kb == 0) { pp.x = pk2(S0[8 * s2 + 0], S0[8 * s2 + 1]); pp.y = pk2(S0[8 * s2 + 2], S0[8 * s2 + 3]); pp.z = pk2(S0[8 * s2 + 4], S0[8 * s2 + 5]); pp.w = pk2(S0[8 * s2 + 6], S0[8 * s2 + 7]); }
                        else         { pp.x = pk2(S1[8 * s2 + 0], S1[8 * s2 + 1]); pp.y = pk2(S1[8 * s2 + 2], S1[8 * s2 + 3]); pp.z = pk2(S1[8 * s2 + 4], S1[8 * s2 + 5]); pp.w = pk2(S1[8 * s2 + 6], S1[8 * s2 + 7]); }
                        const bf16x8 pf = __builtin_bit_cast(bf16x8, pp);
#pragma unroll
                        for (int db = 0; db < 4; ++db) { const bf16x8 a = tr_frag<true>(vb_ + kb * 8192, lane, db, s2); O[db] = MFMA32(a, pf, O[db]); }
                    }
            }
            if (t + 1 < T) ATT_STORE((t + 1) & 1);
            __syncthreads();
        }
#undef ATT_LOAD
#undef ATT_STORE
        const float inv = 1.0f / (l_run + __shfl_xor(l_run, 32));
        bf16* orow = CAT + (size_t)tq * D + 1024 + h * 128;
#pragma unroll
        for (int db = 0; db < 4; ++db)
#pragma unroll
            for (int rq = 0; rq < 4; ++rq) { v2u o; o.x = pk2(O[db][4 * rq + 0] * inv, O[db][4 * rq + 1] * inv); o.y = pk2(O[db][4 * rq + 2] * inv, O[db][4 * rq + 3] * inv);
                *(GAS v2u*)(orow + 32 * db + 8 * rq + 4 * hf) = o; }
    }
}

DI void phase_conv(const Params& P, int lane, int wave) {
    const bf16* BG = (const bf16*)(P.ws + WS_R2); const bf16* CZ = BG + (size_t)NT * D; bf16* WC = (bf16*)(P.ws + WS_R3);
    const float* cw = P.in[I_CONVW];
    const int gw = blockIdx.x * NWAVES + wave, NGW = gridDim.x * NWAVES;
    for (int tok = gw; tok < NT; tok += NGW) {
        const int n = tok & (SEQ - 1); const bool hasm = n > 0, hasp = n < SEQ - 1;
        const GAS v2u* bg = (const GAS v2u*)(BG + (size_t)tok * D) + lane; const GAS v2u* z0 = (const GAS v2u*)(CZ + (size_t)tok * D) + lane;
        const GAS v2u* zm = (const GAS v2u*)(CZ + (size_t)(tok - (hasm ? 1 : 0)) * D) + lane; const GAS v2u* zp = (const GAS v2u*)(CZ + (size_t)(tok + (hasp ? 1 : 0)) * D) + lane;
        GAS v2u* o = (GAS v2u*)(WC + (size_t)tok * D) + lane;
        const float fm = hasm ? 1.f : 0.f, fp = hasp ? 1.f : 0.f;
#pragma unroll
        for (int j = 0; j < 8; ++j) { const int c = 256 * j + 4 * lane;
            const f32x4 w0 = *(const f32x4*)(cw + c) * fm, w1 = *(const f32x4*)(cw + D + c), w2 = *(const f32x4*)(cw + 2 * D + c) * fp;
            const v2u b_ = bg[64 * j], a = zm[64 * j], m = z0[64 * j], p = zp[64 * j];
            const float r0 = bf_lo(b_.x) * (w0.x * bf_lo(a.x) + w1.x * bf_lo(m.x) + w2.x * bf_lo(p.x));
            const float r1 = bf_hi(b_.x) * (w0.y * bf_hi(a.x) + w1.y * bf_hi(m.x) + w2.y * bf_hi(p.x));
            const float r2 = bf_lo(b_.y) * (w0.z * bf_lo(a.y) + w1.z * bf_lo(m.y) + w2.z * bf_lo(p.y));
            const float r3 = bf_hi(b_.y) * (w0.w * bf_hi(a.y) + w1.w * bf_hi(m.y) + w2.w * bf_hi(p.y));
            v2u w; w.x = pk2(r0, r1); w.y = pk2(r2, r3); o[64 * j] = w; }
    }
}

constexpr int NPHASE = 21;
__global__ void __launch_bounds__(NWAVES * 64, 2) mega_fwd(Params P) {
    extern __shared__ __attribute__((aligned(16))) unsigned char lds_raw[];
    LAS unsigned char* lds = (LAS unsigned char*)lds_raw;
    volatile LAS unsigned* MISC = (volatile LAS unsigned*)(lds + MISC_OFF);
    const int tid = threadIdx.x, lane = tid & 63, wave = __builtin_amdgcn_readfirstlane(tid >> 6);
    for (int u = tid; u < (LDS_BYTES - LDSCTL_OFF) / 4; u += NWAVES * 64) ((LAS unsigned*)(lds + LDSCTL_OFF))[u] = 0u;
    __syncthreads();
    unsigned* barw = (unsigned*)(P.ws + WS_CTL + CTL_BAR) + (size_t)P.li * XCD_BAR_WORDS;
    XcdBarrier bar; bar.bar = barw; bar.x = 0; bar.st = nullptr;
    const int lo = P.ph_lo, hi = P.ph_hi;
    if (hi - lo > 1) bar = xcd_barrier_post(barw, MISC + 8);
#define IN(k) (lo <= (k) && (k) < hi)
#define RUN(k, ...) do { if (IN(k)) { __VA_ARGS__; if constexpr ((k) == MK_DUP) { __VA_ARGS__; } } } while (0)
#define SEAM(k) do { if (IN(k) && IN((k) + 1)) xcd_barrier(bar); } while (0)
    unsigned char* ws = P.ws;
    const int G = gridDim.x, cid = blockIdx.x;
    const float* MOD = (const float*)(ws + WS_MOD);

    RUN(0, phase_prologue(P, lds, tid, lane, wave); __syncthreads()); SEAM(0);
    RUN(1, phase_norm1_l0(P, lds, tid, lane, wave)); SEAM(1);
#define GEMM_IN0() do { { pg8::Gemm g{(const bf16*)(ws + WS_H), (const bf16*)(ws + WS_WIN0), NT, 2048, D}; pg8::StaticOrder<false> S; S.init(NT, 2048, G, cid); \
        EpiIn0 E{(bf16*)(ws + WS_R2), 0, 1.0f}; pg8::gemm_phase<EpiIn0, pg8::StaticOrder<false>, true, true>(lds, g, S, E); } \
      { const bool withctx = G < 64; pg8::Gemm g{(const bf16*)(ws + WS_H8), (const bf16*)(ws + WS_WIN0F8), withctx ? MTOT : NT, 3072, D / 2}; pg8::StaticOrder<false> S; S.init(withctx ? MTOT : NT, 3072, G, cid); \
        EpiIn0 E{(bf16*)(ws + WS_R2), 2, F8_WINV}; pg8::gemm_phase<EpiIn0, pg8::StaticOrder<false>, true, true, true>(lds, g, S, E); } } while (0)
    RUN(2, GEMM_IN0()); SEAM(2);
    if (IN(3)) phase_knorm(P, lane, wave);
    RUN(3, phase_gmlp(P, lds, tid, lane, wave)); SEAM(3);
    RUN(4, phase_attn(P, lds, tid, lane, wave)); SEAM(4);
#define GEMM_OUT0() do { pg8::Gemm g{(const bf16*)(ws + WS_R3), (const bf16*)(ws + WS_WOUT0), NT, D, D}; pg8::StaticOrder<false> S; S.init(NT, D, G, cid); \
        EpiResid<true> E{(const void*)P.in[I_X], (bf16*)(ws + WS_XLB), MOD + 2 * 2048}; pg8::gemm_phase<EpiResid<true>, pg8::StaticOrder<false>, true, true>(lds, g, S, E); } while (0)
    RUN(5, GEMM_OUT0()); SEAM(5);
#define GEMM_GU(L) do { static_assert(F8L(L), "gathered gate|up GEMM is fp8 only"); \
        pg8::Gemm g{(const bf16*)(ws + WS_H), (const bf16*)(ws + WS_GU) + (size_t)(L) * 16 * 2048 * 2048, 65536, 2048, D / 2}; pg8::StaticOrder<true> S; S.init(65536, 2048, G, cid); \
        LAS int* tbl = (LAS int*)(lds + LDS_GTBL); const int* IDXg = (const int*)(ws + WS_IDX); \
        for (int e_ = tid; e_ < 8 * 256; e_ += NWAVES * 64) { const int ui_ = e_ >> 8, r_ = e_ & 255; pg8::Unit u_; \
            if (S.next(ui_, u_)) { const int rowid = u_.pm * 256 + r_, ex = rowid >> 12, b_ = (rowid >> 11) & 1, slot = rowid & 2047; tbl[e_] = b_ * SEQ + IDXg[(b_ * 16 + ex) * CAP + slot]; } } \
        __syncthreads(); \
        EpiSwiglu<true> E{(void*)(ws + WS_HID)}; pg8::gemm_phase_gather_f8<EpiSwiglu<true>, pg8::StaticOrder<true>>(lds, g, S, E, tbl); } while (0)
#define GEMM_DN(L) do { constexpr bool F8 = F8L(L); pg8::Gemm g{(const bf16*)(ws + WS_HID), (const bf16*)(ws + WS_DN) + (size_t)(L) * 16 * 2048 * 1024, 65536, 2048, F8 ? FF / 2 : FF}; pg8::StaticOrder<true> S; S.init(65536, 2048, G, cid); \
        EpiPlain E{(bf16*)(ws + WS_R3), D, F8 ? F8_WINV : 1.0f}; pg8::gemm_phase<EpiPlain, pg8::StaticOrder<true>, true, true, F8>(lds, g, S, E); } while (0)
#define MOE_PHASES(L, base) \
    RUN(base + 0, phase_norm2_router(P, L, lds, tid, lane, wave)); SEAM(base + 0); \
    if (IN(base + 1)) { phase_topk(P, L, lds, tid, lane, wave); } SEAM(base + 1); \
    RUN(base + 3, GEMM_GU(L)); SEAM(base + 3); \
    RUN(base + 4, GEMM_DN(L)); SEAM(base + 4);
    MOE_PHASES(0, 6)
    if (IN(11)) { phase_combine<true>(P, 0, lane, wave); } SEAM(11);
#define GEMM_CIN() do { pg8::Gemm g{(const bf16*)(ws + WS_H), (const bf16*)(ws + WS_WCIN), NT, 6144, D}; pg8::StaticOrder<false> S; S.init(NT, 6144, G, cid); S.hot = NOST; \
        EpiCin E{(bf16*)(ws + WS_R2), (bf16*)(ws + WS_R2) + (size_t)NT * D, NOST}; pg8::gemm_phase<EpiCin, pg8::StaticOrder<false>, true, true>(lds, g, S, E); } while (0)
#define NOST 0
    RUN(12, GEMM_CIN()); SEAM(12);
#undef NOST
#if MK_DUP == 112
#define NOST (P.pad + 1)
    if (IN(12)) { GEMM_CIN(); }
#undef NOST
#endif
    RUN(13, phase_conv(P, lane, wave)); SEAM(13);
    if (IN(14)) {
        pg8::Gemm g{(const bf16*)(ws + WS_R3), (const bf16*)(ws + WS_WCOUT), NT, D, D}; pg8::StaticOrder<false> S; S.init(NT, D, G, cid);
        EpiResid<false> E{(const void*)(ws + WS_XLB), (bf16*)(ws + WS_XLB), MOD + 3 * 12288 + 2 * 2048};
        pg8::gemm_phase<EpiResid<false>, pg8::StaticOrder<false>, true, true>(lds, g, S, E);
    } SEAM(14);
    MOE_PHASES(1, 15)
    if (IN(20)) { phase_combine<false>(P, 1, lane, wave); }
#undef IN
#undef SEAM
}

extern "C" void kernel_launch(void* const* d_in, const int* in_sizes, int n_in, void* d_out, int out_size, void* d_ws, size_t ws_size, hipStream_t stream) {
    static int grid = 0;
    if (grid == 0) {
        if (n_in != 23 || out_size != NT * D || ws_size < WS_END) { fprintf(stderr, "kernel_launch: unexpected shapes (n_in %d out %d ws %zu)\n", n_in, out_size, ws_size); grid = -1; return; }
        int dev = 0, cus = 0, per_cu = 0;
        if (hipGetDevice(&dev) != hipSuccess || hipDeviceGetAttribute(&cus, hipDeviceAttributeMultiprocessorCount, dev) != hipSuccess) { grid = -1; return; }
        if (hipFuncSetAttribute((const void*)mega_fwd, hipFuncAttributeMaxDynamicSharedMemorySize, LDS_BYTES) != hipSuccess) { fprintf(stderr, "kernel_launch: hipFuncSetAttribute failed\n"); grid = -1; return; }
        if (hipOccupancyMaxActiveBlocksPerMultiprocessor(&per_cu, (const void*)mega_fwd, NWAVES * 64, LDS_BYTES) != hipSuccess || per_cu < 1) { fprintf(stderr, "kernel_launch: occupancy query says %d\n", per_cu); }
        (void)hipGetLastError();
        grid = cus;
    }
    if (grid < 0) return;
    (void)hipMemsetAsync((char*)d_ws + WS_CTL, 0, CTL_ZERO_BYTES, stream);
    Params p{};
    for (int i = 0; i < 23; ++i) p.in[i] = (const float*)d_in[i];
    p.out = (float*)d_out; p.ws = (unsigned char*)d_ws; p.pad = 0;
    const int last = MK_STOP < NPHASE - 1 ? MK_STOP : NPHASE - 1;
#if MK_SPLIT
    for (int k = 0; k <= last; ++k) { p.ph_lo = k; p.ph_hi = k + 1; p.li = 0; hipLaunchKernelGGL(mega_fwd, dim3(grid), dim3(NWAVES * 64), LDS_BYTES, stream, p); }
#else
    p.ph_lo = 0; p.ph_hi = last + 1; p.li = 0;
    hipLaunchKernelGGL(mega_fwd, dim3(grid), dim3(NWAVES * 64), LDS_BYTES, stream, p);
#endif
}
```

```cpp
#include <hip/hip_runtime.h>
#include <cstdio>
#include <cstdint>

#ifndef MK_SPLIT
#define MK_SPLIT 0
#endif
#ifndef MK_STOP
#define MK_STOP 99
#endif
#ifndef MK_FP8_L0
#define MK_FP8_L0 1
#endif
#ifndef MK_FP8_L1
#define MK_FP8_L1 1
#endif
#ifndef MK_NOST
#define MK_NOST 2
#endif
#ifndef MK_DUP
#define MK_DUP -1
#endif

namespace pg8 {
#define PG8_LAS __attribute__((address_space(3)))
typedef unsigned short bf16_t;
typedef short bf16x8 __attribute__((ext_vector_type(8)));
typedef float f32x4 __attribute__((ext_vector_type(4)));
typedef unsigned u32x4 __attribute__((ext_vector_type(4)));
constexpr int BM = 256, BK = 64, HALF = 128, HTB = HALF * BK * 2, STAGE_BYTES = 8 * HTB, NXCD = 8, WGM = 8;

__host__ __device__ __forceinline__ int lds_byte(int r, int c) { const int st = (r >> 4) * 2 + (c >> 5), rr = r & 15, cc = c & 31, ob = rr * 64 + cc * 2; return st * 1024 + (ob ^ (((ob >> 9) & 1) << 5)); }
__host__ __device__ __forceinline__ void stage_rc(int b, int& R, int& C) { const int st = b / 1024, sb = b % 1024, swz = sb ^ (((sb >> 9) & 1) << 5); R = (st >> 1) * 16 + swz / 64; C = (st & 1) * 32 + (swz % 64) / 2; }
__host__ __device__ __forceinline__ int perm32(int rho) { const int n = rho >> 4, i = rho & 15; return 8 * (i >> 2) + 4 * n + (i & 3); }

struct Unit { int pm, pn, pb; };
struct Gemm { const bf16_t* A; const bf16_t* Bt; int M, N, K; };

template <bool GROUPED>
struct StaticOrder {
    int nM, nN, nwg, G, c, hot;
    __host__ __device__ void init(int M, int N, int G_, int c_) { nM = M / BM; nN = N / BM; nwg = nM * nN; G = G_; c = c_; hot = 0; }
    __host__ __device__ __forceinline__ bool next(int i, Unit& u) const {
        const long L = (long)i * G + c; if (L >= nwg) return false;
        int wgid = (int)L; { const int q = nwg / NXCD, r = nwg % NXCD, xcd = wgid % NXCD, off = wgid / NXCD; wgid = (xcd < r ? xcd * (q + 1) : r * (q + 1) + (xcd - r) * q) + off; }
        const int nig = WGM * nN, gid = wgid / nig, fm = gid * WGM, gsz = (nM - fm) < WGM ? (nM - fm) : WGM;
        u.pm = fm + ((wgid % nig) % gsz); u.pn = (wgid % nig) / gsz;
        u.pb = GROUPED ? ((u.pm >> 4) * 8 + u.pn) : u.pn;
        if (hot) { u.pm = 0; u.pn = 0; u.pb = 0; }
        return true;
    }
    __device__ __forceinline__ void a_ready(const Unit&) const {}
    __device__ __forceinline__ void done(const Unit&) const {}
};

__device__ __forceinline__ unsigned cvt_pk_bf16(float lo, float hi) { unsigned r; asm volatile("v_cvt_pk_bf16_f32 %0, %1, %2" : "=v"(r) : "v"(lo), "v"(hi)); return r; }

typedef int i32x4 __attribute__((ext_vector_type(4)));
typedef int i32x8 __attribute__((ext_vector_type(8)));
__device__ __forceinline__ i32x8 cat8(bf16x8 lo, bf16x8 hi) { return __builtin_shufflevector(__builtin_bit_cast(i32x4, lo), __builtin_bit_cast(i32x4, hi), 0, 1, 2, 3, 4, 5, 6, 7); }
template <class Epi, class Sched, bool ALIGN_EPI = false, bool SP2 = false, bool FP8 = false>
__device__ __forceinline__ void gemm_phase(PG8_LAS unsigned char* lds, const Gemm g, const Sched& S, const Epi& E) {
    const int tid = threadIdx.x, wid = __builtin_amdgcn_readfirstlane(tid >> 6), lane = tid & 63, wr = wid >> 2, wc = wid & 3, fr = lane & 15, fq = lane >> 4;
    const int K = g.K, nt = K / BK;
    constexpr bool WIDE = (Epi::PERM == 2);
    unsigned voffA[2], voffB[2];
#pragma unroll
    for (int i = 0; i < 2; ++i) { int R, C; stage_rc(tid * 16 + i * 8192, R, C); const int Rb = WIDE ? (64 * (R >> 5) + perm32(R & 31)) : (Epi::PERM ? ((R & ~31) + perm32(R & 31)) : R);
        voffA[i] = (unsigned)(R * K + C) * 2u; voffB[i] = (unsigned)(Rb * K + C) * 2u; }
    const size_t kstep = (size_t)(BK * 2);
    const size_t hstep = (size_t)HALF * K * 2;
    const size_t tstep = 2 * hstep;
    const size_t hstepB = WIDE ? (size_t)32 * K * 2 : hstep;
    const unsigned ldsw = (unsigned)wid * 1024u;
    const int aoff = lds_byte(wr * 64 + fr, fq * 8), boff = lds_byte(wc * 32 + fr, fq * 8);
#define PG8_SA(b, h) (((b) * 2 + (h)) * HTB)
#define PG8_SB(b, h) ((4 + (b) * 2 + (h)) * HTB)
#define PG8_STAGE(bufoff, gbase, voff) do { _Pragma("unroll") for (int _i = 0; _i < 2; ++_i) \
        __builtin_amdgcn_global_load_lds((const unsigned*)((const char*)(gbase) + (voff)[_i]), (PG8_LAS unsigned*)(lds + (bufoff) + ldsw + _i * 8192), 16, 0, 0); } while (0)
#define PG8_LDA(dst, b, h) do { _Pragma("unroll") for (int m = 0; m < 4; ++m) _Pragma("unroll") for (int k = 0; k < 2; ++k) dst[m][k] = *(const PG8_LAS bf16x8*)(lds + PG8_SA(b, h) + aoff + m * 2048 + k * 1024); } while (0)
#define PG8_LDB(dst, b, h) do { _Pragma("unroll") for (int n = 0; n < 2; ++n) _Pragma("unroll") for (int k = 0; k < 2; ++k) dst[n][k] = *(const PG8_LAS bf16x8*)(lds + PG8_SB(b, h) + boff + n * 2048 + k * 1024); } while (0)
#define PG8_MMA(ai, bj, At, Bt) do { __builtin_amdgcn_s_setprio(1); _Pragma("unroll") for (int m = 0; m < 4; ++m) _Pragma("unroll") for (int n = 0; n < 2; ++n) { \
        if constexpr (FP8) { const i32x8 _a = cat8(Bt[n][0], Bt[n][1]), _b = cat8(At[m][0], At[m][1]); asm volatile("v_mfma_f32_16x16x128_f8f6f4 %0, %1, %2, %0" : "+v"(acc[ai][bj][m][n]) : "v"(_a), "v"(_b)); } \
        else { _Pragma("unroll") for (int k = 0; k < 2; ++k) acc[ai][bj][m][n] = __builtin_amdgcn_mfma_f32_16x16x32_bf16(Bt[n][k], At[m][k], acc[ai][bj][m][n], 0, 0, 0); } } \
        __builtin_amdgcn_s_setprio(0); } while (0)
#define PG8_WAIT_V(n) asm volatile("s_waitcnt vmcnt(" #n ")" ::: "memory")
#define PG8_WAIT_L(n) asm volatile("s_waitcnt lgkmcnt(" #n ")" ::: "memory")
#define PG8_BAR __builtin_amdgcn_s_barrier()
#define PG8_SCHED __builtin_amdgcn_sched_barrier(0)
    Unit cur, nxt; int ui = 0;
    if (!S.next(0, cur)) return;
    f32x4 acc[2][2][4][2];
#pragma unroll
    for (int a = 0; a < 2; ++a)
#pragma unroll
        for (int b = 0; b < 2; ++b)
#pragma unroll
            for (int m = 0; m < 4; ++m)
#pragma unroll
                for (int n = 0; n < 2; ++n) acc[a][b][m][n] = (f32x4){0.f, 0.f, 0.f, 0.f};
    bf16x8 At[4][2], B0[2][2], B1[2][2];
    const char* cA = (const char*)g.A + (size_t)cur.pm * tstep; const char* cB = (const char*)g.Bt + (size_t)cur.pb * tstep;
    S.a_ready(cur);
    if constexpr (SP2) {
        PG8_STAGE(PG8_SB(0, 0), cB, voffB); PG8_STAGE(PG8_SB(0, 1), cB + hstepB, voffB); PG8_STAGE(PG8_SA(0, 0), cA, voffA); PG8_STAGE(PG8_SA(0, 1), cA + hstep, voffA);
        if (wr == 1) PG8_BAR;
        PG8_WAIT_V(2); PG8_BAR;
        PG8_STAGE(PG8_SB(1, 0), cB + kstep, voffB); PG8_STAGE(PG8_SA(1, 0), cA + kstep, voffA); PG8_STAGE(PG8_SB(1, 1), cB + hstepB + kstep, voffB);
        PG8_WAIT_V(6); PG8_BAR;
    } else {
        PG8_STAGE(PG8_SB(0, 0), cB, voffB); PG8_STAGE(PG8_SA(0, 0), cA, voffA); PG8_STAGE(PG8_SB(0, 1), cB + hstepB, voffB); PG8_STAGE(PG8_SA(0, 1), cA + hstep, voffA);
        if (wr == 1) PG8_BAR;
        PG8_WAIT_V(4); PG8_BAR;
        PG8_STAGE(PG8_SB(1, 0), cB + kstep, voffB); PG8_STAGE(PG8_SA(1, 0), cA + kstep, voffA); PG8_STAGE(PG8_SB(1, 1), cB + hstepB + kstep, voffB);
        PG8_WAIT_V(6); PG8_BAR;
    }
    for (;;) {
        const bool has_next = S.next(ui + 1, nxt);
        const char* nA = has_next ? (const char*)g.A + (size_t)nxt.pm * tstep : cA; const char* nB = has_next ? (const char*)g.Bt + (size_t)nxt.pb * tstep : cB;
        for (int t = 0; t < nt; t += 2) {
            const bool last = (t == nt - 2);
            const char* a1 = cA + (size_t)(t + 1) * kstep;
            const char* a2 = last ? nA : cA + (size_t)(t + 2) * kstep; const char* b2 = last ? nB : cB + (size_t)(t + 2) * kstep;
            const char* a3 = a2 + kstep; const char* b3 = b2 + kstep;
            if (last && has_next) S.a_ready(nxt);
            if constexpr (SP2) {
            PG8_LDB(B0, 0, 0); PG8_LDB(B1, 0, 1); PG8_SCHED; PG8_LDA(At, 0, 0); PG8_STAGE(PG8_SA(1, 1), a1 + hstep, voffA);
            PG8_WAIT_V(8); PG8_WAIT_L(0); PG8_BAR; PG8_MMA(0, 0, At, B0); PG8_MMA(0, 1, At, B1); PG8_BAR; PG8_SCHED;
            PG8_LDA(At, 0, 1); PG8_STAGE(PG8_SB(0, 0), b2, voffB); PG8_STAGE(PG8_SB(0, 1), b2 + hstepB, voffB); PG8_STAGE(PG8_SA(0, 0), a2, voffA);
            PG8_WAIT_V(8); PG8_WAIT_L(0); PG8_BAR; PG8_MMA(1, 0, At, B0); PG8_MMA(1, 1, At, B1); PG8_BAR; PG8_SCHED;
            PG8_LDB(B0, 1, 0); PG8_LDB(B1, 1, 1); PG8_SCHED; PG8_LDA(At, 1, 0); PG8_STAGE(PG8_SA(0, 1), a2 + hstep, voffA);
            PG8_WAIT_V(8); PG8_WAIT_L(0); PG8_BAR; PG8_MMA(0, 0, At, B0); PG8_MMA(0, 1, At, B1); PG8_BAR; PG8_SCHED;
            PG8_LDA(At, 1, 1); PG8_STAGE(PG8_SB(1, 0), b3, voffB); PG8_STAGE(PG8_SB(1, 1), b3 + hstepB, voffB); PG8_STAGE(PG8_SA(1, 0), a3, voffA);
            PG8_WAIT_V(8); PG8_WAIT_L(0); PG8_BAR; PG8_MMA(1, 0, At, B0); PG8_MMA(1, 1, At, B1); PG8_BAR; PG8_SCHED;
            } else {
            PG8_LDB(B0, 0, 0); PG8_SCHED; PG8_LDA(At, 0, 0); PG8_STAGE(PG8_SA(1, 1), a1 + hstep, voffA);
            PG8_WAIT_L(8); PG8_BAR; PG8_WAIT_L(0); PG8_MMA(0, 0, At, B0); PG8_BAR; PG8_SCHED;
            PG8_LDB(B1, 0, 1); PG8_STAGE(PG8_SB(0, 0), b2, voffB);
            PG8_BAR; PG8_WAIT_L(0); PG8_MMA(0, 1, At, B1); PG8_BAR;
            PG8_LDA(At, 0, 1); PG8_STAGE(PG8_SA(0, 0), a2, voffA);
            PG8_BAR; PG8_WAIT_L(0); PG8_MMA(1, 0, At, B0); PG8_BAR; PG8_SCHED;
            PG8_STAGE(PG8_SB(0, 1), b2 + hstepB, voffB);
            PG8_WAIT_V(6); PG8_BAR; PG8_MMA(1, 1, At, B1); PG8_BAR;
            PG8_LDB(B0, 1, 0); PG8_SCHED; PG8_LDA(At, 1, 0); PG8_STAGE(PG8_SA(0, 1), a2 + hstep, voffA);
            PG8_WAIT_L(8); PG8_BAR; PG8_WAIT_L(0); PG8_MMA(0, 0, At, B0); PG8_BAR; PG8_SCHED;
            PG8_LDB(B1, 1, 1); PG8_STAGE(PG8_SB(1, 0), b3, voffB);
            PG8_BAR; PG8_WAIT_L(0); PG8_MMA(0, 1, At, B1); PG8_BAR;
            PG8_LDA(At, 1, 1); PG8_STAGE(PG8_SA(1, 0), a3, voffA);
            PG8_BAR; PG8_WAIT_L(0); PG8_MMA(1, 0, At, B0); PG8_BAR; PG8_SCHED;
            PG8_STAGE(PG8_SB(1, 1), b3 + hstepB, voffB);
            PG8_WAIT_V(6); PG8_BAR; PG8_MMA(1, 1, At, B1); PG8_BAR;
            }
        }
        if constexpr (ALIGN_EPI) { if (wr == 0) PG8_BAR; }
        if constexpr (FP8) asm volatile("s_nop 7\n\ts_nop 7\n\ts_nop 7" ::: "memory");
        E(acc, cur, wr, wc, fr, fq);
        if (!has_next) break;
#pragma unroll
        for (int a = 0; a < 2; ++a)
#pragma unroll
            for (int b = 0; b < 2; ++b)
#pragma unroll
                for (int m = 0; m < 4; ++m)
#pragma unroll
                    for (int n = 0; n < 2; ++n) acc[a][b][m][n] = (f32x4){0.f, 0.f, 0.f, 0.f};
        cur = nxt; cA = nA; cB = nB; ++ui;
        if constexpr (ALIGN_EPI) { if (wr == 1) PG8_BAR; }
    }
    PG8_WAIT_V(0);
    if constexpr (!ALIGN_EPI) { if (wr == 0) PG8_BAR; }
    PG8_BAR;
#undef PG8_SA
#undef PG8_SB
#undef PG8_STAGE
#undef PG8_LDA
#undef PG8_LDB
#undef PG8_MMA
#undef PG8_WAIT_V
#undef PG8_WAIT_L
#undef PG8_BAR
#undef PG8_SCHED
}

template <class Epi, class Sched>
__device__ __forceinline__ void gemm_phase_gather_f8(PG8_LAS unsigned char* lds, const Gemm g, const Sched& S, const Epi& E, const PG8_LAS int* tbl) {
    const int tid = threadIdx.x, wid = __builtin_amdgcn_readfirstlane(tid >> 6), lane = tid & 63, wr = wid >> 2, wc = wid & 3, fr = lane & 15, fq = lane >> 4;
    const int K = g.K, nt = K / BK;
    const unsigned rowb = (unsigned)K * 2u;
    unsigned voffB[2]; int RA[2]; unsigned CA[2];
#pragma unroll
    for (int i = 0; i < 2; ++i) { int R, C; stage_rc(tid * 16 + i * 8192, R, C); const int Rb = Epi::PERM ? ((R & ~31) + perm32(R & 31)) : R;
        RA[i] = R; CA[i] = (unsigned)C * 2u; voffB[i] = (unsigned)(Rb * K + C) * 2u; }
    const size_t kstep = (size_t)(BK * 2);
    const size_t hstep = (size_t)HALF * K * 2;
    const size_t tstep = 2 * hstep;
    const unsigned ldsw = (unsigned)wid * 1024u;
    const int aoff = lds_byte(wr * 64 + fr, fq * 8), boff = lds_byte(wc * 32 + fr, fq * 8);
#define PG8_SA(b, h) (((b) * 2 + (h)) * HTB)
#define PG8_SB(b, h) ((4 + (b) * 2 + (h)) * HTB)
#define PG8_STAGE(bufoff, gbase, voff) do { _Pragma("unroll") for (int _i = 0; _i < 2; ++_i) \
        __builtin_amdgcn_global_load_lds((const unsigned*)((const char*)(gbase) + (voff)[_i]), (PG8_LAS unsigned*)(lds + (bufoff) + ldsw + _i * 8192), 16, 0, 0); } while (0)
#define PG8_STAGE_G(bufoff, koff, o0, o1) do { \
        __builtin_amdgcn_global_load_lds((const unsigned*)(gA + (koff) + (o0)), (PG8_LAS unsigned*)(lds + (bufoff) + ldsw), 16, 0, 0); \
        __builtin_amdgcn_global_load_lds((const unsigned*)(gA + (koff) + (o1)), (PG8_LAS unsigned*)(lds + (bufoff) + ldsw + 8192), 16, 0, 0); } while (0)
#define PG8_LDA(dst, b, h) do { _Pragma("unroll") for (int m = 0; m < 4; ++m) _Pragma("unroll") for (int k = 0; k < 2; ++k) dst[m][k] = *(const PG8_LAS bf16x8*)(lds + PG8_SA(b, h) + aoff + m * 2048 + k * 1024); } while (0)
#define PG8_LDB(dst, b, h) do { _Pragma("unroll") for (int n = 0; n < 2; ++n) _Pragma("unroll") for (int k = 0; k < 2; ++k) dst[n][k] = *(const PG8_LAS bf16x8*)(lds + PG8_SB(b, h) + boff + n * 2048 + k * 1024); } while (0)
#define PG8_MMA(ai, bj, At, Bt) do { __builtin_amdgcn_s_setprio(1); _Pragma("unroll") for (int m = 0; m < 4; ++m) _Pragma("unroll") for (int n = 0; n < 2; ++n) { \
        const i32x8 _a = cat8(Bt[n][0], Bt[n][1]), _b = cat8(At[m][0], At[m][1]); asm volatile("v_mfma_f32_16x16x128_f8f6f4 %0, %1, %2, %0" : "+v"(acc[ai][bj][m][n]) : "v"(_a), "v"(_b)); } \
        __builtin_amdgcn_s_setprio(0); } while (0)
#define PG8_WAIT_V(n) asm volatile("s_waitcnt vmcnt(" #n ")" ::: "memory")
#define PG8_WAIT_L(n) asm volatile("s_waitcnt lgkmcnt(" #n ")" ::: "memory")
#define PG8_BAR __builtin_amdgcn_s_barrier()
#define PG8_SCHED __builtin_amdgcn_sched_barrier(0)
#define PG8_OFFS(dst, ui_) do { _Pragma("unroll") for (int _h = 0; _h < 2; ++_h) _Pragma("unroll") for (int _i = 0; _i < 2; ++_i) \
        dst[_h][_i] = (unsigned)tbl[(ui_) * 256 + _h * HALF + RA[_i]] * rowb + CA[_i]; } while (0)
    Unit cur, nxt; int ui = 0;
    if (!S.next(0, cur)) return;
    const char* gA = (const char*)g.A;
    unsigned oc[2][2], on[2][2];
    PG8_OFFS(oc, 0);
    f32x4 acc[2][2][4][2];
#pragma unroll
    for (int a = 0; a < 2; ++a)
#pragma unroll
        for (int b = 0; b < 2; ++b)
#pragma unroll
            for (int m = 0; m < 4; ++m)
#pragma unroll
                for (int n = 0; n < 2; ++n) acc[a][b][m][n] = (f32x4){0.f, 0.f, 0.f, 0.f};
    bf16x8 At[4][2], B0[2][2], B1[2][2];
    const char* cB = (const char*)g.Bt + (size_t)cur.pb * tstep;
    PG8_STAGE(PG8_SB(0, 0), cB, voffB); PG8_STAGE(PG8_SB(0, 1), cB + hstep, voffB); PG8_STAGE_G(PG8_SA(0, 0), 0, oc[0][0], oc[0][1]); PG8_STAGE_G(PG8_SA(0, 1), 0, oc[1][0], oc[1][1]);
    if (wr == 1) PG8_BAR;
    PG8_WAIT_V(2); PG8_BAR;
    PG8_STAGE(PG8_SB(1, 0), cB + kstep, voffB); PG8_STAGE_G(PG8_SA(1, 0), kstep, oc[0][0], oc[0][1]); PG8_STAGE(PG8_SB(1, 1), cB + hstep + kstep, voffB);
    PG8_WAIT_V(6); PG8_BAR;
    for (;;) {
        const bool has_next = S.next(ui + 1, nxt);
        const char* nB = has_next ? (const char*)g.Bt + (size_t)nxt.pb * tstep : cB;
        if (has_next) PG8_OFFS(on, ui + 1);
        else {
#pragma unroll
            for (int _h = 0; _h < 2; ++_h)
#pragma unroll
                for (int _i = 0; _i < 2; ++_i) on[_h][_i] = oc[_h][_i]; }
        for (int t = 0; t < nt; t += 2) {
            const bool last = (t == nt - 2);
            const size_t k1 = (size_t)(t + 1) * kstep, k2 = last ? 0 : (size_t)(t + 2) * kstep, k3 = k2 + kstep;
            const char* b2 = last ? nB : cB + (size_t)(t + 2) * kstep; const char* b3 = b2 + kstep;
            const unsigned o00 = last ? on[0][0] : oc[0][0], o01 = last ? on[0][1] : oc[0][1], o10 = last ? on[1][0] : oc[1][0], o11 = last ? on[1][1] : oc[1][1];
            PG8_LDB(B0, 0, 0); PG8_LDB(B1, 0, 1); PG8_SCHED; PG8_LDA(At, 0, 0); PG8_STAGE_G(PG8_SA(1, 1), k1, oc[1][0], oc[1][1]);
            PG8_WAIT_V(8); PG8_WAIT_L(0); PG8_BAR; PG8_MMA(0, 0, At, B0); PG8_MMA(0, 1, At, B1); PG8_BAR; PG8_SCHED;
            PG8_LDA(At, 0, 1); PG8_STAGE(PG8_SB(0, 0), b2, voffB); PG8_STAGE(PG8_SB(0, 1), b2 + hstep, voffB); PG8_STAGE_G(PG8_SA(0, 0), k2, o00, o01);
            PG8_WAIT_V(8); PG8_WAIT_L(0); PG8_BAR; PG8_MMA(1, 0, At, B0); PG8_MMA(1, 1, At, B1); PG8_BAR; PG8_SCHED;
            PG8_LDB(B0, 1, 0); PG8_LDB(B1, 1, 1); PG8_SCHED; PG8_LDA(At, 1, 0); PG8_STAGE_G(PG8_SA(0, 1), k2, o10, o11);
            PG8_WAIT_V(8); PG8_WAIT_L(0); PG8_BAR; PG8_MMA(0, 0, At, B0); PG8_MMA(0, 1, At, B1); PG8_BAR; PG8_SCHED;
            PG8_LDA(At, 1, 1); PG8_STAGE(PG8_SB(1, 0), b3, voffB); PG8_STAGE(PG8_SB(1, 1), b3 + hstep, voffB); PG8_STAGE_G(PG8_SA(1, 0), k3, o00, o01);
            PG8_WAIT_V(8); PG8_WAIT_L(0); PG8_BAR; PG8_MMA(1, 0, At, B0); PG8_MMA(1, 1, At, B1); PG8_BAR; PG8_SCHED;
        }
        if (wr == 0) PG8_BAR;
        asm volatile("s_nop 7\n\ts_nop 7\n\ts_nop 7" ::: "memory");
        E(acc, cur, wr, wc, fr, fq);
        if (!has_next) break;
#pragma unroll
        for (int a = 0; a < 2; ++a)
#pragma unroll
            for (int b = 0; b < 2; ++b)
#pragma unroll
                for (int m = 0; m < 4; ++m)
#pragma unroll
                    for (int n = 0; n < 2; ++n) acc[a][b][m][n] = (f32x4){0.f, 0.f, 0.f, 0.f};
        cur = nxt; cB = nB; ++ui;
#pragma unroll
        for (int _h = 0; _h < 2; ++_h)
#pragma unroll
            for (int _i = 0; _i < 2; ++_i) oc[_h][_i] = on[_h][_i];
        if (wr == 1) PG8_BAR;
    }
    PG8_WAIT_V(0);
    PG8_BAR;
#undef PG8_SA
#undef PG8_SB
#undef PG8_STAGE
#undef PG8_STAGE_G
#undef PG8_LDA
#undef PG8_LDB
#undef PG8_MMA
#undef PG8_WAIT_V
#undef PG8_WAIT_L
#undef PG8_BAR
#undef PG8_SCHED
#undef PG8_OFFS
}
}

constexpr int D = 2048, NB = 2, SEQ = 16384, NT = NB * SEQ, CTXL = 256, NCTX = NB * CTXL, MTOT = NT + NCTX;
constexpr int NEXP = 16, CAP = 2048, FF = 1024, GRIDW = 64, NROWS = 256;
constexpr float EPS = 1e-6f;
constexpr float LOG2E = 1.4426950408889634f;
constexpr int NWAVES = 8;

constexpr size_t MiB = 1u << 20;
constexpr size_t WS_CTL = 0, CTL_ZERO_BYTES = 1 * MiB;
constexpr size_t CTL_TOKCNT0 = 262144, CTL_TOKCNT1 = 393216, CTL_BAR = 524288;
constexpr size_t WS_MOD = 1 * MiB;
constexpr size_t WS_AFF = 2 * MiB;
constexpr size_t WS_IDX = 4 * MiB;
constexpr size_t WS_TOKLIST = 5 * MiB;
constexpr size_t WS_WSB = 9 * MiB;
constexpr size_t WS_WIN0 = 10 * MiB, WS_WOUT0 = 30 * MiB, WS_WCIN = 38 * MiB, WS_WCOUT = 62 * MiB;
constexpr size_t WS_GU = 70 * MiB;
constexpr size_t WS_DN = 326 * MiB;
constexpr size_t WS_H = 454 * MiB;
constexpr size_t WS_R2 = 584 * MiB;
constexpr size_t WS_R3 = 968 * MiB;
constexpr size_t WS_H8 = 1224 * MiB;
constexpr size_t WS_END = 1289 * MiB;
constexpr size_t WS_WIN0F8 = WS_WIN0 + 8 * MiB;
constexpr size_t WS_XLB = WS_R2 + 256 * MiB;
constexpr size_t WS_HID = WS_R2 + 128 * MiB;
static_assert(MK_FP8_L0 && MK_FP8_L1, "the workspace map assumes fp8 MoE activations");
constexpr size_t R2_T = (size_t)MTOT * 1024;

constexpr int LDS_SCR = 0;
constexpr int LDSCTL_OFF = 146944, MISC_OFF = LDSCTL_OFF;
constexpr int LDS_KPART = 131072;
constexpr int LDS_GTBL = 138752;
constexpr int LDS_BYTES = 147456;

#define GAS __attribute__((address_space(1)))
#define LAS __attribute__((address_space(3)))
#define DI __device__ __forceinline__
typedef unsigned short bf16;
typedef unsigned v4u __attribute__((ext_vector_type(4)));
typedef unsigned v2u __attribute__((ext_vector_type(2)));
typedef float f32x4 __attribute__((ext_vector_type(4)));
typedef float f32x16 __attribute__((ext_vector_type(16)));
typedef short bf16x8 __attribute__((ext_vector_type(8)));
typedef short s16x4 __attribute__((ext_vector_type(4)));
typedef GAS unsigned gu32;
#define RLX_AGENT __ATOMIC_RELAXED, __HIP_MEMORY_SCOPE_AGENT
#define LDS_WAIT() asm volatile("s_waitcnt lgkmcnt(0)" ::: "memory")
#define VM_WAIT() asm volatile("s_waitcnt vmcnt(0)" ::: "memory")
DI float bf_lo(unsigned u) { return __uint_as_float(u << 16); }
DI float bf_hi(unsigned u) { return __uint_as_float(u & 0xffff0000u); }
DI unsigned pk2(float lo, float hi) { return pg8::cvt_pk_bf16(lo, hi); }
constexpr float F8_WSCALE = 64.0f, F8_WINV = 1.0f / 64.0f;
DI float clamp448(float x) { return __builtin_amdgcn_fmed3f(x, -448.0f, 448.0f); }
DI unsigned pk4_fp8(float a, float b, float c, float d) { int p = __builtin_amdgcn_cvt_pk_fp8_f32(clamp448(a), clamp448(b), 0, false); p = __builtin_amdgcn_cvt_pk_fp8_f32(clamp448(c), clamp448(d), p, true); return (unsigned)p; }
DI float wave_sum(float v) {
#pragma unroll
    for (int o = 1; o < 64; o <<= 1) v += __shfl_xor(v, o);
    return v;
}
DI int wave_sum_i(int v) {
#pragma unroll
    for (int o = 1; o < 64; o <<= 1) v += __shfl_xor(v, o);
    return v;
}
DI float fast_rcp(float x) { return __builtin_amdgcn_rcpf(x); }
DI float fast_exp2(float x) { return __builtin_amdgcn_exp2f(x); }
DI float sigmoidf_(float z) { return fast_rcp(1.0f + fast_exp2(-z * LOG2E)); }
DI float gelu_tanh(float x) { const float z = 1.5957691216057308f * (x + 0.044715f * x * x * x); return x * sigmoidf_(z); }
DI float siluf_(float x) { return x * sigmoidf_(x); }

#define XB_TMO      128
#define XB_XCNT(j)  (256  + 64 * (j))
#define XB_XSUB(j)  (1280 + 64 * (j))
#define XB_XGEN(j)  (2304 + 64 * (j))
#define XB_TOP      3328
#define XB_TOPGEN   3392
#define XCD_BAR_WORDS 3456
#define XB_SPIN_CAP (1u << 18)

__device__ __forceinline__ unsigned xb_ld(unsigned* p)              { return __hip_atomic_load(p, __ATOMIC_RELAXED, __HIP_MEMORY_SCOPE_AGENT); }
__device__ __forceinline__ unsigned xb_add(unsigned* p, unsigned v) { return __hip_atomic_fetch_add(p, v, __ATOMIC_RELAXED, __HIP_MEMORY_SCOPE_AGENT); }
__device__ __forceinline__ unsigned xb_xcc_id() { return (unsigned)__builtin_amdgcn_s_getreg((3 << 11) | 20) & 0xFu; }
#define XB_SPIN(cond, bar) do { unsigned _sp = 0; while (cond) { __builtin_amdgcn_s_sleep(1); \
    if ((++_sp & 255u) == 0u) { if (xb_ld(&(bar)[XB_TMO])) break; if (_sp > XB_SPIN_CAP) { atomicAdd(&(bar)[XB_TMO], 1u); break; } } } } while (0)

struct XcdBarrier {
    unsigned* bar; unsigned x;
    volatile LAS unsigned* st;
};
__device__ __forceinline__ XcdBarrier xcd_barrier_post(unsigned* bar, volatile LAS unsigned* st) {
    XcdBarrier b; b.bar = bar; b.x = xb_xcc_id(); b.st = st;
    if (threadIdx.x == 0) (void)xb_add(&bar[XB_XCNT(b.x)], 1u);
    return b;
}
__device__ __forceinline__ void xcd_barrier_complete(unsigned* bar, unsigned x, unsigned& nloc, unsigned& nx) {
    const unsigned G = gridDim.x * gridDim.y * gridDim.z;
    unsigned sum, cnt, mine, sp = 0u;
    for (;;) {
        sum = 0u; cnt = 0u; mine = 0u;
#pragma unroll
        for (unsigned j = 0; j < 16; ++j) { const unsigned c = xb_ld(&bar[XB_XCNT(j)]); sum += c; cnt += (c > 0u) ? 1u : 0u; mine = (j == x) ? c : mine; }
        if (sum == G) break;
        __builtin_amdgcn_s_sleep(1);
        if ((++sp & 255u) == 0u) { if (xb_ld(&bar[XB_TMO])) break; if (sp > XB_SPIN_CAP) { atomicAdd(&bar[XB_TMO], 1u); break; } }
    }
    nloc = mine > 0u ? mine : 1u; nx = cnt > 0u ? cnt : 1u;
}
__device__ __forceinline__ void xcd_barrier(const XcdBarrier& b) {
    asm volatile("s_waitcnt vmcnt(0)" ::: "memory");
    __syncthreads();
    if (threadIdx.x == 0) {
        unsigned* bar = b.bar;
        __builtin_amdgcn_s_waitcnt(0);
        unsigned nloc = b.st[0], nx = b.st[1];
        if (nloc == 0u) { xcd_barrier_complete(bar, b.x, nloc, nx); b.st[0] = nloc; b.st[1] = nx; }
        const unsigned old = xb_add(&bar[XB_XSUB(b.x)], 1u);
        const unsigned gen = old / nloc;
        if (old + 1u == (gen + 1u) * nloc) {
            __builtin_amdgcn_fence(__ATOMIC_RELEASE, "agent");
            asm volatile("s_waitcnt vmcnt(0)" ::: "memory");
            const unsigned og = xb_add(&bar[XB_TOP], 1u);
            const unsigned tg = og / nx;
            if (og + 1u == (tg + 1u) * nx) xb_add(&bar[XB_TOPGEN], 1u);
            else XB_SPIN(xb_ld(&bar[XB_TOPGEN]) == tg, bar);
            __builtin_amdgcn_fence(__ATOMIC_ACQUIRE, "agent");
            xb_add(&bar[XB_XGEN(b.x)], 1u);
            asm volatile("s_waitcnt vmcnt(0)" ::: "memory");
        } else {
            XB_SPIN(xb_ld(&bar[XB_XGEN(b.x)]) == gen, bar);
            __builtin_amdgcn_fence(__ATOMIC_ACQUIRE, "agent");
            asm volatile("s_waitcnt vmcnt(0)" ::: "memory");
        }
    }
    __syncthreads();
}

using pg8::Unit; using pg8::BM; using pg8::HALF;
struct EpiIn0 {
    static constexpr int PERM = 2;
    bf16* O; int tbase; float sc; const float* gk; LAS float* part;
    DI void operator()(const f32x4 (&acc)[2][2][4][2], const Unit& u, int wr, int wc, int fr, int fq) const {
        const int row0 = u.pm * BM + wr * 64 + fr; const int t = tbase + (u.pn >> 2); const int colt = (u.pn & 3) * BM;
        bf16* base = O + (size_t)t * R2_T; const int col0 = colt + wc * 64 + 8 * fq; const bool act = t < 2;
        if (t == 3) {
            float ssv[2][4];
#pragma unroll
            for (int ai = 0; ai < 2; ++ai)
#pragma unroll
                for (int m = 0; m < 4; ++m) { float q = 0.f;
#pragma unroll
                    for (int bj = 0; bj < 2; ++bj)
#pragma unroll
                        for (int n = 0; n < 2; ++n) { const f32x4 v = acc[ai][bj][m][n] * sc; q += (v[0] * v[0] + v[1] * v[1]) + (v[2] * v[2] + v[3] * v[3]); }
                    q += __shfl_xor(q, 16); q += __shfl_xor(q, 32); ssv[ai][m] = q;
                    if (fq == 0) part[(ai * HALF + wr * 64 + m * 16 + fr) * 4 + wc] = q; }
            asm volatile("s_waitcnt lgkmcnt(0)" ::: "memory"); __builtin_amdgcn_s_barrier(); asm volatile("" ::: "memory");
            f32x4 gv[2][2];
#pragma unroll
            for (int bj = 0; bj < 2; ++bj)
#pragma unroll
                for (int n = 0; n < 2; ++n) gv[bj][n] = *(const f32x4*)(gk + 64 * (wc & 1) + 32 * bj + 8 * fq + 4 * n);
#pragma unroll
            for (int ai = 0; ai < 2; ++ai)
#pragma unroll
                for (int m = 0; m < 4; ++m) { const float tot = ssv[ai][m] + part[(ai * HALF + wr * 64 + m * 16 + fr) * 4 + (wc ^ 1)];
                    const float rstd = 1.0f / sqrtf(tot * (1.0f / 128.0f) + EPS);
                    bf16* rowp = base + (size_t)(row0 + ai * HALF + m * 16) * 1024 + col0;
#pragma unroll
                    for (int bj = 0; bj < 2; ++bj) { const f32x4 v0 = acc[ai][bj][m][0] * (sc * rstd) * gv[bj][0], v1 = acc[ai][bj][m][1] * (sc * rstd) * gv[bj][1];
                        v4u w; w.x = pk2(v0[0], v0[1]); w.y = pk2(v0[2], v0[3]); w.z = pk2(v1[0], v1[1]); w.w = pk2(v1[2], v1[3]);
                        *(v4u*)(rowp + bj * 32) = w; } }
            return;
        }
#pragma unroll
        for (int ai = 0; ai < 2; ++ai)
#pragma unroll
            for (int m = 0; m < 4; ++m) { bf16* rowp = base + (size_t)(row0 + ai * HALF + m * 16) * 1024 + col0;
#pragma unroll
                for (int bj = 0; bj < 2; ++bj) { f32x4 v0 = acc[ai][bj][m][0] * sc, v1 = acc[ai][bj][m][1] * sc;
                    if (act) {
#pragma unroll
                        for (int j = 0; j < 4; ++j) { v0[j] = gelu_tanh(v0[j]); v1[j] = gelu_tanh(v1[j]); } }
                    v4u w; w.x = pk2(v0[0], v0[1]); w.y = pk2(v0[2], v0[3]); w.z = pk2(v1[0], v1[1]); w.w = pk2(v1[2], v1[3]);
                    *(v4u*)(rowp + bj * 32) = w; } }
    }
};
struct OneUnit {
    int pm, pn;
    __device__ __forceinline__ bool next(int i, Unit& u) const { if (i != 0) return false; u.pm = pm; u.pn = pn; u.pb = pn; return true; }
    DI void a_ready(const Unit&) const {}
    DI void done(const Unit&) const {}
};
template <bool BASE_F32>
struct EpiResid {
    static constexpr int PERM = 2;
    const void* base; bf16* out; const float* gate0;
    DI void operator()(const f32x4 (&acc)[2][2][4][2], const Unit& u, int wr, int wc, int fr, int fq) const {
        const int row0 = u.pm * BM + wr * 64 + fr, col0 = u.pn * BM + wc * 64 + 8 * fq;
        const float* gate = gate0 + (size_t)((u.pm * BM) >> 14) * 12288;
        f32x4 gv[2][2];
#pragma unroll
        for (int bj = 0; bj < 2; ++bj)
#pragma unroll
            for (int n = 0; n < 2; ++n) gv[bj][n] = *(const f32x4*)(gate + col0 + bj * 32 + n * 4);
#pragma unroll
        for (int ai = 0; ai < 2; ++ai)
#pragma unroll
            for (int m = 0; m < 4; ++m) { const size_t off = (size_t)(row0 + ai * HALF + m * 16) * D + col0;
#pragma unroll
                for (int bj = 0; bj < 2; ++bj) { f32x4 b0, b1;
                    if constexpr (BASE_F32) { b0 = __builtin_nontemporal_load((const f32x4*)((const float*)base + off + bj * 32)); b1 = __builtin_nontemporal_load((const f32x4*)((const float*)base + off + bj * 32 + 4)); }
                    else { const v4u w = *(const v4u*)((const bf16*)base + off + bj * 32); b0 = (f32x4){bf_lo(w.x), bf_hi(w.x), bf_lo(w.y), bf_hi(w.y)}; b1 = (f32x4){bf_lo(w.z), bf_hi(w.z), bf_lo(w.w), bf_hi(w.w)}; }
                    const f32x4 v0 = b0 + gv[bj][0] * acc[ai][bj][m][0], v1 = b1 + gv[bj][1] * acc[ai][bj][m][1];
                    v4u o; o.x = pk2(v0[0], v0[1]); o.y = pk2(v0[2], v0[3]); o.z = pk2(v1[0], v1[1]); o.w = pk2(v1[2], v1[3]);
                    *(v4u*)(out + off + bj * 32) = o; } }
    }
};
template <bool F8>
struct EpiSwiglu {
    static constexpr int PERM = 1;
    void* O;
    DI void operator()(const f32x4 (&acc)[2][2][4][2], const Unit& u, int wr, int wc, int fr, int fq) const {
        const int row0 = u.pm * BM + wr * 64 + fr, col0 = u.pn * HALF + wc * 32 + 8 * fq;
        const float sc = F8 ? F8_WINV : 1.0f;
        if constexpr (F8) {
            const int colw = u.pn * HALF + wc * 32 + 8 * (fq & ~1);
#pragma unroll
            for (int ai = 0; ai < 2; ++ai)
#pragma unroll
                for (int mp = 0; mp < 2; ++mp) { v2u w[2];
#pragma unroll
                    for (int x = 0; x < 2; ++x) { const int m = 2 * mp + x;
                        f32x4 g0 = acc[ai][0][m][0] * sc, g1 = acc[ai][0][m][1] * sc; const f32x4 u0 = acc[ai][1][m][0] * sc, u1 = acc[ai][1][m][1] * sc;
#pragma unroll
                        for (int j = 0; j < 4; ++j) { g0[j] = siluf_(g0[j]) * u0[j]; g1[j] = siluf_(g1[j]) * u1[j]; }
                        w[x].x = pk4_fp8(g0[0], g0[1], g0[2], g0[3]); w[x].y = pk4_fp8(g1[0], g1[1], g1[2], g1[3]); }
                    const auto rx = __builtin_amdgcn_permlane16_swap(w[0].x, w[1].x, false, false); const auto ry = __builtin_amdgcn_permlane16_swap(w[0].y, w[1].y, false, false);
                    v4u o; o.x = rx[0]; o.y = ry[0]; o.z = rx[1]; o.w = ry[1];
                    *(v4u*)((unsigned char*)O + (size_t)(row0 + ai * HALF + (2 * mp + (fq & 1)) * 16) * FF + colw) = o; }
            return;
        }
#pragma unroll
        for (int ai = 0; ai < 2; ++ai)
#pragma unroll
            for (int m = 0; m < 4; ++m) { const size_t eo = (size_t)(row0 + ai * HALF + m * 16) * FF + col0;
                f32x4 g0 = acc[ai][0][m][0] * sc, g1 = acc[ai][0][m][1] * sc; const f32x4 u0 = acc[ai][1][m][0] * sc, u1 = acc[ai][1][m][1] * sc;
#pragma unroll
                for (int j = 0; j < 4; ++j) { g0[j] = siluf_(g0[j]) * u0[j]; g1[j] = siluf_(g1[j]) * u1[j]; }
                { v4u w; w.x = pk2(g0[0], g0[1]); w.y = pk2(g0[2], g0[3]); w.z = pk2(g1[0], g1[1]); w.w = pk2(g1[2], g1[3]); *(v4u*)((bf16*)O + eo) = w; } }
    }
};
struct EpiPlain {
    static constexpr int PERM = 2;
    unsigned char* O; int ldc; float sc; int nostore;
    DI void operator()(const f32x4 (&acc)[2][2][4][2], const Unit& u, int wr, int wc, int fr, int fq) const {
        if (nostore == 1) return;
        const int row0 = u.pm * BM + wr * 64 + fr, col0 = u.pn * BM + wc * 64 + ((fq & 1) ? 24 + 8 * fq : 8 * fq);
#pragma unroll
        for (int ai = 0; ai < 2; ++ai)
#pragma unroll
            for (int m = 0; m < 4; ++m) { unsigned char* rowp = O + (size_t)(row0 + ai * HALF + m * 16) * ldc + col0;
                v2u w[2];
#pragma unroll
                for (int bj = 0; bj < 2; ++bj) { const f32x4 v0 = acc[ai][bj][m][0] * sc, v1 = acc[ai][bj][m][1] * sc;
                    w[bj].x = pk4_fp8(v0[0], v0[1], v0[2], v0[3]); w[bj].y = pk4_fp8(v1[0], v1[1], v1[2], v1[3]); }
                const auto rx = __builtin_amdgcn_permlane16_swap(w[0].x, w[1].x, false, false); const auto ry = __builtin_amdgcn_permlane16_swap(w[0].y, w[1].y, false, false);
                v4u o; o.x = rx[0]; o.y = ry[0]; o.z = rx[1]; o.w = ry[1];
                __builtin_nontemporal_store(o, (v4u*)rowp); }
    }
};
struct EpiCin {
    static constexpr int PERM = 1;
    bf16* BG; bf16* CZ; int nostore;
    DI void operator()(const f32x4 (&acc)[2][2][4][2], const Unit& u, int wr, int wc, int fr, int fq) const {
        if (nostore) return;
        const int row0 = u.pm * BM + wr * 64 + fr;
        if (u.pn < 8) {
            const int col0 = u.pn * BM + wc * 32 + 8 * fq;
#pragma unroll
            for (int ai = 0; ai < 2; ++ai)
#pragma unroll
                for (int m = 0; m < 4; ++m) { bf16* rowp = BG + (size_t)(row0 + ai * HALF + m * 16) * D + col0;
#pragma unroll
                    for (int bj = 0; bj < 2; ++bj) { const f32x4 v0 = acc[ai][bj][m][0], v1 = acc[ai][bj][m][1];
                        v4u w; w.x = pk2(v0[0], v0[1]); w.y = pk2(v0[2], v0[3]); w.z = pk2(v1[0], v1[1]); w.w = pk2(v1[2], v1[3]);
                        *(v4u*)(rowp + bj * HALF) = w; } }
        } else {
            const int col0 = (u.pn - 8) * HALF + wc * 32 + 8 * fq;
#pragma unroll
            for (int ai = 0; ai < 2; ++ai)
#pragma unroll
                for (int m = 0; m < 4; ++m) { bf16* rowp = CZ + (size_t)(row0 + ai * HALF + m * 16) * D + col0;
                    const f32x4 p0 = acc[ai][0][m][0] * acc[ai][1][m][0], p1 = acc[ai][0][m][1] * acc[ai][1][m][1];
                    v4u w; w.x = pk2(p0[0], p0[1]); w.y = pk2(p0[2], p0[3]); w.z = pk2(p1[0], p1[1]); w.w = pk2(p1[2], p1[3]);
                    *(v4u*)rowp = w; }
        }
    }
};

DI unsigned off_b(unsigned row, unsigned ch) { return 256u * row + 16u * (ch ^ (((row & 3) << 2) | ((row >> 2) & 3))); }
DI bf16x8 row_frag(const LAS unsigned char* img, int lane, int s) { return *(const LAS bf16x8*)(img + off_b(lane & 31, 2 * s + (lane >> 5))); }
template <bool KROW>
DI bf16x8 tr_frag(const LAS unsigned char* img, int lane, int c, int ks) {
    const unsigned h = lane >> 5, blk = (lane >> 4) & 1, q = (lane & 15) >> 2, p = lane & 3;
    const unsigned r0 = KROW ? (16 * ks + 4 * h + q) : (16 * ks + 8 * h + q), r1 = KROW ? (r0 + 8) : (r0 + 4);
    const unsigned ch = 4 * c + 2 * blk + (p >> 1), sub = 8 * (p & 1);
    const s16x4 lo = __builtin_amdgcn_ds_read_tr16_b64_v4i16((LAS s16x4*)(img + off_b(r0, ch) + sub));
    const s16x4 hi = __builtin_amdgcn_ds_read_tr16_b64_v4i16((LAS s16x4*)(img + off_b(r1, ch) + sub));
    return __builtin_shufflevector(lo, hi, 0, 1, 2, 3, 4, 5, 6, 7);
}
DI void tr_frag4_krow(bf16x8 (&a)[4], const LAS unsigned char* img, int lane, int ks) {
    const unsigned h = lane >> 5, blk = (lane >> 4) & 1, q = (lane & 15) >> 2, p = lane & 3;
    const unsigned r0 = 16 * ks + 4 * h + q, r1 = r0 + 8, sub = 8 * (p & 1);
    const unsigned base = (unsigned)(unsigned long)img;
    unsigned al[4], ah[4];
#pragma unroll
    for (int c = 0; c < 4; ++c) { const unsigned ch = 4 * c + 2 * blk + (p >> 1); al[c] = base + off_b(r0, ch) + sub; ah[c] = base + off_b(r1, ch) + sub; }
    s16x4 l0, l1, l2, l3, h0, h1, h2, h3;
    asm volatile("ds_read_b64_tr_b16 %0, %8\n\tds_read_b64_tr_b16 %1, %9\n\tds_read_b64_tr_b16 %2, %10\n\tds_read_b64_tr_b16 %3, %11\n\t"
                 "ds_read_b64_tr_b16 %4, %12\n\tds_read_b64_tr_b16 %5, %13\n\tds_read_b64_tr_b16 %6, %14\n\tds_read_b64_tr_b16 %7, %15\n\ts_waitcnt lgkmcnt(0)"
                 : "=&v"(l0), "=&v"(l1), "=&v"(l2), "=&v"(l3), "=&v"(h0), "=&v"(h1), "=&v"(h2), "=&v"(h3)
                 : "v"(al[0]), "v"(al[1]), "v"(al[2]), "v"(al[3]), "v"(ah[0]), "v"(ah[1]), "v"(ah[2]), "v"(ah[3]) : "memory");
    a[0] = __builtin_shufflevector(l0, h0, 0, 1, 2, 3, 4, 5, 6, 7); a[1] = __builtin_shufflevector(l1, h1, 0, 1, 2, 3, 4, 5, 6, 7);
    a[2] = __builtin_shufflevector(l2, h2, 0, 1, 2, 3, 4, 5, 6, 7); a[3] = __builtin_shufflevector(l3, h3, 0, 1, 2, 3, 4, 5, 6, 7);
}
template <int OFF>
DI void tr_frag4_pre(bf16x8 (&a)[4], const unsigned (&al)[4], const unsigned (&ah)[4]) {
    s16x4 l0, l1, l2, l3, h0, h1, h2, h3;
    asm volatile("ds_read_b64_tr_b16 %0, %8 offset:%16\n\tds_read_b64_tr_b16 %1, %9 offset:%16\n\tds_read_b64_tr_b16 %2, %10 offset:%16\n\tds_read_b64_tr_b16 %3, %11 offset:%16\n\t"
                 "ds_read_b64_tr_b16 %4, %12 offset:%16\n\tds_read_b64_tr_b16 %5, %13 offset:%16\n\tds_read_b64_tr_b16 %6, %14 offset:%16\n\tds_read_b64_tr_b16 %7, %15 offset:%16\n\ts_waitcnt lgkmcnt(0)"
                 : "=&v"(l0), "=&v"(l1), "=&v"(l2), "=&v"(l3), "=&v"(h0), "=&v"(h1), "=&v"(h2), "=&v"(h3)
                 : "v"(al[0]), "v"(al[1]), "v"(al[2]), "v"(al[3]), "v"(ah[0]), "v"(ah[1]), "v"(ah[2]), "v"(ah[3]), "n"(OFF) : "memory");
    a[0] = __builtin_shufflevector(l0, h0, 0, 1, 2, 3, 4, 5, 6, 7); a[1] = __builtin_shufflevector(l1, h1, 0, 1, 2, 3, 4, 5, 6, 7);
    a[2] = __builtin_shufflevector(l2, h2, 0, 1, 2, 3, 4, 5, 6, 7); a[3] = __builtin_shufflevector(l3, h3, 0, 1, 2, 3, 4, 5, 6, 7);
}
DI int crow(int reg, int h) { return (reg & 3) + 8 * (reg >> 2) + 4 * h; }
#define MFMA32(a, b, c) __builtin_amdgcn_mfma_f32_32x32x16_bf16((a), (b), (c), 0, 0, 0)

struct Params { const float* in[23]; float* out; unsigned char* ws; int ph_lo, ph_hi, li, pad; };
typedef const __attribute__((address_space(4))) Params* KP;
DI KP kparams() { KP p = (KP)__builtin_amdgcn_kernarg_segment_ptr(); asm volatile("" : "+s"(p)); return p; }
enum { I_X = 0, I_C, I_CTX, I_CCTX, I_ADAW, I_ADAB, I_N1G, I_N2G, I_ABWIN, I_ABWOUT, I_AWS, I_ABS, I_AVG, I_BQG, I_BKG, I_RPB, I_CWIN, I_CONVW, I_CWOUT, I_ROUTER, I_WGATE, I_WUP, I_WDOWN };

struct XItem { const float* src; unsigned char* dst; int N, Kd, k0, dstrow0, f8; };
DI void xpose_load(const XItem& d, f32x4 (&v)[16], int lane) {
    const GAS f32x4* src = (const GAS f32x4*)d.src; const int lr = lane >> 4, lc = lane & 15;
#pragma unroll
    for (int i = 0; i < 16; ++i) v[i] = __builtin_nontemporal_load(src + (size_t)(lr + 4 * i) * (d.N / 4) + lc);
}
DI void xpose_store(const XItem& d, const f32x4 (&v)[16], LAS float* scr, int lane) {
    const int lr = lane >> 4, lc = lane & 15;
#pragma unroll
    for (int i = 0; i < 16; ++i) { LAS float* p = scr + (lr + 4 * i) * 65 + 4 * lc; p[0] = v[i].x; p[1] = v[i].y; p[2] = v[i].z; p[3] = v[i].w; }
    LDS_WAIT(); asm volatile("" ::: "memory");
    if (d.f8) {
        const int c = lane & 3;
#pragma unroll
        for (int i = 0; i < 4; ++i) { const int n = 16 * i + (lane >> 2); const LAS float* s = scr + (16 * c) * 65 + n;
            v4u o;
            o.x = pk4_fp8(s[0 * 65] * F8_WSCALE, s[1 * 65] * F8_WSCALE, s[2 * 65] * F8_WSCALE, s[3 * 65] * F8_WSCALE); o.y = pk4_fp8(s[4 * 65] * F8_WSCALE, s[5 * 65] * F8_WSCALE, s[6 * 65] * F8_WSCALE, s[7 * 65] * F8_WSCALE);
            o.z = pk4_fp8(s[8 * 65] * F8_WSCALE, s[9 * 65] * F8_WSCALE, s[10 * 65] * F8_WSCALE, s[11 * 65] * F8_WSCALE); o.w = pk4_fp8(s[12 * 65] * F8_WSCALE, s[13 * 65] * F8_WSCALE, s[14 * 65] * F8_WSCALE, s[15 * 65] * F8_WSCALE);
            *(GAS v4u*)(d.dst + (size_t)(d.dstrow0 + n) * d.Kd + d.k0 + 16 * c) = o; }
    } else {
        const int c = lane & 7;
#pragma unroll
        for (int i = 0; i < 8; ++i) { const int n = 8 * i + (lane >> 3); const LAS float* s = scr + (8 * c) * 65 + n;
            v4u o; o.x = pk2(s[0 * 65], s[1 * 65]); o.y = pk2(s[2 * 65], s[3 * 65]); o.z = pk2(s[4 * 65], s[5 * 65]); o.w = pk2(s[6 * 65], s[7 * 65]);
            *(GAS v4u*)((bf16*)d.dst + (size_t)(d.dstrow0 + n) * d.Kd + d.k0 + 8 * c) = o; }
    }
    LDS_WAIT(); asm volatile("" ::: "memory");
}
DI int ilv_row(int j, int hv) { return ((j >> 7) << 8) + hv * 128 + (j & 127); }

#define F8L(l) ((l) == 0 ? (MK_FP8_L0 != 0) : (MK_FP8_L1 != 0))
DI void xpose_range(KP P, LAS unsigned char* lds, int lane, int wave, int mode, int w, int nw) {
    unsigned char* ws = P->ws;
    LAS float* scr = (LAS float*)(lds + LDS_SCR + wave * 16640);
    constexpr int I0 = 32 * 80, I1 = 32 * 32, I2 = 32 * 96, I3 = 32 * 32, IM = 512, I4 = 32 * IM, IB = I0 + I1 + I2 + I3, IH = I4 / 2;
    const int nlist = mode == 0 ? IB : ((mode == 4 || mode == 3) ? 3 * IH : (3 * IH) / 2);
    auto item_id = [&](int j) -> int {
        if (mode == 0) return j;
        if (mode == 4) return IB + (j / IH) * I4 + (j % IH);
        if (mode == 3) return IB + (j / IH) * I4 + IH + (j % IH);
        const int q = j + (mode == 2 ? (3 * IH) / 2 : 0); return IB + (q / IH) * I4 + IH + (q % IH);
    };
    auto decode = [&](int it, XItem& d) {
        int r = it;
        if (r < I0) { const int kb = r / 80, nb = r % 80; const bool f8 = nb >= 32;
            d = XItem{P->in[I_ABWIN] + (size_t)(kb * 64) * 5120 + nb * 64, f8 ? ws + WS_WIN0F8 : ws + WS_WIN0, 5120, 2048, kb * 64, f8 ? nb * 64 - 2048 : nb * 64, f8 ? 1 : 0}; return; } r -= I0;
        if (r < I1) { const int kb = r / 32, nb = r % 32; d = XItem{P->in[I_ABWOUT] + (size_t)(kb * 64) * 2048 + nb * 64, ws + WS_WOUT0, 2048, 2048, kb * 64, nb * 64, 0}; return; } r -= I1;
        if (r < I2) { const int kb = r / 96, nb = r % 96; const int n0 = nb * 64;
            const int drow = n0 < 2048 ? n0 : (n0 < 4096 ? 2048 + ilv_row(n0 - 2048, 0) : 2048 + ilv_row(n0 - 4096, 1));
            d = XItem{P->in[I_CWIN] + (size_t)(kb * 64) * 6144 + n0, ws + WS_WCIN, 6144, 2048, kb * 64, drow, 0}; return; } r -= I2;
        if (r < I3) { const int kb = r / 32, nb = r % 32; d = XItem{P->in[I_CWOUT] + (size_t)(kb * 64) * 2048 + nb * 64, ws + WS_WCOUT, 2048, 2048, kb * 64, nb * 64, 0}; return; } r -= I3;
        if (r < 2 * I4) { const bool up = r >= I4; if (up) r -= I4; const int mt = r / IM, q = r % IM, kb = q / 16, nb = q % 16;
            d = XItem{(up ? P->in[I_WUP] : P->in[I_WGATE]) + (size_t)mt * 2048 * 1024 + (size_t)(kb * 64) * 1024 + nb * 64,
                      ws + WS_GU + (size_t)(mt >> 4) * 16 * 2048 * 2048 * 2 + (size_t)(mt & 15) * 2048 * 2048, 1024, 2048, kb * 64, ilv_row(nb * 64, up ? 1 : 0), 1}; return; } r -= 2 * I4;
        { const int mt = r / IM, q = r % IM, kb = q / 32, nb = q % 32;
            d = XItem{P->in[I_WDOWN] + (size_t)mt * 1024 * 2048 + (size_t)(kb * 64) * 2048 + nb * 64,
                      ws + WS_DN + (size_t)(mt >> 4) * 16 * 2048 * 1024 * 2 + (size_t)(mt & 15) * 2048 * 1024, 2048, 1024, kb * 64, nb * 64, 1}; }
    };
    f32x4 va[16], vb[16]; XItem da, db;
    int it = w;
    if (it < nlist) { decode(item_id(it), da); xpose_load(da, va, lane); }
    while (it < nlist) {
        const int it1 = it + nw; if (it1 < nlist) { decode(item_id(it1), db); xpose_load(db, vb, lane); }
        xpose_store(da, va, scr, lane);
        if (it1 >= nlist) break;
        const int it2 = it1 + nw; if (it2 < nlist) { decode(item_id(it2), da); xpose_load(da, va, lane); }
        xpose_store(db, vb, scr, lane);
        it = it2;
    }
}

DI void phase_prologue(KP P, LAS unsigned char* lds, int tid, int lane, int wave) {
    unsigned char* ws = P->ws;
    for (int u = blockIdx.x; u < 192; u += gridDim.x) {
        const int l = u / 96, cb = u % 96;
        LAS float* sv = (LAS float*)(lds + LDS_SCR);
        LAS float* part = (LAS float*)(lds + LDS_SCR + 24576);
        for (int i = tid; i < 3 * 2048; i += 512) { const int r = i >> 11, k = i & 2047; const float c = r < 2 ? P->in[I_C][r * 2048 + k] : P->in[I_CCTX][k]; sv[i] = c / (1.0f + __expf(-c)); }
        __syncthreads();
        const int col4 = tid & 31, ks = tid >> 5;
        const GAS f32x4* w = (const GAS f32x4*)(P->in[I_ADAW] + (size_t)l * 2048 * 12288 + (size_t)(ks * 128) * 12288 + cb * 128) + col4;
        f32x4 a0 = {0.f, 0.f, 0.f, 0.f}, a1 = a0, a2 = a0;
#pragma unroll 8
        for (int k = 0; k < 128; ++k) { const f32x4 wv = __builtin_nontemporal_load(w + (size_t)k * (12288 / 4)); const int kk = ks * 128 + k;
            a0 += wv * sv[kk]; a1 += wv * sv[2048 + kk]; a2 += wv * sv[4096 + kk]; }
        *(LAS f32x4*)(part + (ks * 3 + 0) * 128 + 4 * col4) = a0; *(LAS f32x4*)(part + (ks * 3 + 1) * 128 + 4 * col4) = a1; *(LAS f32x4*)(part + (ks * 3 + 2) * 128 + 4 * col4) = a2;
        __syncthreads();
        if (tid < 384) { const int r = tid >> 7, cc = tid & 127; float s = P->in[I_ADAB][l * 12288 + cb * 128 + cc];
#pragma unroll
            for (int q = 0; q < 16; ++q) s += part[(q * 3 + r) * 128 + cc];
            ((float*)(ws + WS_MOD))[(size_t)(l * 3 + r) * 12288 + cb * 128 + cc] = s; }
        __syncthreads();
    }
    { const float* src = P->in[I_AWS]; bf16* dst = (bf16*)(ws + WS_WSB);
      for (int i = blockIdx.x * 512 + tid; i < 8 * 128 * 128 / 2; i += gridDim.x * 512) { const float a = src[2 * i], b = src[2 * i + 1]; ((unsigned*)dst)[i] = pk2(a, b); } }
    xpose_range(P, lds, lane, wave, 0, blockIdx.x * NWAVES + wave, gridDim.x * NWAVES);
}


DI void norm_mod_row(f32x4 (&v)[8], const float* __restrict__ g, const float* __restrict__ shift, const float* __restrict__ scale, int lane) {
    float ss = 0.f;
#pragma unroll
    for (int j = 0; j < 8; ++j) ss += (v[j].x * v[j].x + v[j].y * v[j].y) + (v[j].z * v[j].z + v[j].w * v[j].w);
    const float rstd = 1.0f / sqrtf(wave_sum(ss) * (1.0f / D) + EPS);
#pragma unroll
    for (int j = 0; j < 8; ++j) { const int c = 256 * j + 4 * lane; const f32x4 gg = *(const f32x4*)(g + c), sc = *(const f32x4*)(scale + c), sh = *(const f32x4*)(shift + c);
        v[j] = (v[j] * rstd * gg) * (1.0f + sc) + sh; }
}
DI void store_row_bf16(bf16* __restrict__ orow, const f32x4 (&v)[8], int lane) {
    GAS v2u* o = (GAS v2u*)orow + lane;
#pragma unroll
    for (int j = 0; j < 8; ++j) { v2u w; w.x = pk2(v[j].x, v[j].y); w.y = pk2(v[j].z, v[j].w); o[64 * j] = w; }
}
DI void store_row_fp8(unsigned char* __restrict__ orow, const f32x4 (&v)[8], int lane) {
    GAS unsigned* o = (GAS unsigned*)orow + lane;
#pragma unroll
    for (int j = 0; j < 8; ++j) o[64 * j] = pk4_fp8(v[j].x, v[j].y, v[j].z, v[j].w);
}
DI void load_row_bf16(f32x4 (&v)[8], const bf16* __restrict__ xrow, int lane) {
    const GAS v2u* xr = (const GAS v2u*)xrow + lane;
#pragma unroll
    for (int j = 0; j < 8; ++j) { const v2u w = xr[64 * j]; v[j] = (f32x4){bf_lo(w.x), bf_hi(w.x), bf_lo(w.y), bf_hi(w.y)}; }
}
DI void load_row_f32(f32x4 (&v)[8], const float* __restrict__ xrow, int lane) {
    const GAS f32x4* xr = (const GAS f32x4*)xrow + lane;
#pragma unroll
    for (int j = 0; j < 8; ++j) v[j] = __builtin_nontemporal_load(xr + 64 * j);
}

DI void phase_norm1_l0(KP P, LAS unsigned char* lds, int tid, int lane, int wave) {
    const float* mod = (const float*)(P->ws + WS_MOD); bf16* H = (bf16*)(P->ws + WS_H); unsigned char* H8 = P->ws + WS_H8;
    const bool ctxwg = (gridDim.x >= 64) && (blockIdx.x < 16);
    if (ctxwg) {
        const int pmc = blockIdx.x >> 3, pnc = blockIdx.x & 7;
        const float* m = mod + (size_t)2 * 12288;
        for (int rr = 2 * wave; rr < 256; rr += 2 * NWAVES) {
            f32x4 v[2][8];
#pragma unroll
            for (int q = 0; q < 2; ++q) load_row_f32(v[q], P->in[I_CTX] + (size_t)(pmc * 256 + rr + q) * D, lane);
#pragma unroll
            for (int q = 0; q < 2; ++q) { norm_mod_row(v[q], P->in[I_N1G], m + 0 * 2048, m + 1 * 2048, lane); store_row_fp8(H8 + (size_t)(NT + pmc * 256 + rr + q) * D, v[q], lane); } }
        VM_WAIT(); __syncthreads();
        __builtin_amdgcn_fence(__ATOMIC_ACQUIRE, "agent"); VM_WAIT(); __syncthreads();
        pg8::Gemm g{(const bf16*)H8, (const bf16*)(P->ws + WS_WIN0F8), MTOT, 3072, D / 2}; OneUnit S{128 + pmc, 4 + pnc};
        EpiIn0 E{(bf16*)(P->ws + WS_R2), 2, F8_WINV, P->in[I_BKG], (LAS float*)(lds + LDS_KPART)};
        pg8::gemm_phase<EpiIn0, OneUnit, true, true, true>(lds, g, S, E);
        return;
    }
    const int nskip = (gridDim.x >= 64) ? 16 : 0;
    const int gw = (blockIdx.x - nskip) * NWAVES + wave, NGW = (gridDim.x - nskip) * NWAVES;
    const int nrows = (gridDim.x >= 64) ? NT : MTOT;
    for (int row0 = 2 * gw; row0 < nrows; row0 += 2 * NGW) {
        f32x4 v[2][8];
#pragma unroll
        for (int q = 0; q < 2; ++q) { const int row = row0 + q; load_row_f32(v[q], row < NT ? P->in[I_X] + (size_t)row * D : P->in[I_CTX] + (size_t)(row - NT) * D, lane); }
        const int r = row0 < NT ? (row0 >> 14) : 2;
        const float* m = mod + (size_t)r * 12288;
#pragma unroll
        for (int q = 0; q < 2; ++q) { const int row = row0 + q;
            norm_mod_row(v[q], P->in[I_N1G], m + 0 * 2048, m + 1 * 2048, lane);
            if (row < NT) store_row_bf16(H + (size_t)row * D, v[q], lane);
            store_row_fp8(H8 + (size_t)row * D, v[q], lane); }
    }
}

DI void phase_norm2_router(KP P, int layer, LAS unsigned char* lds, int tid, int lane, int wave) {
    const float* mod = (const float*)(P->ws + WS_MOD) + (size_t)layer * 3 * 12288; unsigned char* H8 = P->ws + WS_H;
    float* AFF = (float*)(P->ws + WS_AFF); const bf16* XLB = (const bf16*)(P->ws + WS_XLB);
    LAS unsigned char* wt = lds + LDS_SCR;
    LAS unsigned char* gsL = lds + LDS_SCR + 131072;
    LAS unsigned char* shL = lds + LDS_SCR + 135168;
    LAS float* part = (LAS float*)(lds + LDS_SCR + 139264);
    const float* n2g = P->in[I_N2G] + (size_t)layer * D; const float* wr = P->in[I_ROUTER] + (size_t)layer * 2048 * 16;
    const int gw = blockIdx.x * NWAVES + wave, NGW = gridDim.x * NWAVES;
    const int i16 = lane & 15, kq = lane >> 4;
    int cur_b = -1;
    for (int rb = gw; rb < NT / 16; rb += NGW) {
        const int b = rb >> 10;
        if (b != cur_b) {
            cur_b = b; __syncthreads();
            const float* m = mod + (size_t)b * 12288; const float* sh = m + 3 * 2048; const float* sc = m + 4 * 2048;
            { const int e = tid & 15;
              for (int kc = tid >> 4; kc < 256; kc += 32) { float w[8];
#pragma unroll
                  for (int jj = 0; jj < 8; ++jj) { const int k = 8 * kc + jj; w[jj] = n2g[k] * (1.0f + sc[k]) * wr[k * 16 + e]; }
                  v4u hi, lo; unsigned h_[4], l_[4];
#pragma unroll
                  for (int q = 0; q < 4; ++q) { h_[q] = pk2(w[2 * q], w[2 * q + 1]); l_[q] = pk2(w[2 * q] - bf_lo(h_[q]), w[2 * q + 1] - bf_hi(h_[q])); }
                  hi.x = h_[0]; hi.y = h_[1]; hi.z = h_[2]; hi.w = h_[3]; lo.x = l_[0]; lo.y = l_[1]; lo.z = l_[2]; lo.w = l_[3];
                  *(LAS v4u*)(wt + ((0 * 16 + e) * 256 + (kc ^ e)) * 16) = hi; *(LAS v4u*)(wt + ((1 * 16 + e) * 256 + (kc ^ e)) * 16) = lo; }
              float pb = 0.f; const int pt = tid >> 4;
              for (int k = 64 * pt; k < 64 * pt + 64; ++k) pb += sh[k] * wr[k * 16 + e];
              part[pt * 16 + e] = pb; }
            if (tid < 256) { float a[8], c[8];
#pragma unroll
                for (int jj = 0; jj < 8; ++jj) { const int k = 8 * tid + jj; a[jj] = n2g[k] * (1.0f + sc[k]); c[jj] = sh[k]; }
                v4u ga, sa; ga.x = pk2(a[0], a[1]); ga.y = pk2(a[2], a[3]); ga.z = pk2(a[4], a[5]); ga.w = pk2(a[6], a[7]); sa.x = pk2(c[0], c[1]); sa.y = pk2(c[2], c[3]); sa.z = pk2(c[4], c[5]); sa.w = pk2(c[6], c[7]);
                *(LAS v4u*)(gsL + tid * 16) = ga; *(LAS v4u*)(shL + tid * 16) = sa; }
            __syncthreads();
            if (tid < 16) { float sacc = 0.f;
#pragma unroll 8
                for (int p = 0; p < 32; ++p) sacc += part[p * 16 + tid];
                part[512 + tid] = sacc; }
            __syncthreads();
        }
        const int row = 16 * rb + i16;
        const GAS v4u* xr = (const GAS v4u*)(XLB + (size_t)row * D) + 2 * kq;
        pg8::f32x4 acc = {0.f, 0.f, 0.f, 0.f}; float ss = 0.f;
#pragma unroll 4
        for (int t = 0; t < 32; ++t) {
            const v4u x0 = xr[8 * t], x1 = xr[8 * t + 1];
            const int c0 = 8 * t + 2 * kq;
            const bf16x8 wh0 = *(const LAS bf16x8*)(wt + ((0 * 16 + i16) * 256 + ((c0 + 0) ^ i16)) * 16), wl0 = *(const LAS bf16x8*)(wt + ((1 * 16 + i16) * 256 + ((c0 + 0) ^ i16)) * 16);
            const bf16x8 wh1 = *(const LAS bf16x8*)(wt + ((0 * 16 + i16) * 256 + ((c0 + 1) ^ i16)) * 16), wl1 = *(const LAS bf16x8*)(wt + ((1 * 16 + i16) * 256 + ((c0 + 1) ^ i16)) * 16);
            const bf16x8 a0 = __builtin_bit_cast(bf16x8, x0), a1 = __builtin_bit_cast(bf16x8, x1);
            acc = __builtin_amdgcn_mfma_f32_16x16x32_bf16(a0, wh0, acc, 0, 0, 0); acc = __builtin_amdgcn_mfma_f32_16x16x32_bf16(a0, wl0, acc, 0, 0, 0);
            acc = __builtin_amdgcn_mfma_f32_16x16x32_bf16(a1, wh1, acc, 0, 0, 0); acc = __builtin_amdgcn_mfma_f32_16x16x32_bf16(a1, wl1, acc, 0, 0, 0);
            float f;
            f = bf_lo(x0.x); ss += f * f; f = bf_hi(x0.x); ss += f * f; f = bf_lo(x0.y); ss += f * f; f = bf_hi(x0.y); ss += f * f;
            f = bf_lo(x0.z); ss += f * f; f = bf_hi(x0.z); ss += f * f; f = bf_lo(x0.w); ss += f * f; f = bf_hi(x0.w); ss += f * f;
            f = bf_lo(x1.x); ss += f * f; f = bf_hi(x1.x); ss += f * f; f = bf_lo(x1.y); ss += f * f; f = bf_hi(x1.y); ss += f * f;
            f = bf_lo(x1.z); ss += f * f; f = bf_hi(x1.z); ss += f * f; f = bf_lo(x1.w); ss += f * f; f = bf_hi(x1.w); ss += f * f;
        }
        ss += __shfl_xor(ss, 16); ss += __shfl_xor(ss, 32);
        const float rstd = 1.0f / sqrtf(ss * (1.0f / D) + EPS);
        const float bias = part[512 + i16];
        float lg[4], mx[4], sm[4];
#pragma unroll
        for (int r = 0; r < 4; ++r) { const float rs = __shfl(rstd, 4 * kq + r); lg[r] = rs * acc[r] + bias; mx[r] = lg[r]; }
#pragma unroll
        for (int o = 1; o < 16; o <<= 1)
#pragma unroll
            for (int r = 0; r < 4; ++r) mx[r] = fmaxf(mx[r], __shfl_xor(mx[r], o));
#pragma unroll
        for (int r = 0; r < 4; ++r) { lg[r] = __expf(lg[r] - mx[r]); sm[r] = lg[r]; }
#pragma unroll
        for (int o = 1; o < 16; o <<= 1)
#pragma unroll
            for (int r = 0; r < 4; ++r) sm[r] += __shfl_xor(sm[r], o);
        { const int n0 = (16 * rb) & (SEQ - 1); pg8::f32x4 o4 = {lg[0] / sm[0], lg[1] / sm[1], lg[2] / sm[2], lg[3] / sm[3]};
          *(GAS pg8::f32x4*)(AFF + ((size_t)(b * 16 + i16)) * SEQ + n0 + 4 * kq) = o4; }
        GAS v4u* hr = (GAS v4u*)(H8 + (size_t)row * D) + kq;
#pragma unroll 4
        for (int t = 0; t < 32; ++t) {
            const v4u x0 = xr[8 * t], x1 = xr[8 * t + 1];
            const v4u g0 = *(const LAS v4u*)(gsL + (8 * t + 2 * kq) * 16), g1 = *(const LAS v4u*)(gsL + (8 * t + 2 * kq + 1) * 16);
            const v4u s0 = *(const LAS v4u*)(shL + (8 * t + 2 * kq) * 16), s1 = *(const LAS v4u*)(shL + (8 * t + 2 * kq + 1) * 16);
            v4u o;
#define H2LO(xw, gw_, sw) (bf_lo(xw) * rstd * bf_lo(gw_) + bf_lo(sw))
#define H2HI(xw, gw_, sw) (bf_hi(xw) * rstd * bf_hi(gw_) + bf_hi(sw))
            o.x = pk4_fp8(H2LO(x0.x, g0.x, s0.x), H2HI(x0.x, g0.x, s0.x), H2LO(x0.y, g0.y, s0.y), H2HI(x0.y, g0.y, s0.y));
            o.y = pk4_fp8(H2LO(x0.z, g0.z, s0.z), H2HI(x0.z, g0.z, s0.z), H2LO(x0.w, g0.w, s0.w), H2HI(x0.w, g0.w, s0.w));
            o.z = pk4_fp8(H2LO(x1.x, g1.x, s1.x), H2HI(x1.x, g1.x, s1.x), H2LO(x1.y, g1.y, s1.y), H2HI(x1.y, g1.y, s1.y));
            o.w = pk4_fp8(H2LO(x1.z, g1.z, s1.z), H2HI(x1.z, g1.z, s1.z), H2LO(x1.w, g1.w, s1.w), H2HI(x1.w, g1.w, s1.w));
#undef H2LO
#undef H2HI
            hr[4 * t] = o;
        }
    }
    __syncthreads();
}

DI void phase_topk(KP P, int layer, LAS unsigned char* lds, int tid, int lane, int wave) {
    LAS unsigned* vals = (LAS unsigned*)(lds + LDS_SCR);
    LAS int* red = (LAS int*)(lds + LDS_SCR + 65536);
    LAS int* slotctr = (LAS int*)(lds + LDS_SCR + 65536 + 64);
    const unsigned* AFF = (const unsigned*)(P->ws + WS_AFF);
    int* IDX = (int*)(P->ws + WS_IDX);
    unsigned* tokcnt = (unsigned*)(P->ws + (layer ? CTL_TOKCNT1 : CTL_TOKCNT0));
    unsigned long long* toklist = (unsigned long long*)(P->ws + WS_TOKLIST);
    if (gridDim.x > 32 && blockIdx.x >= 32) {
        xpose_range(P, lds, lane, wave, layer == 0 ? 4 : 3, (blockIdx.x - 32) * NWAVES + wave, (gridDim.x - 32) * NWAVES);
        return;
    }
    for (int j = blockIdx.x; j < 32; j += gridDim.x) {
        const int b = j >> 4, e = j & 15;
        const unsigned* src = AFF + (size_t)j * SEQ;
#pragma unroll 8
        for (int i = 0; i < 32; ++i) vals[tid + 512 * i] = src[tid + 512 * i];
        if (tid == 0) slotctr[0] = 0;
        __syncthreads();
        int par = 0;
#define TK_COUNT(pred, total) do { int _c = 0; _Pragma("unroll 8") for (int i = 0; i < 32; ++i) { const int idx = tid + 512 * i; const unsigned v = vals[idx]; (void)idx; _c += (pred) ? 1 : 0; } \
        _c = wave_sum_i(_c); if (lane == 0) red[par * 8 + wave] = _c; __syncthreads(); total = 0; _Pragma("unroll") for (int w = 0; w < 8; ++w) total += red[par * 8 + w]; par ^= 1; } while (0)
        unsigned T = 0u;
        for (int bit = 30; bit >= 0; --bit) { const unsigned cand = T | (1u << bit); int total; TK_COUNT(v >= cand, total); if (total >= CAP) T = cand; }
        int ngt; TK_COUNT(v > T, ngt);
        const int need = CAP - ngt;
        int lo = 0, hi = SEQ - 1;
        while (lo < hi) { const int mid = (lo + hi) >> 1; int c; TK_COUNT(v == T && idx <= mid, c); if (c >= need) hi = mid; else lo = mid + 1; }
        const int J = lo;
#undef TK_COUNT
        for (int i = 0; i < 32; ++i) { const int idx = tid + 512 * i; const unsigned v = vals[idx];
            if (v > T || (v == T && idx <= J)) {
                const int slot = __hip_atomic_fetch_add(slotctr, 1, __ATOMIC_RELAXED, __HIP_MEMORY_SCOPE_WORKGROUP);
                IDX[j * CAP + slot] = idx;
                const int tok = b * SEQ + idx; const unsigned rowid = (unsigned)(e * 4096 + b * 2048 + slot);
                const unsigned p = __hip_atomic_fetch_add(tokcnt + tok, 1u, RLX_AGENT);
                toklist[(size_t)tok * 16 + (p & 15u)] = ((unsigned long long)v << 32) | rowid; } }
        __syncthreads();
    }
}

template <bool F8>
DI void phase_gather(KP P, int lane, int wave) {
    const int* IDX = (const int*)(P->ws + WS_IDX); const unsigned char* H = (const unsigned char*)(P->ws + WS_H); unsigned char* XS = (unsigned char*)(P->ws + WS_R2);
    const int gw = blockIdx.x * NWAVES + wave, NGW = gridDim.x * NWAVES;
    constexpr int RB = F8 ? D : 2 * D, NV = RB / 1024;
    for (int rowid = gw; rowid < 65536; rowid += NGW) {
        const int e = rowid >> 12, b = (rowid >> 11) & 1, slot = rowid & 2047;
        const int n = IDX[(b * 16 + e) * CAP + slot];
        const GAS v4u* s = (const GAS v4u*)(H + (size_t)(b * SEQ + n) * RB) + lane; GAS v4u* d = (GAS v4u*)(XS + (size_t)rowid * RB) + lane;
        v4u t[NV];
#pragma unroll
        for (int j = 0; j < NV; ++j) t[j] = s[64 * j];
#pragma unroll
        for (int j = 0; j < NV; ++j) d[64 * j] = t[j];
    }
}

DI void unpack8(float (&f)[8], const v4u w) { f[0] = bf_lo(w.x); f[1] = bf_hi(w.x); f[2] = bf_lo(w.y); f[3] = bf_hi(w.y); f[4] = bf_lo(w.z); f[5] = bf_hi(w.z); f[6] = bf_lo(w.w); f[7] = bf_hi(w.w); }
typedef float f32x2_t __attribute__((ext_vector_type(2)));
DI void unpack8_fp8(float (&f)[8], const v2u w) {
    const f32x2_t a = __builtin_amdgcn_cvt_pk_f32_fp8((int)w.x, false), b = __builtin_amdgcn_cvt_pk_f32_fp8((int)w.x, true), c = __builtin_amdgcn_cvt_pk_f32_fp8((int)w.y, false), d = __builtin_amdgcn_cvt_pk_f32_fp8((int)w.y, true);
    f[0] = a.x; f[1] = a.y; f[2] = b.x; f[3] = b.y; f[4] = c.x; f[5] = c.y; f[6] = d.x; f[7] = d.y; }
template <bool NEXT_NORM>
DI void phase_combine(KP P, int layer, int lane, int wave) {
    const float* mod = (const float*)(P->ws + WS_MOD) + (size_t)layer * 3 * 12288;
    const float* modn = (const float*)(P->ws + WS_MOD) + (size_t)(layer + 1) * 3 * 12288;
    const unsigned* tokcnt = (const unsigned*)(P->ws + (layer ? CTL_TOKCNT1 : CTL_TOKCNT0));
    const unsigned long long* toklist = (const unsigned long long*)(P->ws + WS_TOKLIST);
    const unsigned char* YB = (const unsigned char*)(P->ws + WS_R3); bf16* H = (bf16*)(P->ws + WS_H); bf16* XLB = (bf16*)(P->ws + WS_XLB);
    const int gw = blockIdx.x * NWAVES + wave, NGW = gridDim.x * NWAVES;
    for (int tb = gw; tb < NT; tb += 16 * NGW) {
        int cntv = 0; { const int tk = tb + (lane & 15) * NGW; if (tk < NT) cntv = (int)tokcnt[tk]; }
        unsigned long long en0 = 0ull, en1 = 0ull, en2 = 0ull, en3 = 0ull; { const int tk = tb + (lane >> 2) * NGW;
            if (tk < NT) { const unsigned long long* ep = toklist + (size_t)tk * 16 + 4 * (lane & 3); en0 = ep[0]; en1 = ep[1]; en2 = ep[2]; en3 = ep[3]; } }
        v4u xn[4];
#pragma unroll
        for (int jj = 0; jj < 4; ++jj) xn[jj] = *(const GAS v4u*)(XLB + (size_t)tb * D + 512 * jj + 8 * lane);
        for (int i = 0; i < 16; ++i) {
            const int tok = tb + i * NGW; if (tok >= NT) break;
            const int b = tok >> 14;
            v4u xc[4];
#pragma unroll
            for (int jj = 0; jj < 4; ++jj) xc[jj] = xn[jj];
            if (i + 1 < 16 && tok + NGW < NT) {
#pragma unroll
                for (int jj = 0; jj < 4; ++jj) xn[jj] = *(const GAS v4u*)(XLB + (size_t)(tok + NGW) * D + 512 * jj + 8 * lane); }
            int cnt = __builtin_amdgcn_readlane(cntv, i); cnt = cnt > 16 ? 16 : cnt;
            float a[4][8];
#pragma unroll
            for (int jj = 0; jj < 4; ++jj)
#pragma unroll
                for (int e = 0; e < 8; ++e) a[jj][e] = 0.f;
            for (int p = 0; p < cnt; p += 2) {
                unsigned r0, r1; float g0, g1;
                { const int q = p & 3, sl = 4 * i + (p >> 2); const unsigned long long xa = (q & 1) ? en1 : en0, xb = (q & 1) ? en3 : en2, x = (q & 2) ? xb : xa;
                  r0 = (unsigned)__builtin_amdgcn_readlane((int)(unsigned)x, sl); g0 = __uint_as_float((unsigned)__builtin_amdgcn_readlane((int)(unsigned)(x >> 32), sl)); }
                if (p + 1 < cnt) { const int p1 = p + 1, q = p1 & 3, sl = 4 * i + (p1 >> 2); const unsigned long long xa = (q & 1) ? en1 : en0, xb = (q & 1) ? en3 : en2, x = (q & 2) ? xb : xa;
                  r1 = (unsigned)__builtin_amdgcn_readlane((int)(unsigned)x, sl); g1 = __uint_as_float((unsigned)__builtin_amdgcn_readlane((int)(unsigned)(x >> 32), sl)); }
                else { r1 = r0; g1 = 0.f; }
                v2u y0[4], y1[4];
#pragma unroll
                for (int jj = 0; jj < 4; ++jj) { y0[jj] = *(const GAS v2u*)(YB + (size_t)r0 * D + 512 * jj + 8 * lane); y1[jj] = *(const GAS v2u*)(YB + (size_t)r1 * D + 512 * jj + 8 * lane); }
#pragma unroll
                for (int jj = 0; jj < 4; ++jj) { float f0[8], f1[8]; unpack8_fp8(f0, y0[jj]); unpack8_fp8(f1, y1[jj]);
#pragma unroll
                    for (int e = 0; e < 8; ++e) a[jj][e] += g0 * f0[e] + g1 * f1[e]; }
            }
            const float* g2 = mod + (size_t)b * 12288 + 5 * 2048;
            float v[4][8]; float ss = 0.f;
#pragma unroll
            for (int jj = 0; jj < 4; ++jj) { const int c = 512 * jj + 8 * lane; const f32x4 ga = *(const f32x4*)(g2 + c), gb = *(const f32x4*)(g2 + c + 4); float x[8]; unpack8(x, xc[jj]);
                v[jj][0] = x[0] + ga.x * a[jj][0]; v[jj][1] = x[1] + ga.y * a[jj][1]; v[jj][2] = x[2] + ga.z * a[jj][2]; v[jj][3] = x[3] + ga.w * a[jj][3];
                v[jj][4] = x[4] + gb.x * a[jj][4]; v[jj][5] = x[5] + gb.y * a[jj][5]; v[jj][6] = x[6] + gb.z * a[jj][6]; v[jj][7] = x[7] + gb.w * a[jj][7];
#pragma unroll
                for (int e = 0; e < 8; ++e) ss += v[jj][e] * v[jj][e]; }
            if constexpr (NEXT_NORM) {
#pragma unroll
                for (int jj = 0; jj < 4; ++jj) { v4u o; o.x = pk2(v[jj][0], v[jj][1]); o.y = pk2(v[jj][2], v[jj][3]); o.z = pk2(v[jj][4], v[jj][5]); o.w = pk2(v[jj][6], v[jj][7]);
                    *(GAS v4u*)(XLB + (size_t)tok * D + 512 * jj + 8 * lane) = o; }
                const float rstd = 1.0f / sqrtf(wave_sum(ss) * (1.0f / D) + EPS);
                const float* m = modn + (size_t)b * 12288; const float* gn = P->in[I_N1G] + (size_t)(layer + 1) * D;
#pragma unroll
                for (int jj = 0; jj < 4; ++jj) { const int c = 512 * jj + 8 * lane; float h[8];
#pragma unroll
                    for (int hf2 = 0; hf2 < 2; ++hf2) { const f32x4 gg = *(const f32x4*)(gn + c + 4 * hf2), sc = *(const f32x4*)(m + 2048 + c + 4 * hf2), sh = *(const f32x4*)(m + c + 4 * hf2);
                        h[4 * hf2 + 0] = v[jj][4 * hf2 + 0] * rstd * gg.x * (1.0f + sc.x) + sh.x; h[4 * hf2 + 1] = v[jj][4 * hf2 + 1] * rstd * gg.y * (1.0f + sc.y) + sh.y;
                        h[4 * hf2 + 2] = v[jj][4 * hf2 + 2] * rstd * gg.z * (1.0f + sc.z) + sh.z; h[4 * hf2 + 3] = v[jj][4 * hf2 + 3] * rstd * gg.w * (1.0f + sc.w) + sh.w; }
                    v4u o; o.x = pk2(h[0], h[1]); o.y = pk2(h[2], h[3]); o.z = pk2(h[4], h[5]); o.w = pk2(h[6], h[7]);
                    *(GAS v4u*)(H + (size_t)tok * D + 512 * jj + 8 * lane) = o; }
            } else {
#pragma unroll
                for (int jj = 0; jj < 4; ++jj) { GAS f32x4* o = (GAS f32x4*)(P->out + (size_t)tok * D + 512 * jj + 8 * lane);
                    __builtin_nontemporal_store((f32x4){v[jj][0], v[jj][1], v[jj][2], v[jj][3]}, o); __builtin_nontemporal_store((f32x4){v[jj][4], v[jj][5], v[jj][6], v[jj][7]}, o + 1); }
            }
        }
    }
}

DI void phase_knorm(KP P, int lane, int wave) {
    bf16* KK = (bf16*)(P->ws + WS_R2) + 3 * R2_T; const float* gk = P->in[I_BKG];
    const int gw = blockIdx.x * NWAVES + wave, NGW = gridDim.x * NWAVES;
    const int d0 = (lane & 7) * 16;
    float gkr[16];
#pragma unroll
    for (int i = 0; i < 16; ++i) gkr[i] = gk[d0 + i];
    for (int row = gw; row < MTOT; row += NGW) {
        GAS v4u* p = (GAS v4u*)(KK + (size_t)row * 1024) + 2 * lane;
        const v4u w0 = p[0], w1 = p[1];
        float f[16];
        f[0] = bf_lo(w0.x); f[1] = bf_hi(w0.x); f[2] = bf_lo(w0.y); f[3] = bf_hi(w0.y); f[4] = bf_lo(w0.z); f[5] = bf_hi(w0.z); f[6] = bf_lo(w0.w); f[7] = bf_hi(w0.w);
        f[8] = bf_lo(w1.x); f[9] = bf_hi(w1.x); f[10] = bf_lo(w1.y); f[11] = bf_hi(w1.y); f[12] = bf_lo(w1.z); f[13] = bf_hi(w1.z); f[14] = bf_lo(w1.w); f[15] = bf_hi(w1.w);
        float ss = 0.f;
#pragma unroll
        for (int i = 0; i < 16; ++i) ss += f[i] * f[i];
        ss += __shfl_xor(ss, 1); ss += __shfl_xor(ss, 2); ss += __shfl_xor(ss, 4);
        const float rstd = 1.0f / sqrtf(ss * (1.0f / 128.0f) + EPS);
#pragma unroll
        for (int i = 0; i < 16; ++i) f[i] = f[i] * rstd * gkr[i];
        v4u o0, o1; o0.x = pk2(f[0], f[1]); o0.y = pk2(f[2], f[3]); o0.z = pk2(f[4], f[5]); o0.w = pk2(f[6], f[7]); o1.x = pk2(f[8], f[9]); o1.y = pk2(f[10], f[11]); o1.z = pk2(f[12], f[13]); o1.w = pk2(f[14], f[15]);
        p[0] = o0; p[1] = o1;
    }
}

DI void phase_gmlp(KP P, LAS unsigned char* lds, int tid, int lane, int wave) {
    const bf16* U = (const bf16*)(P->ws + WS_R2); const bf16* V = U + R2_T; const bf16* WSB = (const bf16*)(P->ws + WS_WSB);
    bf16* CAT = (bf16*)(P->ws + WS_R3);
    LAS unsigned char* wimg = lds + LDS_SCR;
    LAS unsigned char* vimg = lds + LDS_SCR + 32768;
    const int ql = lane & 31, hf = lane >> 5;
    const int G = gridDim.x;
    const bool wonce = (G & 7) == 0;
    v4u vraw[4];
    int u = blockIdx.x;
    if (u < 2048) { const int g = u & 7, cn = (u >> 3) & 127, b = u >> 10; const int tok0 = b * SEQ + cn * 128;
#pragma unroll
        for (int i = 0; i < 4; ++i) { const int cidx = tid + 512 * i, q = cidx >> 4, ch = cidx & 15; vraw[i] = *(const GAS v4u*)(V + (size_t)(tok0 + q) * 1024 + g * 128 + ch * 8); } }
    for (int it = 0; u < 2048; u += G, ++it) {
        const int g = u & 7, cn = (u >> 3) & 127, b = u >> 10;
        const int tok0 = b * SEQ + cn * 128;
        const float* gv = P->in[I_AVG] + g * 128;
        if (it == 0 || !wonce) {
#pragma unroll
            for (int i = 0; i < 4; ++i) { const int cidx = tid + 512 * i, q = cidx >> 4, ch = cidx & 15;
                const v4u wraw = *(const GAS v4u*)(WSB + (size_t)(g * 128 + q) * 128 + ch * 8);
                *(LAS v4u*)(wimg + (q >> 5) * 8192 + off_b(q & 31, ch)) = wraw; } }
#pragma unroll
        for (int i = 0; i < 4; ++i) { const int cidx = tid + 512 * i, q = cidx >> 4, ch = cidx & 15;
            const v4u raw = vraw[i];
            float f[8]; f[0] = bf_lo(raw.x); f[1] = bf_hi(raw.x); f[2] = bf_lo(raw.y); f[3] = bf_hi(raw.y); f[4] = bf_lo(raw.z); f[5] = bf_hi(raw.z); f[6] = bf_lo(raw.w); f[7] = bf_hi(raw.w);
            float ss = 0.f;
#pragma unroll
            for (int k = 0; k < 8; ++k) ss += f[k] * f[k];
            ss += __shfl_xor(ss, 1); ss += __shfl_xor(ss, 2); ss += __shfl_xor(ss, 4); ss += __shfl_xor(ss, 8);
            const float rstd = 1.0f / sqrtf(ss * (1.0f / 128.0f) + EPS);
            const f32x4 g0 = *(const f32x4*)(gv + ch * 8), g1 = *(const f32x4*)(gv + ch * 8 + 4);
            v4u o; o.x = pk2(f[0] * rstd * g0.x, f[1] * rstd * g0.y); o.y = pk2(f[2] * rstd * g0.z, f[3] * rstd * g0.w); o.z = pk2(f[4] * rstd * g1.x, f[5] * rstd * g1.y); o.w = pk2(f[6] * rstd * g1.z, f[7] * rstd * g1.w);
            *(LAS v4u*)(vimg + (q >> 5) * 8192 + off_b(q & 31, ch)) = o; }
        __syncthreads();
        const int cb = wave & 3, pb0 = 2 * (wave >> 2);
        { const int un = u + G; if (un < 2048) { const int gn = un & 7, cnn = (un >> 3) & 127, bn = un >> 10; const int tokn = bn * SEQ + cnn * 128;
#pragma unroll
            for (int i = 0; i < 4; ++i) { const int cidx = tid + 512 * i, q = cidx >> 4, ch = cidx & 15; vraw[i] = *(const GAS v4u*)(V + (size_t)(tokn + q) * 1024 + gn * 128 + ch * 8); } } }
        v2u uu[2][4]; float bsv[2];
#pragma unroll
        for (int x = 0; x < 2; ++x) { const int p = 32 * (pb0 + x) + ql; bsv[x] = P->in[I_ABS][g * 128 + p];
#pragma unroll
            for (int rq = 0; rq < 4; ++rq) uu[x][rq] = *(const GAS v2u*)(U + (size_t)(tok0 + p) * 1024 + g * 128 + 32 * cb + 8 * rq + 4 * hf); }
        f32x16 acc0, acc1;
#pragma unroll
        for (int i = 0; i < 16; ++i) { acc0[i] = 0.f; acc1[i] = 0.f; }
#pragma unroll
        for (int ks = 0; ks < 8; ++ks) {
            const bf16x8 a = tr_frag<false>(vimg + (ks >> 1) * 8192, lane, cb, ks & 1);
            const bf16x8 b0 = row_frag(wimg + (pb0 + 0) * 8192, lane, ks), b1 = row_frag(wimg + (pb0 + 1) * 8192, lane, ks);
            acc0 = MFMA32(a, b0, acc0); acc1 = MFMA32(a, b1, acc1);
        }
#pragma unroll
        for (int x = 0; x < 2; ++x) { const int p = 32 * (pb0 + x) + ql; const int tok = tok0 + p; const float bs = bsv[x];
            v2u oo[4];
#pragma unroll
            for (int rq = 0; rq < 4; ++rq) {
                const v2u w = uu[x][rq];
                const float s0 = (x ? acc1[4 * rq + 0] : acc0[4 * rq + 0]) + bs, s1 = (x ? acc1[4 * rq + 1] : acc0[4 * rq + 1]) + bs, s2 = (x ? acc1[4 * rq + 2] : acc0[4 * rq + 2]) + bs, s3 = (x ? acc1[4 * rq + 3] : acc0[4 * rq + 3]) + bs;
                oo[rq].x = pk2(bf_lo(w.x) * s0, bf_hi(w.x) * s1); oo[rq].y = pk2(bf_lo(w.y) * s2, bf_hi(w.y) * s3); }
#pragma unroll
            for (int rq = 0; rq < 4; rq += 2) {
                const auto rx = __builtin_amdgcn_permlane32_swap(oo[rq].x, oo[rq + 1].x, false, false); const auto ry = __builtin_amdgcn_permlane32_swap(oo[rq].y, oo[rq + 1].y, false, false);
                v4u o; o.x = rx[0]; o.y = ry[0]; o.z = rx[1]; o.w = ry[1];
                *(GAS v4u*)(CAT + (size_t)tok * D + g * 128 + 32 * cb + 8 * (rq + hf)) = o; } }
        __syncthreads();
    }
}

DI void phase_attn(KP P, LAS unsigned char* lds, int tid, int lane, int wave) {
    const bf16* Qb = (const bf16*)(P->ws + WS_R2) + 2 * R2_T; const bf16* KK = Qb + R2_T; const bf16* VV = KK + R2_T;
    bf16* CAT = (bf16*)(P->ws + WS_R3);
    LAS unsigned char* kbuf = lds + LDS_SCR;
    LAS unsigned char* vbuf = lds + LDS_SCR + 49152;
    LAS float* rpbL = (LAS float*)(lds + LDS_SCR + 98304 + 1024);
    const int ql = lane & 31, hf = lane >> 5;
    const float* gq = P->in[I_BQG];
    const int rp = wave >> 2, cb = wave & 3;
    const int c0 = min(max(16 * cb - 8, 0), 32);
    const int u00 = c0 >> 3; const bool oddw = (u00 & 1) != 0; const unsigned offw = 4096u * (unsigned)(u00 >> 1);
    unsigned trl[4], trh[4];
    { const unsigned h = lane >> 5, blk = (lane >> 4) & 1, q = (lane & 15) >> 2, p = lane & 3, r0 = 4 * h + q, sub = 8 * (p & 1);
#pragma unroll
      for (int c = 0; c < 4; ++c) { const unsigned ch = 4 * c + 2 * blk + (p >> 1); trl[c] = off_b(r0, ch) + sub; trh[c] = off_b(r0 + 8, ch) + sub; } }
    unsigned kfl[8];
    { const unsigned key = (unsigned)(c0 + ql);
#pragma unroll
      for (int s = 0; s < 8; ++s) kfl[s] = (key >> 5) * 8192u + off_b(key & 31u, 2 * s + hf); }
    for (int u = blockIdx.x; u < 1024; u += gridDim.x) {
        const int h = u & 7, rg = (u >> 3) & 63, b = u >> 9;
        const int qr = 4 * rg + 2 * rp + (ql >> 4), qc = 16 * cb + (ql & 15);
        const int tq = b * SEQ + qr * GRIDW + qc;
        bf16x8 Qf[8];
        { v4u raw[8]; float ss = 0.f;
#pragma unroll
          for (int s = 0; s < 8; ++s) { raw[s] = *(const GAS v4u*)(Qb + (size_t)tq * 1024 + h * 128 + 16 * s + 8 * hf);
              const float a0 = bf_lo(raw[s].x), a1 = bf_hi(raw[s].x), a2 = bf_lo(raw[s].y), a3 = bf_hi(raw[s].y), a4 = bf_lo(raw[s].z), a5 = bf_hi(raw[s].z), a6 = bf_lo(raw[s].w), a7 = bf_hi(raw[s].w);
              ss += (a0 * a0 + a1 * a1) + (a2 * a2 + a3 * a3) + (a4 * a4 + a5 * a5) + (a6 * a6 + a7 * a7); }
          ss += __shfl_xor(ss, 32);
          const float qs = (1.0f / sqrtf(ss * (1.0f / 128.0f) + EPS)) * (0.08838834764831845f * LOG2E);
#pragma unroll
          for (int s = 0; s < 8; ++s) { const f32x4 g0 = *(const f32x4*)(gq + 16 * s + 8 * hf), g1 = *(const f32x4*)(gq + 16 * s + 8 * hf + 4);
              v4u o; o.x = pk2(bf_lo(raw[s].x) * qs * g0.x, bf_hi(raw[s].x) * qs * g0.y); o.y = pk2(bf_lo(raw[s].y) * qs * g0.z, bf_hi(raw[s].y) * qs * g0.w);
              o.z = pk2(bf_lo(raw[s].z) * qs * g1.x, bf_hi(raw[s].z) * qs * g1.y); o.w = pk2(bf_lo(raw[s].w) * qs * g1.z, bf_hi(raw[s].w) * qs * g1.w);
              Qf[s] = __builtin_bit_cast(bf16x8, o); } }
        if (tid < 465) rpbL[tid] = P->in[I_RPB][h * 465 + tid] * LOG2E;
        const int rs_q = min(max(qr - 4, 0), NROWS - 8);
        const int wlo = min(max(4 * rg + 2 * rp - 4, 0), NROWS - 8), whi = min(max(4 * rg + 2 * rp + 1 - 4, 0), NROWS - 8) + 7;
        const int krlo = min(max(4 * rg - 4, 0), NROWS - 8), krhi = min(max(4 * rg + 3 - 4, 0), NROWS - 8) + 7, ntl = krhi - krlo + 1, T = ntl + 4;
        const int cs = min(max(qc - 8, 0), GRIDW - 16);
        f32x16 O[4];
#pragma unroll
        for (int db = 0; db < 4; ++db)
#pragma unroll
            for (int i = 0; i < 16; ++i) O[db][i] = 0.f;
        float m_run = -5e29f, l_run = 0.f;
#define ATT_DMA(t, slot) do { const int _tb = (t) < ntl ? b * SEQ + (krlo + (t)) * GRIDW : NT + b * CTXL + 64 * ((t) - ntl); \
        _Pragma("unroll") for (int _i = 0; _i < 2; ++_i) { const int _c = tid + 512 * _i, _key = _c >> 4, _chp = _c & 15, _row = _key & 31; const int _ch = _chp ^ (((_row & 3) << 2) | ((_row >> 2) & 3)); \
            const size_t _o = (size_t)(_tb + _key) * 1024 + h * 128 + _ch * 8; const unsigned _l = (unsigned)(slot) * 16384u + (unsigned)(wave * 64 + 512 * _i) * 16u; \
            __builtin_amdgcn_global_load_lds((const unsigned*)(KK + _o), (LAS unsigned*)(kbuf + _l), 16, 0, 0); \
            __builtin_amdgcn_global_load_lds((const unsigned*)(VV + _o), (LAS unsigned*)(vbuf + _l), 16, 0, 0); } } while (0)
        ATT_DMA(0, 0); ATT_DMA(1, 1);
        asm volatile("s_waitcnt vmcnt(4) lgkmcnt(0)" ::: "memory"); __builtin_amdgcn_s_barrier(); asm volatile("" ::: "memory");
        for (int t = 0; t < T; ++t) {
            const int slot = t % 3;
            if (t + 2 < T) ATT_DMA(t + 2, (t + 2) % 3);
            const bool local = t < ntl; const int kr = krlo + t;
            const bool active = !local || (kr >= wlo && kr <= whi);
            if (active) {
                const LAS unsigned char* kb_ = kbuf + slot * 16384; const LAS unsigned char* vb_ = vbuf + slot * 16384;
                f32x16 S0, S1;
#pragma unroll
                for (int i = 0; i < 16; ++i) { S0[i] = 0.f; S1[i] = 0.f; }
                if (local) {
#pragma unroll
                    for (int s = 0; s < 8; ++s) { const bf16x8 a0 = *(const LAS bf16x8*)(kb_ + kfl[s]); S0 = MFMA32(a0, Qf[s], S0); }
                    const bool rowok = (kr >= rs_q) && (kr <= rs_q + 7);
                    int cl = rowok ? (cs - c0 - 4 * hf) : 0x40000000; int bbase = min(max(kr - qr + 7, 0), 14) * 31 + 15 + c0 + 4 * hf - qc;
                    asm volatile("" : "+v"(cl), "+v"(bbase));
                    const LAS float* bp = rpbL + bbase;
                    float bia0[16];
#pragma unroll
                    for (int r = 0; r < 16; ++r) bia0[r] = bp[(r & 3) + 8 * (r >> 2)];
#pragma unroll
                    for (int r = 0; r < 16; ++r) asm volatile("" : "+v"(bia0[r]));
#pragma unroll
                    for (int r = 0; r < 16; ++r) { const int k0 = (r & 3) + 8 * (r >> 2); const bool ok = (unsigned)(k0 - cl) < 16u; S0[r] = ok ? S0[r] + bia0[r] : -1e30f; }
                } else {
#pragma unroll
                    for (int s = 0; s < 8; ++s) { const bf16x8 a0 = row_frag(kb_, lane, s), a1 = row_frag(kb_ + 8192, lane, s); S0 = MFMA32(a0, Qf[s], S0); S1 = MFMA32(a1, Qf[s], S1); }
                }
                float mt = S0[0];
#pragma unroll
                for (int r = 1; r < 16; ++r) mt = fmaxf(mt, S0[r]);
                if (!local) {
#pragma unroll
                    for (int r = 0; r < 16; ++r) mt = fmaxf(mt, S1[r]); }
                mt = fmaxf(mt, __shfl_xor(mt, 32));
                const float m_new = fmaxf(m_run, mt), alpha = fast_exp2(m_run - m_new);
                m_run = m_new;
                float ps = 0.f;
#pragma unroll
                for (int r = 0; r < 16; ++r) { S0[r] = fast_exp2(S0[r] - m_new); ps += S0[r]; }
                if (!local) {
#pragma unroll
                    for (int r = 0; r < 16; ++r) { S1[r] = fast_exp2(S1[r] - m_new); ps += S1[r]; } }
                l_run = l_run * alpha + ps;
                if (__builtin_amdgcn_ballot_w64(alpha != 1.0f) != 0ull) {
#pragma unroll
                    for (int db = 0; db < 4; ++db)
#pragma unroll
                        for (int i = 0; i < 16; ++i) O[db][i] *= alpha; }
                const unsigned vb_a = (unsigned)(unsigned long)vb_;
                unsigned tal[4], tah[4];
#pragma unroll
                for (int c = 0; c < 4; ++c) { tal[c] = vb_a + trl[c]; tah[c] = vb_a + trh[c]; }
                unsigned al0[4], ah0[4];
#pragma unroll
                for (int c = 0; c < 4; ++c) { al0[c] = local ? ((oddw ? tah[c] : tal[c]) + offw) : tal[c]; ah0[c] = local ? ((oddw ? tal[c] + 4096u : tah[c]) + offw) : tah[c]; }
#pragma unroll
                for (int s2 = 0; s2 < 2; ++s2) {
                    v4u pp; pp.x = pk2(S0[8 * s2 + 0], S0[8 * s2 + 1]); pp.y = pk2(S0[8 * s2 + 2], S0[8 * s2 + 3]); pp.z = pk2(S0[8 * s2 + 4], S0[8 * s2 + 5]); pp.w = pk2(S0[8 * s2 + 6], S0[8 * s2 + 7]);
                    const bf16x8 pf = __builtin_bit_cast(bf16x8, pp);
                    bf16x8 av[4];
                    if (s2 == 0) tr_frag4_pre<0>(av, al0, ah0); else tr_frag4_pre<4096>(av, al0, ah0);
#pragma unroll
                    for (int db = 0; db < 4; ++db) O[db] = MFMA32(av[db], pf, O[db]);
                }
                if (!local) {
#pragma unroll
                    for (int s2 = 0; s2 < 2; ++s2) {
                        v4u pp; pp.x = pk2(S1[8 * s2 + 0], S1[8 * s2 + 1]); pp.y = pk2(S1[8 * s2 + 2], S1[8 * s2 + 3]); pp.z = pk2(S1[8 * s2 + 4], S1[8 * s2 + 5]); pp.w = pk2(S1[8 * s2 + 6], S1[8 * s2 + 7]);
                        const bf16x8 pf = __builtin_bit_cast(bf16x8, pp);
                        bf16x8 av[4];
                        if (s2 == 0) tr_frag4_pre<8192>(av, tal, tah); else tr_frag4_pre<12288>(av, tal, tah);
#pragma unroll
                        for (int db = 0; db < 4; ++db) O[db] = MFMA32(av[db], pf, O[db]);
                    }
                }
            }
            if (t + 2 < T) asm volatile("s_waitcnt vmcnt(4)" ::: "memory"); else asm volatile("s_waitcnt vmcnt(0)" ::: "memory");
            asm volatile("s_waitcnt lgkmcnt(0)" ::: "memory"); __builtin_amdgcn_s_barrier(); asm volatile("" ::: "memory");
        }
#undef ATT_DMA
        const float inv = 1.0f / (l_run + __shfl_xor(l_run, 32));
        bf16* orow = CAT + (size_t)tq * D + 1024 + h * 128;
#pragma unroll
        for (int db = 0; db < 4; ++db)
#pragma unroll
            for (int rq = 0; rq < 4; rq += 2) {
                const unsigned ax = pk2(O[db][4 * rq + 0] * inv, O[db][4 * rq + 1] * inv), ay = pk2(O[db][4 * rq + 2] * inv, O[db][4 * rq + 3] * inv);
                const unsigned bx = pk2(O[db][4 * rq + 4] * inv, O[db][4 * rq + 5] * inv), by = pk2(O[db][4 * rq + 6] * inv, O[db][4 * rq + 7] * inv);
                const auto rx = __builtin_amdgcn_permlane32_swap(ax, bx, false, false); const auto ry = __builtin_amdgcn_permlane32_swap(ay, by, false, false);
                v4u o; o.x = rx[0]; o.y = ry[0]; o.z = rx[1]; o.w = ry[1];
                *(GAS v4u*)(orow + 32 * db + 8 * (rq + hf)) = o; }
    }
}

DI void phase_conv(KP P, int lane, int wave) {
    const bf16* BG = (const bf16*)(P->ws + WS_R2); const bf16* CZ = BG + (size_t)NT * D; bf16* WC = (bf16*)(P->ws + WS_R3);
    const float* cw = P->in[I_CONVW];
    const int gw = blockIdx.x * NWAVES + wave, NGW = gridDim.x * NWAVES;
    for (int it = gw; it < (NT / 8) * 4; it += NGW) {
        const int tb = it >> 2, cq = it & 3;
        const int tok0 = tb * 8, c0 = cq * 512 + lane * 8;
        const int n0 = tok0 & (SEQ - 1);
        v4u z[10], g[8];
#pragma unroll
        for (int q = 0; q < 10; ++q) { const int n = n0 + q - 1; const bool in = (n >= 0) && (n < SEQ);
            z[q] = in ? *(const GAS v4u*)(CZ + (size_t)(tok0 + q - 1) * D + c0) : (v4u){0u, 0u, 0u, 0u}; }
#pragma unroll
        for (int q = 0; q < 8; ++q) g[q] = *(const GAS v4u*)(BG + (size_t)(tok0 + q) * D + c0);
        const f32x4 w0a = *(const f32x4*)(cw + c0), w0b = *(const f32x4*)(cw + c0 + 4), w1a = *(const f32x4*)(cw + D + c0), w1b = *(const f32x4*)(cw + D + c0 + 4), w2a = *(const f32x4*)(cw + 2 * D + c0), w2b = *(const f32x4*)(cw + 2 * D + c0 + 4);
#pragma unroll
        for (int q = 0; q < 8; ++q) { const v4u a = z[q], m = z[q + 1], p = z[q + 2], b_ = g[q]; v4u o;
#define CV(lohi, wsel, widx, word) (lohi(b_.word) * (w0##wsel[widx] * lohi(a.word) + w1##wsel[widx] * lohi(m.word) + w2##wsel[widx] * lohi(p.word)))
            o.x = pk2(CV(bf_lo, a, 0, x), CV(bf_hi, a, 1, x)); o.y = pk2(CV(bf_lo, a, 2, y), CV(bf_hi, a, 3, y));
            o.z = pk2(CV(bf_lo, b, 0, z), CV(bf_hi, b, 1, z)); o.w = pk2(CV(bf_lo, b, 2, w), CV(bf_hi, b, 3, w));
#undef CV
            *(GAS v4u*)(WC + (size_t)(tok0 + q) * D + c0) = o; }
    }
}

constexpr int NPHASE = 21;
__global__ void __launch_bounds__(NWAVES * 64, 2) mega_fwd(Params P_) {
    KP P = kparams();
    extern __shared__ __attribute__((aligned(16))) unsigned char lds_raw[];
    LAS unsigned char* lds = (LAS unsigned char*)lds_raw;
    volatile LAS unsigned* MISC = (volatile LAS unsigned*)(lds + MISC_OFF);
    const int tid = threadIdx.x, lane = tid & 63, wave = __builtin_amdgcn_readfirstlane(tid >> 6);
    for (int u = tid; u < (LDS_BYTES - LDSCTL_OFF) / 4; u += NWAVES * 64) ((LAS unsigned*)(lds + LDSCTL_OFF))[u] = 0u;
    __syncthreads();
    unsigned* barw = (unsigned*)(P->ws + WS_CTL + CTL_BAR);
    XcdBarrier bar; bar.bar = barw; bar.x = 0; bar.st = nullptr;
    if (P->ph_hi - P->ph_lo > 1) bar = xcd_barrier_post(barw, MISC + 8);
#define IN(k) (kparams()->ph_lo <= (k) && (k) < kparams()->ph_hi)
#define RUN(k, ...) do { if (IN(k)) { KP P = kparams(); unsigned char* ws = P->ws; (void)ws; __VA_ARGS__; if constexpr ((k) == MK_DUP) { __VA_ARGS__; } } } while (0)
#define SEAM(k) do { if (IN(k) && IN((k) + 1)) xcd_barrier(bar); } while (0)
    unsigned char* ws = P->ws;
    const int G = gridDim.x, cid = blockIdx.x;
    const float* MOD = (const float*)(ws + WS_MOD);

    RUN(0, phase_prologue(P, lds, tid, lane, wave); __syncthreads()); SEAM(0);

    RUN(1, phase_norm1_l0(P, lds, tid, lane, wave));

    SEAM(1);
#define GEMM_IN0() do { { pg8::Gemm g{(const bf16*)(ws + WS_H), (const bf16*)(ws + WS_WIN0), NT, 2048, D}; pg8::StaticOrder<false> S; S.init(NT, 2048, G, cid); \
        EpiIn0 E{(bf16*)(ws + WS_R2), 0, 1.0f, P->in[I_BKG], (LAS float*)(lds + LDS_KPART)}; pg8::gemm_phase<EpiIn0, pg8::StaticOrder<false>, true, true>(lds, g, S, E); } \
      { const bool withctx = G < 64; pg8::Gemm g{(const bf16*)(ws + WS_H8), (const bf16*)(ws + WS_WIN0F8), withctx ? MTOT : NT, 3072, D / 2}; pg8::StaticOrder<false> S; S.init(withctx ? MTOT : NT, 3072, G, cid); \
        EpiIn0 E{(bf16*)(ws + WS_R2), 2, F8_WINV, P->in[I_BKG], (LAS float*)(lds + LDS_KPART)}; pg8::gemm_phase<EpiIn0, pg8::StaticOrder<false>, true, true, true>(lds, g, S, E); } } while (0)
    RUN(2, GEMM_IN0()); SEAM(2);
    RUN(3, phase_gmlp(P, lds, tid, lane, wave));
    RUN(4, phase_attn(P, lds, tid, lane, wave)); SEAM(4);
#define GEMM_OUT0() do { pg8::Gemm g{(const bf16*)(ws + WS_R3), (const bf16*)(ws + WS_WOUT0), NT, D, D}; pg8::StaticOrder<false> S; S.init(NT, D, G, cid); \
        EpiResid<true> E{(const void*)P->in[I_X], (bf16*)(ws + WS_XLB), MOD + 2 * 2048}; pg8::gemm_phase<EpiResid<true>, pg8::StaticOrder<false>, true, true>(lds, g, S, E); } while (0)
    RUN(5, GEMM_OUT0()); SEAM(5);
#define GEMM_GU(L) do { static_assert(F8L(L), "gathered gate|up GEMM is fp8 only"); \
        pg8::Gemm g{(const bf16*)(ws + WS_H), (const bf16*)(ws + WS_GU) + (size_t)(L) * 16 * 2048 * 2048, 65536, 2048, D / 2}; pg8::StaticOrder<true> S; S.init(65536, 2048, G, cid); \
        LAS int* tbl = (LAS int*)(lds + LDS_GTBL); const int* IDXg = (const int*)(ws + WS_IDX); \
        for (int e_ = tid; e_ < 8 * 256; e_ += NWAVES * 64) { const int ui_ = e_ >> 8, r_ = e_ & 255; pg8::Unit u_; \
            if (S.next(ui_, u_)) { const int rowid = u_.pm * 256 + r_, ex = rowid >> 12, b_ = (rowid >> 11) & 1, slot = rowid & 2047; tbl[e_] = b_ * SEQ + IDXg[(b_ * 16 + ex) * CAP + slot]; } } \
        __syncthreads(); \
        EpiSwiglu<true> E{(void*)(ws + WS_HID)}; pg8::gemm_phase_gather_f8<EpiSwiglu<true>, pg8::StaticOrder<true>>(lds, g, S, E, tbl); } while (0)
#define GEMM_DN(L) do { constexpr bool F8 = F8L(L); pg8::Gemm g{(const bf16*)(ws + WS_HID), (const bf16*)(ws + WS_DN) + (size_t)(L) * 16 * 2048 * 1024, 65536, 2048, F8 ? FF / 2 : FF}; pg8::StaticOrder<true> S; S.init(65536, 2048, G, cid); \
        EpiPlain E{(unsigned char*)(ws + WS_R3), D, F8 ? F8_WINV : 1.0f, NOSTDN}; pg8::gemm_phase<EpiPlain, pg8::StaticOrder<true>, true, true, F8>(lds, g, S, E); } while (0)
#define NOSTDN 0
#define MOE_PHASES(L, base) \
    RUN(base + 0, phase_norm2_router(P, L, lds, tid, lane, wave)); SEAM(base + 0); \
    if (IN(base + 1)) { phase_topk(P, L, lds, tid, lane, wave); } SEAM(base + 1); \
    RUN(base + 3, GEMM_GU(L)); SEAM(base + 3); \
    RUN(base + 4, GEMM_DN(L)); SEAM(base + 4);
    MOE_PHASES(0, 6)
#if MK_DUP == 110
#undef NOSTDN
#define NOSTDN (P->pad + MK_NOST)
    if (IN(10)) { KP P = kparams(); unsigned char* ws = P->ws; GEMM_DN(0); }
#undef NOSTDN
#define NOSTDN 0
#endif
    if (IN(11)) { phase_combine<true>(P, 0, lane, wave); } SEAM(11);
#define GEMM_CIN() do { pg8::Gemm g{(const bf16*)(ws + WS_H), (const bf16*)(ws + WS_WCIN), NT, 6144, D}; pg8::StaticOrder<false> S; S.init(NT, 6144, G, cid); S.hot = NOST; \
        EpiCin E{(bf16*)(ws + WS_R2), (bf16*)(ws + WS_R2) + (size_t)NT * D, NOST}; pg8::gemm_phase<EpiCin, pg8::StaticOrder<false>, true, true>(lds, g, S, E); } while (0)
#define NOST 0
    RUN(12, GEMM_CIN()); SEAM(12);
#undef NOST
#if MK_DUP == 112
#define NOST (P->pad + 1)
    if (IN(12)) { GEMM_CIN(); }
#undef NOST
#endif
    RUN(13, phase_conv(P, lane, wave)); SEAM(13);
    if (IN(14)) {
        pg8::Gemm g{(const bf16*)(ws + WS_R3), (const bf16*)(ws + WS_WCOUT), NT, D, D}; pg8::StaticOrder<false> S; S.init(NT, D, G, cid);
        EpiResid<false> E{(const void*)(ws + WS_XLB), (bf16*)(ws + WS_XLB), MOD + 3 * 12288 + 2 * 2048};
        pg8::gemm_phase<EpiResid<false>, pg8::StaticOrder<false>, true, true>(lds, g, S, E);
    } SEAM(14);
    MOE_PHASES(1, 15)
    if (IN(20)) { phase_combine<false>(P, 1, lane, wave); }
#undef IN
#undef SEAM
}

extern "C" void kernel_launch(void* const* d_in, const int* in_sizes, int n_in, void* d_out, int out_size, void* d_ws, size_t ws_size, hipStream_t stream) {
    static int grid = 0;
    if (grid == 0) {
        if (n_in != 23 || out_size != NT * D || ws_size < WS_END) { fprintf(stderr, "kernel_launch: unexpected shapes (n_in %d out %d ws %zu)\n", n_in, out_size, ws_size); grid = -1; return; }
        int dev = 0, cus = 0, per_cu = 0;
        if (hipGetDevice(&dev) != hipSuccess || hipDeviceGetAttribute(&cus, hipDeviceAttributeMultiprocessorCount, dev) != hipSuccess) { grid = -1; return; }
        if (hipFuncSetAttribute((const void*)mega_fwd, hipFuncAttributeMaxDynamicSharedMemorySize, LDS_BYTES) != hipSuccess) { fprintf(stderr, "kernel_launch: hipFuncSetAttribute failed\n"); grid = -1; return; }
        if (hipOccupancyMaxActiveBlocksPerMultiprocessor(&per_cu, (const void*)mega_fwd, NWAVES * 64, LDS_BYTES) != hipSuccess || per_cu < 1) { fprintf(stderr, "kernel_launch: occupancy query says %d\n", per_cu); }
        (void)hipGetLastError();
        if (cus != 256) { fprintf(stderr, "kernel_launch: built for a 256-CU device (unit counts, the gathered-row table and the context projection assume 256 workgroups); found %d\n", cus); grid = -1; return; }
        grid = cus;
    }
    if (grid < 0) return;
    (void)hipMemsetAsync((char*)d_ws + WS_CTL, 0, CTL_ZERO_BYTES, stream);
    Params p{};
    for (int i = 0; i < 23; ++i) p.in[i] = (const float*)d_in[i];
    p.out = (float*)d_out; p.ws = (unsigned char*)d_ws; p.pad = 0;
    const int last = MK_STOP < NPHASE - 1 ? MK_STOP : NPHASE - 1;
#if MK_SPLIT
    for (int k = 0; k <= last; ++k) { p.ph_lo = k; p.ph_hi = k + 1; p.li = 0; hipLaunchKernelGGL(mega_fwd, dim3(grid), dim3(NWAVES * 64), LDS_BYTES, stream, p); }
#else
    p.ph_lo = 0; p.ph_hi = last + 1; p.li = 0;
    hipLaunchKernelGGL(mega_fwd, dim3(grid), dim3(NWAVES * 64), LDS_BYTES, stream, p);
#endif
}
```

```cpp
#include <hip/hip_runtime.h>
#include <cstdio>
#include <cstdint>

#ifndef MK_SPLIT
#define MK_SPLIT 0
#endif
#ifndef MK_STOP
#define MK_STOP 99
#endif
#ifndef MK_FP8_L0
#define MK_FP8_L0 1
#endif
#ifndef MK_FP8_L1
#define MK_FP8_L1 1
#endif
#ifndef MK_NOST
#define MK_NOST 2
#endif
#ifndef MK_DUP
#define MK_DUP -1
#endif

namespace pg8 {
#define PG8_LAS __attribute__((address_space(3)))
typedef unsigned short bf16_t;
typedef short bf16x8 __attribute__((ext_vector_type(8)));
typedef float f32x4 __attribute__((ext_vector_type(4)));
typedef unsigned u32x4 __attribute__((ext_vector_type(4)));
constexpr int BM = 256, BK = 64, HALF = 128, HTB = HALF * BK * 2, STAGE_BYTES = 8 * HTB, NXCD = 8, WGM = 8;

__host__ __device__ __forceinline__ int lds_byte(int r, int c) { const int st = (r >> 4) * 2 + (c >> 5), rr = r & 15, cc = c & 31, ob = rr * 64 + cc * 2; return st * 1024 + (ob ^ (((ob >> 9) & 1) << 5)); }
__host__ __device__ __forceinline__ void stage_rc(int b, int& R, int& C) { const int st = b / 1024, sb = b % 1024, swz = sb ^ (((sb >> 9) & 1) << 5); R = (st >> 1) * 16 + swz / 64; C = (st & 1) * 32 + (swz % 64) / 2; }
__host__ __device__ __forceinline__ int perm32(int rho) { const int n = rho >> 4, i = rho & 15; return 8 * (i >> 2) + 4 * n + (i & 3); }

struct Unit { int pm, pn, pb; };
struct Gemm { const bf16_t* A; const bf16_t* Bt; int M, N, K; };

template <bool GROUPED>
struct StaticOrder {
    int nM, nN, nwg, G, c, hot;
    __host__ __device__ void init(int M, int N, int G_, int c_) { nM = M / BM; nN = N / BM; nwg = nM * nN; G = G_; c = c_; hot = 0; }
    __host__ __device__ __forceinline__ bool next(int i, Unit& u) const {
        const long L = (long)i * G + c; if (L >= nwg) return false;
        int wgid = (int)L; { const int q = nwg / NXCD, r = nwg % NXCD, xcd = wgid % NXCD, off = wgid / NXCD; wgid = (xcd < r ? xcd * (q + 1) : r * (q + 1) + (xcd - r) * q) + off; }
        const int nig = WGM * nN, gid = wgid / nig, fm = gid * WGM, gsz = (nM - fm) < WGM ? (nM - fm) : WGM;
        u.pm = fm + ((wgid % nig) % gsz); u.pn = (wgid % nig) / gsz;
        u.pb = GROUPED ? ((u.pm >> 4) * 8 + u.pn) : u.pn;
        if (hot) { u.pm = 0; u.pn = 0; u.pb = 0; }
        return true;
    }
    __device__ __forceinline__ void a_ready(const Unit&) const {}
    __device__ __forceinline__ void done(const Unit&) const {}
};

__device__ __forceinline__ unsigned cvt_pk_bf16(float lo, float hi) { unsigned r; asm volatile("v_cvt_pk_bf16_f32 %0, %1, %2" : "=v"(r) : "v"(lo), "v"(hi)); return r; }

typedef int i32x4 __attribute__((ext_vector_type(4)));
typedef int i32x8 __attribute__((ext_vector_type(8)));
__device__ __forceinline__ i32x8 cat8(bf16x8 lo, bf16x8 hi) { return __builtin_shufflevector(__builtin_bit_cast(i32x4, lo), __builtin_bit_cast(i32x4, hi), 0, 1, 2, 3, 4, 5, 6, 7); }
template <class Epi, class Sched, bool ALIGN_EPI = false, bool SP2 = false, bool FP8 = false>
__device__ __forceinline__ void gemm_phase(PG8_LAS unsigned char* lds, const Gemm g, const Sched& S, const Epi& E) {
    const int tid = threadIdx.x, wid = __builtin_amdgcn_readfirstlane(tid >> 6), lane = tid & 63, wr = wid >> 2, wc = wid & 3, fr = lane & 15, fq = lane >> 4;
    const int K = g.K, nt = K / BK;
    constexpr bool WIDE = (Epi::PERM == 2);
    unsigned voffA[2], voffB[2];
#pragma unroll
    for (int i = 0; i < 2; ++i) { int R, C; stage_rc(tid * 16 + i * 8192, R, C); const int Rb = WIDE ? (64 * (R >> 5) + perm32(R & 31)) : (Epi::PERM ? ((R & ~31) + perm32(R & 31)) : R);
        voffA[i] = (unsigned)(R * K + C) * 2u; voffB[i] = (unsigned)(Rb * K + C) * 2u; }
    const size_t kstep = (size_t)(BK * 2);
    const size_t hstep = (size_t)HALF * K * 2;
    const size_t tstep = 2 * hstep;
    const size_t hstepB = WIDE ? (size_t)32 * K * 2 : hstep;
    const unsigned ldsw = (unsigned)wid * 1024u;
    const int aoff = lds_byte(wr * 64 + fr, fq * 8), boff = lds_byte(wc * 32 + fr, fq * 8);
#define PG8_SA(b, h) (((b) * 2 + (h)) * HTB)
#define PG8_SB(b, h) ((4 + (b) * 2 + (h)) * HTB)
#define PG8_STAGE(bufoff, gbase, voff) do { _Pragma("unroll") for (int _i = 0; _i < 2; ++_i) \
        __builtin_amdgcn_global_load_lds((const unsigned*)((const char*)(gbase) + (voff)[_i]), (PG8_LAS unsigned*)(lds + (bufoff) + ldsw + _i * 8192), 16, 0, 0); } while (0)
#define PG8_LDA(dst, b, h) do { _Pragma("unroll") for (int m = 0; m < 4; ++m) _Pragma("unroll") for (int k = 0; k < 2; ++k) dst[m][k] = *(const PG8_LAS bf16x8*)(lds + PG8_SA(b, h) + aoff + m * 2048 + k * 1024); } while (0)
#define PG8_LDB(dst, b, h) do { _Pragma("unroll") for (int n = 0; n < 2; ++n) _Pragma("unroll") for (int k = 0; k < 2; ++k) dst[n][k] = *(const PG8_LAS bf16x8*)(lds + PG8_SB(b, h) + boff + n * 2048 + k * 1024); } while (0)
#define PG8_MMA(ai, bj, At, Bt) do { __builtin_amdgcn_s_setprio(1); _Pragma("unroll") for (int m = 0; m < 4; ++m) _Pragma("unroll") for (int n = 0; n < 2; ++n) { \
        if constexpr (FP8) { const i32x8 _a = cat8(Bt[n][0], Bt[n][1]), _b = cat8(At[m][0], At[m][1]); asm volatile("v_mfma_f32_16x16x128_f8f6f4 %0, %1, %2, %0" : "+v"(acc[ai][bj][m][n]) : "v"(_a), "v"(_b)); } \
        else { _Pragma("unroll") for (int k = 0; k < 2; ++k) acc[ai][bj][m][n] = __builtin_amdgcn_mfma_f32_16x16x32_bf16(Bt[n][k], At[m][k], acc[ai][bj][m][n], 0, 0, 0); } } \
        __builtin_amdgcn_s_setprio(0); } while (0)
#define PG8_WAIT_V(n) asm volatile("s_waitcnt vmcnt(" #n ")" ::: "memory")
#define PG8_WAIT_L(n) asm volatile("s_waitcnt lgkmcnt(" #n ")" ::: "memory")
#define PG8_BAR __builtin_amdgcn_s_barrier()
#define PG8_SCHED __builtin_amdgcn_sched_barrier(0)
    Unit cur, nxt; int ui = 0;
    if (!S.next(0, cur)) return;
    f32x4 acc[2][2][4][2];
#pragma unroll
    for (int a = 0; a < 2; ++a)
#pragma unroll
        for (int b = 0; b < 2; ++b)
#pragma unroll
            for (int m = 0; m < 4; ++m)
#pragma unroll
                for (int n = 0; n < 2; ++n) acc[a][b][m][n] = (f32x4){0.f, 0.f, 0.f, 0.f};
    bf16x8 At[4][2], B0[2][2], B1[2][2];
    const char* cA = (const char*)g.A + (size_t)cur.pm * tstep; const char* cB = (const char*)g.Bt + (size_t)cur.pb * tstep;
    S.a_ready(cur);
    if constexpr (SP2) {
        PG8_STAGE(PG8_SB(0, 0), cB, voffB); PG8_STAGE(PG8_SB(0, 1), cB + hstepB, voffB); PG8_STAGE(PG8_SA(0, 0), cA, voffA); PG8_STAGE(PG8_SA(0, 1), cA + hstep, voffA);
        if (wr == 1) PG8_BAR;
        PG8_WAIT_V(2); PG8_BAR;
        PG8_STAGE(PG8_SB(1, 0), cB + kstep, voffB); PG8_STAGE(PG8_SA(1, 0), cA + kstep, voffA); PG8_STAGE(PG8_SB(1, 1), cB + hstepB + kstep, voffB);
        PG8_WAIT_V(6); PG8_BAR;
    } else {
        PG8_STAGE(PG8_SB(0, 0), cB, voffB); PG8_STAGE(PG8_SA(0, 0), cA, voffA); PG8_STAGE(PG8_SB(0, 1), cB + hstepB, voffB); PG8_STAGE(PG8_SA(0, 1), cA + hstep, voffA);
        if (wr == 1) PG8_BAR;
        PG8_WAIT_V(4); PG8_BAR;
        PG8_STAGE(PG8_SB(1, 0), cB + kstep, voffB); PG8_STAGE(PG8_SA(1, 0), cA + kstep, voffA); PG8_STAGE(PG8_SB(1, 1), cB + hstepB + kstep, voffB);
        PG8_WAIT_V(6); PG8_BAR;
    }
    for (;;) {
        const bool has_next = S.next(ui + 1, nxt);
        const char* nA = has_next ? (const char*)g.A + (size_t)nxt.pm * tstep : cA; const char* nB = has_next ? (const char*)g.Bt + (size_t)nxt.pb * tstep : cB;
        for (int t = 0; t < nt; t += 2) {
            const bool last = (t == nt - 2);
            const char* a1 = cA + (size_t)(t + 1) * kstep;
            const char* a2 = last ? nA : cA + (size_t)(t + 2) * kstep; const char* b2 = last ? nB : cB + (size_t)(t + 2) * kstep;
            const char* a3 = a2 + kstep; const char* b3 = b2 + kstep;
            if (last && has_next) S.a_ready(nxt);
            if constexpr (SP2) {
            PG8_LDB(B0, 0, 0); PG8_LDB(B1, 0, 1); PG8_SCHED; PG8_LDA(At, 0, 0); PG8_STAGE(PG8_SA(1, 1), a1 + hstep, voffA);
            PG8_WAIT_V(8); PG8_WAIT_L(0); PG8_BAR; PG8_MMA(0, 0, At, B0); PG8_MMA(0, 1, At, B1); PG8_BAR; PG8_SCHED;
            PG8_LDA(At, 0, 1); PG8_STAGE(PG8_SB(0, 0), b2, voffB); PG8_STAGE(PG8_SB(0, 1), b2 + hstepB, voffB); PG8_STAGE(PG8_SA(0, 0), a2, voffA);
            PG8_WAIT_V(8); PG8_WAIT_L(0); PG8_BAR; PG8_MMA(1, 0, At, B0); PG8_MMA(1, 1, At, B1); PG8_BAR; PG8_SCHED;
            PG8_LDB(B0, 1, 0); PG8_LDB(B1, 1, 1); PG8_SCHED; PG8_LDA(At, 1, 0); PG8_STAGE(PG8_SA(0, 1), a2 + hstep, voffA);
            PG8_WAIT_V(8); PG8_WAIT_L(0); PG8_BAR; PG8_MMA(0, 0, At, B0); PG8_MMA(0, 1, At, B1); PG8_BAR; PG8_SCHED;
            PG8_LDA(At, 1, 1); PG8_STAGE(PG8_SB(1, 0), b3, voffB); PG8_STAGE(PG8_SB(1, 1), b3 + hstepB, voffB); PG8_STAGE(PG8_SA(1, 0), a3, voffA);
            PG8_WAIT_V(8); PG8_WAIT_L(0); PG8_BAR; PG8_MMA(1, 0, At, B0); PG8_MMA(1, 1, At, B1); PG8_BAR; PG8_SCHED;
            } else {
            PG8_LDB(B0, 0, 0); PG8_SCHED; PG8_LDA(At, 0, 0); PG8_STAGE(PG8_SA(1, 1), a1 + hstep, voffA);
            PG8_WAIT_L(8); PG8_BAR; PG8_WAIT_L(0); PG8_MMA(0, 0, At, B0); PG8_BAR; PG8_SCHED;
            PG8_LDB(B1, 0, 1); PG8_STAGE(PG8_SB(0, 0), b2, voffB);
            PG8_BAR; PG8_WAIT_L(0); PG8_MMA(0, 1, At, B1); PG8_BAR;
            PG8_LDA(At, 0, 1); PG8_STAGE(PG8_SA(0, 0), a2, voffA);
            PG8_BAR; PG8_WAIT_L(0); PG8_MMA(1, 0, At, B0); PG8_BAR; PG8_SCHED;
            PG8_STAGE(PG8_SB(0, 1), b2 + hstepB, voffB);
            PG8_WAIT_V(6); PG8_BAR; PG8_MMA(1, 1, At, B1); PG8_BAR;
            PG8_LDB(B0, 1, 0); PG8_SCHED; PG8_LDA(At, 1, 0); PG8_STAGE(PG8_SA(0, 1), a2 + hstep, voffA);
            PG8_WAIT_L(8); PG8_BAR; PG8_WAIT_L(0); PG8_MMA(0, 0, At, B0); PG8_BAR; PG8_SCHED;
            PG8_LDB(B1, 1, 1); PG8_STAGE(PG8_SB(1, 0), b3, voffB);
            PG8_BAR; PG8_WAIT_L(0); PG8_MMA(0, 1, At, B1); PG8_BAR;
            PG8_LDA(At, 1, 1); PG8_STAGE(PG8_SA(1, 0), a3, voffA);
            PG8_BAR; PG8_WAIT_L(0); PG8_MMA(1, 0, At, B0); PG8_BAR; PG8_SCHED;
            PG8_STAGE(PG8_SB(1, 1), b3 + hstepB, voffB);
            PG8_WAIT_V(6); PG8_BAR; PG8_MMA(1, 1, At, B1); PG8_BAR;
            }
        }
        if constexpr (ALIGN_EPI) { if (wr == 0) PG8_BAR; }
        if constexpr (FP8) asm volatile("s_nop 7\n\ts_nop 7\n\ts_nop 7" ::: "memory");
        E(acc, cur, wr, wc, fr, fq);
        if (!has_next) break;
#pragma unroll
        for (int a = 0; a < 2; ++a)
#pragma unroll
            for (int b = 0; b < 2; ++b)
#pragma unroll
                for (int m = 0; m < 4; ++m)
#pragma unroll
                    for (int n = 0; n < 2; ++n) acc[a][b][m][n] = (f32x4){0.f, 0.f, 0.f, 0.f};
        cur = nxt; cA = nA; cB = nB; ++ui;
        if constexpr (ALIGN_EPI) { if (wr == 1) PG8_BAR; }
    }
    PG8_WAIT_V(0);
    if constexpr (!ALIGN_EPI) { if (wr == 0) PG8_BAR; }
    PG8_BAR;
#undef PG8_SA
#undef PG8_SB
#undef PG8_STAGE
#undef PG8_LDA
#undef PG8_LDB
#undef PG8_MMA
#undef PG8_WAIT_V
#undef PG8_WAIT_L
#undef PG8_BAR
#undef PG8_SCHED
}

template <class Epi, class Sched>
__device__ __forceinline__ void gemm_phase_gather_f8(PG8_LAS unsigned char* lds, const Gemm g, const Sched& S, const Epi& E, const PG8_LAS int* tbl) {
    const int tid = threadIdx.x, wid = __builtin_amdgcn_readfirstlane(tid >> 6), lane = tid & 63, wr = wid >> 2, wc = wid & 3, fr = lane & 15, fq = lane >> 4;
    const int K = g.K, nt = K / BK;
    const unsigned rowb = (unsigned)K * 2u;
    unsigned voffB[2]; int RA[2]; unsigned CA[2];
#pragma unroll
    for (int i = 0; i < 2; ++i) { int R, C; stage_rc(tid * 16 + i * 8192, R, C); const int Rb = Epi::PERM ? ((R & ~31) + perm32(R & 31)) : R;
        RA[i] = R; CA[i] = (unsigned)C * 2u; voffB[i] = (unsigned)(Rb * K + C) * 2u; }
    const size_t kstep = (size_t)(BK * 2);
    const size_t hstep = (size_t)HALF * K * 2;
    const size_t tstep = 2 * hstep;
    const unsigned ldsw = (unsigned)wid * 1024u;
    const int aoff = lds_byte(wr * 64 + fr, fq * 8), boff = lds_byte(wc * 32 + fr, fq * 8);
#define PG8_SA(b, h) (((b) * 2 + (h)) * HTB)
#define PG8_SB(b, h) ((4 + (b) * 2 + (h)) * HTB)
#define PG8_STAGE(bufoff, gbase, voff) do { _Pragma("unroll") for (int _i = 0; _i < 2; ++_i) \
        __builtin_amdgcn_global_load_lds((const unsigned*)((const char*)(gbase) + (voff)[_i]), (PG8_LAS unsigned*)(lds + (bufoff) + ldsw + _i * 8192), 16, 0, 0); } while (0)
#define PG8_STAGE_G(bufoff, koff, o0, o1) do { \
        __builtin_amdgcn_global_load_lds((const unsigned*)(gA + (koff) + (o0)), (PG8_LAS unsigned*)(lds + (bufoff) + ldsw), 16, 0, 0); \
        __builtin_amdgcn_global_load_lds((const unsigned*)(gA + (koff) + (o1)), (PG8_LAS unsigned*)(lds + (bufoff) + ldsw + 8192), 16, 0, 0); } while (0)
#define PG8_LDA(dst, b, h) do { _Pragma("unroll") for (int m = 0; m < 4; ++m) _Pragma("unroll") for (int k = 0; k < 2; ++k) dst[m][k] = *(const PG8_LAS bf16x8*)(lds + PG8_SA(b, h) + aoff + m * 2048 + k * 1024); } while (0)
#define PG8_LDB(dst, b, h) do { _Pragma("unroll") for (int n = 0; n < 2; ++n) _Pragma("unroll") for (int k = 0; k < 2; ++k) dst[n][k] = *(const PG8_LAS bf16x8*)(lds + PG8_SB(b, h) + boff + n * 2048 + k * 1024); } while (0)
#define PG8_MMA(ai, bj, At, Bt) do { __builtin_amdgcn_s_setprio(1); _Pragma("unroll") for (int m = 0; m < 4; ++m) _Pragma("unroll") for (int n = 0; n < 2; ++n) { \
        const i32x8 _a = cat8(Bt[n][0], Bt[n][1]), _b = cat8(At[m][0], At[m][1]); asm volatile("v_mfma_f32_16x16x128_f8f6f4 %0, %1, %2, %0" : "+v"(acc[ai][bj][m][n]) : "v"(_a), "v"(_b)); } \
        __builtin_amdgcn_s_setprio(0); } while (0)
#define PG8_WAIT_V(n) asm volatile("s_waitcnt vmcnt(" #n ")" ::: "memory")
#define PG8_WAIT_L(n) asm volatile("s_waitcnt lgkmcnt(" #n ")" ::: "memory")
#define PG8_BAR __builtin_amdgcn_s_barrier()
#define PG8_SCHED __builtin_amdgcn_sched_barrier(0)
#define PG8_OFFS(dst, ui_) do { _Pragma("unroll") for (int _h = 0; _h < 2; ++_h) _Pragma("unroll") for (int _i = 0; _i < 2; ++_i) \
        dst[_h][_i] = (unsigned)tbl[(ui_) * 256 + _h * HALF + RA[_i]] * rowb + CA[_i]; } while (0)
    Unit cur, nxt; int ui = 0;
    if (!S.next(0, cur)) return;
    const char* gA = (const char*)g.A;
    unsigned oc[2][2], on[2][2];
    PG8_OFFS(oc, 0);
    f32x4 acc[2][2][4][2];
#pragma unroll
    for (int a = 0; a < 2; ++a)
#pragma unroll
        for (int b = 0; b < 2; ++b)
#pragma unroll
            for (int m = 0; m < 4; ++m)
#pragma unroll
                for (int n = 0; n < 2; ++n) acc[a][b][m][n] = (f32x4){0.f, 0.f, 0.f, 0.f};
    bf16x8 At[4][2], B0[2][2], B1[2][2];
    const char* cB = (const char*)g.Bt + (size_t)cur.pb * tstep;
    PG8_STAGE(PG8_SB(0, 0), cB, voffB); PG8_STAGE(PG8_SB(0, 1), cB + hstep, voffB); PG8_STAGE_G(PG8_SA(0, 0), 0, oc[0][0], oc[0][1]); PG8_STAGE_G(PG8_SA(0, 1), 0, oc[1][0], oc[1][1]);
    if (wr == 1) PG8_BAR;
    PG8_WAIT_V(2); PG8_BAR;
    PG8_STAGE(PG8_SB(1, 0), cB + kstep, voffB); PG8_STAGE_G(PG8_SA(1, 0), kstep, oc[0][0], oc[0][1]); PG8_STAGE(PG8_SB(1, 1), cB + hstep + kstep, voffB);
    PG8_WAIT_V(6); PG8_BAR;
    for (;;) {
        const bool has_next = S.next(ui + 1, nxt);
        const char* nB = has_next ? (const char*)g.Bt + (size_t)nxt.pb * tstep : cB;
        if (has_next) PG8_OFFS(on, ui + 1);
        else {
#pragma unroll
            for (int _h = 0; _h < 2; ++_h)
#pragma unroll
                for (int _i = 0; _i < 2; ++_i) on[_h][_i] = oc[_h][_i]; }
        for (int t = 0; t < nt; t += 2) {
            const bool last = (t == nt - 2);
            const size_t k1 = (size_t)(t + 1) * kstep, k2 = last ? 0 : (size_t)(t + 2) * kstep, k3 = k2 + kstep;
            const char* b2 = last ? nB : cB + (size_t)(t + 2) * kstep; const char* b3 = b2 + kstep;
            const unsigned o00 = last ? on[0][0] : oc[0][0], o01 = last ? on[0][1] : oc[0][1], o10 = last ? on[1][0] : oc[1][0], o11 = last ? on[1][1] : oc[1][1];
            PG8_LDB(B0, 0, 0); PG8_LDB(B1, 0, 1); PG8_SCHED; PG8_LDA(At, 0, 0); PG8_STAGE_G(PG8_SA(1, 1), k1, oc[1][0], oc[1][1]);
            PG8_WAIT_V(8); PG8_WAIT_L(0); PG8_BAR; PG8_MMA(0, 0, At, B0); PG8_MMA(0, 1, At, B1); PG8_BAR; PG8_SCHED;
            PG8_LDA(At, 0, 1); PG8_STAGE(PG8_SB(0, 0), b2, voffB); PG8_STAGE(PG8_SB(0, 1), b2 + hstep, voffB); PG8_STAGE_G(PG8_SA(0, 0), k2, o00, o01);
            PG8_WAIT_V(8); PG8_WAIT_L(0); PG8_BAR; PG8_MMA(1, 0, At, B0); PG8_MMA(1, 1, At, B1); PG8_BAR; PG8_SCHED;
            PG8_LDB(B0, 1, 0); PG8_LDB(B1, 1, 1); PG8_SCHED; PG8_LDA(At, 1, 0); PG8_STAGE_G(PG8_SA(0, 1), k2, o10, o11);
            PG8_WAIT_V(8); PG8_WAIT_L(0); PG8_BAR; PG8_MMA(0, 0, At, B0); PG8_MMA(0, 1, At, B1); PG8_BAR; PG8_SCHED;
            PG8_LDA(At, 1, 1); PG8_STAGE(PG8_SB(1, 0), b3, voffB); PG8_STAGE(PG8_SB(1, 1), b3 + hstep, voffB); PG8_STAGE_G(PG8_SA(1, 0), k3, o00, o01);
            PG8_WAIT_V(8); PG8_WAIT_L(0); PG8_BAR; PG8_MMA(1, 0, At, B0); PG8_MMA(1, 1, At, B1); PG8_BAR; PG8_SCHED;
        }
        if (wr == 0) PG8_BAR;
        asm volatile("s_nop 7\n\ts_nop 7\n\ts_nop 7" ::: "memory");
        E(acc, cur, wr, wc, fr, fq);
        if (!has_next) break;
#pragma unroll
        for (int a = 0; a < 2; ++a)
#pragma unroll
            for (int b = 0; b < 2; ++b)
#pragma unroll
                for (int m = 0; m < 4; ++m)
#pragma unroll
                    for (int n = 0; n < 2; ++n) acc[a][b][m][n] = (f32x4){0.f, 0.f, 0.f, 0.f};
        cur = nxt; cB = nB; ++ui;
#pragma unroll
        for (int _h = 0; _h < 2; ++_h)
#pragma unroll
            for (int _i = 0; _i < 2; ++_i) oc[_h][_i] = on[_h][_i];
        if (wr == 1) PG8_BAR;
    }
    PG8_WAIT_V(0);
    PG8_BAR;
#undef PG8_SA
#undef PG8_SB
#undef PG8_STAGE
#undef PG8_STAGE_G
#undef PG8_LDA
#undef PG8_LDB
#undef PG8_MMA
#undef PG8_WAIT_V
#undef PG8_WAIT_L
#undef PG8_BAR
#undef PG8_SCHED
#undef PG8_OFFS
}
}

constexpr int D = 2048, NB = 2, SEQ = 16384, NT = NB * SEQ, CTXL = 256, NCTX = NB * CTXL, MTOT = NT + NCTX;
constexpr int NEXP = 16, CAP = 2048, FF = 1024, GRIDW = 64, NROWS = 256;
constexpr float EPS = 1e-6f;
constexpr float LOG2E = 1.4426950408889634f;
constexpr int NWAVES = 8;

constexpr size_t MiB = 1u << 20;
constexpr size_t WS_CTL = 0, CTL_ZERO_BYTES = 1 * MiB;
constexpr size_t CTL_TOKCNT0 = 262144, CTL_TOKCNT1 = 393216, CTL_BAR = 524288;
constexpr size_t WS_MOD = 1 * MiB;
constexpr size_t WS_AFF = 2 * MiB;
constexpr size_t WS_IDX = 4 * MiB;
constexpr size_t WS_TOKLIST = 5 * MiB;
constexpr size_t WS_WSB = 9 * MiB;
constexpr size_t WS_WIN0 = 10 * MiB, WS_WOUT0 = 30 * MiB, WS_WCIN = 38 * MiB, WS_WCOUT = 62 * MiB;
constexpr size_t WS_GU = 70 * MiB;
constexpr size_t WS_DN = 326 * MiB;
constexpr size_t WS_H = 454 * MiB;
constexpr size_t WS_R2 = 584 * MiB;
constexpr size_t WS_R3 = 968 * MiB;
constexpr size_t WS_H8 = 1224 * MiB;
constexpr size_t WS_END = 1289 * MiB;
constexpr size_t WS_WIN0F8 = WS_WIN0 + 8 * MiB;
constexpr size_t WS_XLB = WS_R2 + 256 * MiB;
constexpr size_t WS_HID = WS_R2 + 128 * MiB;
static_assert(MK_FP8_L0 && MK_FP8_L1, "the workspace map assumes fp8 MoE activations");
constexpr size_t R2_T = (size_t)MTOT * 1024;

constexpr int LDS_SCR = 0;
constexpr int LDSCTL_OFF = 146944, MISC_OFF = LDSCTL_OFF;
constexpr int LDS_KPART = 131072;
constexpr int LDS_GTBL = 138752;
constexpr int LDS_BYTES = 147456;

#define GAS __attribute__((address_space(1)))
#define LAS __attribute__((address_space(3)))
#define DI __device__ __forceinline__
typedef unsigned short bf16;
typedef unsigned v4u __attribute__((ext_vector_type(4)));
typedef unsigned v2u __attribute__((ext_vector_type(2)));
typedef float f32x4 __attribute__((ext_vector_type(4)));
typedef float f32x16 __attribute__((ext_vector_type(16)));
typedef short bf16x8 __attribute__((ext_vector_type(8)));
typedef short s16x4 __attribute__((ext_vector_type(4)));
typedef GAS unsigned gu32;
#define RLX_AGENT __ATOMIC_RELAXED, __HIP_MEMORY_SCOPE_AGENT
#define LDS_WAIT() asm volatile("s_waitcnt lgkmcnt(0)" ::: "memory")
#define VM_WAIT() asm volatile("s_waitcnt vmcnt(0)" ::: "memory")
DI float bf_lo(unsigned u) { return __uint_as_float(u << 16); }
DI float bf_hi(unsigned u) { return __uint_as_float(u & 0xffff0000u); }
DI unsigned pk2(float lo, float hi) { return pg8::cvt_pk_bf16(lo, hi); }
constexpr float F8_WSCALE = 64.0f, F8_WINV = 1.0f / 64.0f;
DI float clamp448(float x) { return __builtin_amdgcn_fmed3f(x, -448.0f, 448.0f); }
DI unsigned pk4_fp8(float a, float b, float c, float d) { int p = __builtin_amdgcn_cvt_pk_fp8_f32(clamp448(a), clamp448(b), 0, false); p = __builtin_amdgcn_cvt_pk_fp8_f32(clamp448(c), clamp448(d), p, true); return (unsigned)p; }
DI float wave_sum(float v) {
#pragma unroll
    for (int o = 1; o < 64; o <<= 1) v += __shfl_xor(v, o);
    return v;
}
DI int wave_sum_i(int v) {
#pragma unroll
    for (int o = 1; o < 64; o <<= 1) v += __shfl_xor(v, o);
    return v;
}
DI float fast_rcp(float x) { return __builtin_amdgcn_rcpf(x); }
DI float fast_exp2(float x) { return __builtin_amdgcn_exp2f(x); }
DI float sigmoidf_(float z) { return fast_rcp(1.0f + fast_exp2(-z * LOG2E)); }
DI float gelu_tanh(float x) { const float z = 1.5957691216057308f * (x + 0.044715f * x * x * x); return x * sigmoidf_(z); }
DI float siluf_(float x) { return x * sigmoidf_(x); }

#define XB_TMO      128
#define XB_XCNT(j)  (256  + 64 * (j))
#define XB_XSUB(j)  (1280 + 64 * (j))
#define XB_XGEN(j)  (2304 + 64 * (j))
#define XB_TOP      3328
#define XB_TOPGEN   3392
#define XCD_BAR_WORDS 3456
#define XB_SPIN_CAP (1u << 18)

__device__ __forceinline__ unsigned xb_ld(unsigned* p)              { return __hip_atomic_load(p, __ATOMIC_RELAXED, __HIP_MEMORY_SCOPE_AGENT); }
__device__ __forceinline__ unsigned xb_add(unsigned* p, unsigned v) { return __hip_atomic_fetch_add(p, v, __ATOMIC_RELAXED, __HIP_MEMORY_SCOPE_AGENT); }
__device__ __forceinline__ unsigned xb_xcc_id() { return (unsigned)__builtin_amdgcn_s_getreg((3 << 11) | 20) & 0xFu; }
#define XB_SPIN(cond, bar) do { unsigned _sp = 0; while (cond) { __builtin_amdgcn_s_sleep(1); \
    if ((++_sp & 255u) == 0u) { if (xb_ld(&(bar)[XB_TMO])) break; if (_sp > XB_SPIN_CAP) { atomicAdd(&(bar)[XB_TMO], 1u); break; } } } } while (0)

struct XcdBarrier {
    unsigned* bar; unsigned x;
    volatile LAS unsigned* st;
};
__device__ __forceinline__ XcdBarrier xcd_barrier_post(unsigned* bar, volatile LAS unsigned* st) {
    XcdBarrier b; b.bar = bar; b.x = xb_xcc_id(); b.st = st;
    if (threadIdx.x == 0) (void)xb_add(&bar[XB_XCNT(b.x)], 1u);
    return b;
}
__device__ __forceinline__ void xcd_barrier_complete(unsigned* bar, unsigned x, unsigned& nloc, unsigned& nx) {
    const unsigned G = gridDim.x * gridDim.y * gridDim.z;
    unsigned sum, cnt, mine, sp = 0u;
    for (;;) {
        sum = 0u; cnt = 0u; mine = 0u;
#pragma unroll
        for (unsigned j = 0; j < 16; ++j) { const unsigned c = xb_ld(&bar[XB_XCNT(j)]); sum += c; cnt += (c > 0u) ? 1u : 0u; mine = (j == x) ? c : mine; }
        if (sum == G) break;
        __builtin_amdgcn_s_sleep(1);
        if ((++sp & 255u) == 0u) { if (xb_ld(&bar[XB_TMO])) break; if (sp > XB_SPIN_CAP) { atomicAdd(&bar[XB_TMO], 1u); break; } }
    }
    nloc = mine > 0u ? mine : 1u; nx = cnt > 0u ? cnt : 1u;
}
__device__ __forceinline__ void xcd_barrier(const XcdBarrier& b) {
    asm volatile("s_waitcnt vmcnt(0)" ::: "memory");
    __syncthreads();
    if (threadIdx.x == 0) {
        unsigned* bar = b.bar;
        __builtin_amdgcn_s_waitcnt(0);
        unsigned nloc = b.st[0], nx = b.st[1];
        if (nloc == 0u) { xcd_barrier_complete(bar, b.x, nloc, nx); b.st[0] = nloc; b.st[1] = nx; }
        const unsigned old = xb_add(&bar[XB_XSUB(b.x)], 1u);
        const unsigned gen = old / nloc;
        if (old + 1u == (gen + 1u) * nloc) {
            __builtin_amdgcn_fence(__ATOMIC_RELEASE, "agent");
            asm volatile("s_waitcnt vmcnt(0)" ::: "memory");
            const unsigned og = xb_add(&bar[XB_TOP], 1u);
            const unsigned tg = og / nx;
            if (og + 1u == (tg + 1u) * nx) xb_add(&bar[XB_TOPGEN], 1u);
            else XB_SPIN(xb_ld(&bar[XB_TOPGEN]) == tg, bar);
            __builtin_amdgcn_fence(__ATOMIC_ACQUIRE, "agent");
            xb_add(&bar[XB_XGEN(b.x)], 1u);
            asm volatile("s_waitcnt vmcnt(0)" ::: "memory");
        } else {
            XB_SPIN(xb_ld(&bar[XB_XGEN(b.x)]) == gen, bar);
            __builtin_amdgcn_fence(__ATOMIC_ACQUIRE, "agent");
            asm volatile("s_waitcnt vmcnt(0)" ::: "memory");
        }
    }
    __syncthreads();
}

using pg8::Unit; using pg8::BM; using pg8::HALF;
struct EpiIn0 {
    static constexpr int PERM = 2;
    bf16* O; int tbase; float sc; const float* gk; LAS float* part;
    DI void operator()(const f32x4 (&acc)[2][2][4][2], const Unit& u, int wr, int wc, int fr, int fq) const {
        const int row0 = u.pm * BM + wr * 64 + fr; const int t = tbase + (u.pn >> 2); const int colt = (u.pn & 3) * BM;
        bf16* base = O + (size_t)t * R2_T; const int col0 = colt + wc * 64 + 8 * fq; const bool act = t < 2;
        if (t == 3) {
            float ssv[2][4];
#pragma unroll
            for (int ai = 0; ai < 2; ++ai)
#pragma unroll
                for (int m = 0; m < 4; ++m) { float q = 0.f;
#pragma unroll
                    for (int bj = 0; bj < 2; ++bj)
#pragma unroll
                        for (int n = 0; n < 2; ++n) { const f32x4 v = acc[ai][bj][m][n] * sc; q += (v[0] * v[0] + v[1] * v[1]) + (v[2] * v[2] + v[3] * v[3]); }
                    q += __shfl_xor(q, 16); q += __shfl_xor(q, 32); ssv[ai][m] = q;
                    if (fq == 0) part[(ai * HALF + wr * 64 + m * 16 + fr) * 4 + wc] = q; }
            asm volatile("s_waitcnt lgkmcnt(0)" ::: "memory"); __builtin_amdgcn_s_barrier(); asm volatile("" ::: "memory");
            f32x4 gv[2][2];
#pragma unroll
            for (int bj = 0; bj < 2; ++bj)
#pragma unroll
                for (int n = 0; n < 2; ++n) gv[bj][n] = *(const f32x4*)(gk + 64 * (wc & 1) + 32 * bj + 8 * fq + 4 * n);
#pragma unroll
            for (int ai = 0; ai < 2; ++ai)
#pragma unroll
                for (int m = 0; m < 4; ++m) { const float tot = ssv[ai][m] + part[(ai * HALF + wr * 64 + m * 16 + fr) * 4 + (wc ^ 1)];
                    const float rstd = 1.0f / sqrtf(tot * (1.0f / 128.0f) + EPS);
                    bf16* rowp = base + (size_t)(row0 + ai * HALF + m * 16) * 1024 + col0;
#pragma unroll
                    for (int bj = 0; bj < 2; ++bj) { const f32x4 v0 = acc[ai][bj][m][0] * (sc * rstd) * gv[bj][0], v1 = acc[ai][bj][m][1] * (sc * rstd) * gv[bj][1];
                        v4u w; w.x = pk2(v0[0], v0[1]); w.y = pk2(v0[2], v0[3]); w.z = pk2(v1[0], v1[1]); w.w = pk2(v1[2], v1[3]);
                        *(v4u*)(rowp + bj * 32) = w; } }
            return;
        }
#pragma unroll
        for (int ai = 0; ai < 2; ++ai)
#pragma unroll
            for (int m = 0; m < 4; ++m) { bf16* rowp = base + (size_t)(row0 + ai * HALF + m * 16) * 1024 + col0;
#pragma unroll
                for (int bj = 0; bj < 2; ++bj) { f32x4 v0 = acc[ai][bj][m][0] * sc, v1 = acc[ai][bj][m][1] * sc;
                    if (act) {
#pragma unroll
                        for (int j = 0; j < 4; ++j) { v0[j] = gelu_tanh(v0[j]); v1[j] = gelu_tanh(v1[j]); } }
                    v4u w; w.x = pk2(v0[0], v0[1]); w.y = pk2(v0[2], v0[3]); w.z = pk2(v1[0], v1[1]); w.w = pk2(v1[2], v1[3]);
                    *(v4u*)(rowp + bj * 32) = w; } }
    }
};
struct OneUnit {
    int pm, pn;
    __device__ __forceinline__ bool next(int i, Unit& u) const { if (i != 0) return false; u.pm = pm; u.pn = pn; u.pb = pn; return true; }
    DI void a_ready(const Unit&) const {}
    DI void done(const Unit&) const {}
};
template <bool BASE_F32>
struct EpiResid {
    static constexpr int PERM = 2;
    const void* base; bf16* out; const float* gate0;
    DI void operator()(const f32x4 (&acc)[2][2][4][2], const Unit& u, int wr, int wc, int fr, int fq) const {
        const int row0 = u.pm * BM + wr * 64 + fr, col0 = u.pn * BM + wc * 64 + 8 * fq;
        const float* gate = gate0 + (size_t)((u.pm * BM) >> 14) * 12288;
        f32x4 gv[2][2];
#pragma unroll
        for (int bj = 0; bj < 2; ++bj)
#pragma unroll
            for (int n = 0; n < 2; ++n) gv[bj][n] = *(const f32x4*)(gate + col0 + bj * 32 + n * 4);
#pragma unroll
        for (int ai = 0; ai < 2; ++ai)
#pragma unroll
            for (int m = 0; m < 4; ++m) { const size_t off = (size_t)(row0 + ai * HALF + m * 16) * D + col0;
#pragma unroll
                for (int bj = 0; bj < 2; ++bj) { f32x4 b0, b1;
                    if constexpr (BASE_F32) { b0 = __builtin_nontemporal_load((const f32x4*)((const float*)base + off + bj * 32)); b1 = __builtin_nontemporal_load((const f32x4*)((const float*)base + off + bj * 32 + 4)); }
                    else { const v4u w = *(const v4u*)((const bf16*)base + off + bj * 32); b0 = (f32x4){bf_lo(w.x), bf_hi(w.x), bf_lo(w.y), bf_hi(w.y)}; b1 = (f32x4){bf_lo(w.z), bf_hi(w.z), bf_lo(w.w), bf_hi(w.w)}; }
                    const f32x4 v0 = b0 + gv[bj][0] * acc[ai][bj][m][0], v1 = b1 + gv[bj][1] * acc[ai][bj][m][1];
                    v4u o; o.x = pk2(v0[0], v0[1]); o.y = pk2(v0[2], v0[3]); o.z = pk2(v1[0], v1[1]); o.w = pk2(v1[2], v1[3]);
                    *(v4u*)(out + off + bj * 32) = o; } }
    }
};
template <bool F8>
struct EpiSwiglu {
    static constexpr int PERM = 1;
    void* O;
    DI void operator()(const f32x4 (&acc)[2][2][4][2], const Unit& u, int wr, int wc, int fr, int fq) const {
        const int row0 = u.pm * BM + wr * 64 + fr, col0 = u.pn * HALF + wc * 32 + 8 * fq;
        const float sc = F8 ? F8_WINV : 1.0f;
        if constexpr (F8) {
            const int colw = u.pn * HALF + wc * 32 + 8 * (fq & ~1);
#pragma unroll
            for (int ai = 0; ai < 2; ++ai)
#pragma unroll
                for (int mp = 0; mp < 2; ++mp) { v2u w[2];
#pragma unroll
                    for (int x = 0; x < 2; ++x) { const int m = 2 * mp + x;
                        f32x4 g0 = acc[ai][0][m][0] * sc, g1 = acc[ai][0][m][1] * sc; const f32x4 u0 = acc[ai][1][m][0] * sc, u1 = acc[ai][1][m][1] * sc;
#pragma unroll
                        for (int j = 0; j < 4; ++j) { g0[j] = siluf_(g0[j]) * u0[j]; g1[j] = siluf_(g1[j]) * u1[j]; }
                        w[x].x = pk4_fp8(g0[0], g0[1], g0[2], g0[3]); w[x].y = pk4_fp8(g1[0], g1[1], g1[2], g1[3]); }
                    const auto rx = __builtin_amdgcn_permlane16_swap(w[0].x, w[1].x, false, false); const auto ry = __builtin_amdgcn_permlane16_swap(w[0].y, w[1].y, false, false);
                    v4u o; o.x = rx[0]; o.y = ry[0]; o.z = rx[1]; o.w = ry[1];
                    *(v4u*)((unsigned char*)O + (size_t)(row0 + ai * HALF + (2 * mp + (fq & 1)) * 16) * FF + colw) = o; }
            return;
        }
#pragma unroll
        for (int ai = 0; ai < 2; ++ai)
#pragma unroll
            for (int m = 0; m < 4; ++m) { const size_t eo = (size_t)(row0 + ai * HALF + m * 16) * FF + col0;
                f32x4 g0 = acc[ai][0][m][0] * sc, g1 = acc[ai][0][m][1] * sc; const f32x4 u0 = acc[ai][1][m][0] * sc, u1 = acc[ai][1][m][1] * sc;
#pragma unroll
                for (int j = 0; j < 4; ++j) { g0[j] = siluf_(g0[j]) * u0[j]; g1[j] = siluf_(g1[j]) * u1[j]; }
                { v4u w; w.x = pk2(g0[0], g0[1]); w.y = pk2(g0[2], g0[3]); w.z = pk2(g1[0], g1[1]); w.w = pk2(g1[2], g1[3]); *(v4u*)((bf16*)O + eo) = w; } }
    }
};
struct EpiPlain {
    static constexpr int PERM = 2;
    unsigned char* O; int ldc; float sc; int nostore;
    DI void operator()(const f32x4 (&acc)[2][2][4][2], const Unit& u, int wr, int wc, int fr, int fq) const {
        if (nostore == 1) return;
        const int row0 = u.pm * BM + wr * 64 + fr, col0 = u.pn * BM + wc * 64 + ((fq & 1) ? 24 + 8 * fq : 8 * fq);
#pragma unroll
        for (int ai = 0; ai < 2; ++ai)
#pragma unroll
            for (int m = 0; m < 4; ++m) { unsigned char* rowp = O + (size_t)(row0 + ai * HALF + m * 16) * ldc + col0;
                v2u w[2];
#pragma unroll
                for (int bj = 0; bj < 2; ++bj) { const f32x4 v0 = acc[ai][bj][m][0] * sc, v1 = acc[ai][bj][m][1] * sc;
                    w[bj].x = pk4_fp8(v0[0], v0[1], v0[2], v0[3]); w[bj].y = pk4_fp8(v1[0], v1[1], v1[2], v1[3]); }
                const auto rx = __builtin_amdgcn_permlane16_swap(w[0].x, w[1].x, false, false); const auto ry = __builtin_amdgcn_permlane16_swap(w[0].y, w[1].y, false, false);
                v4u o; o.x = rx[0]; o.y = ry[0]; o.z = rx[1]; o.w = ry[1];
                __builtin_nontemporal_store(o, (v4u*)rowp); }
    }
};
struct EpiCin {
    static constexpr int PERM = 1;
    bf16* BG; bf16* CZ; int nostore;
    DI void operator()(const f32x4 (&acc)[2][2][4][2], const Unit& u, int wr, int wc, int fr, int fq) const {
        if (nostore) return;
        const int row0 = u.pm * BM + wr * 64 + fr;
        if (u.pn < 8) {
            const int col0 = u.pn * BM + wc * 32 + 8 * fq;
#pragma unroll
            for (int ai = 0; ai < 2; ++ai)
#pragma unroll
                for (int m = 0; m < 4; ++m) { bf16* rowp = BG + (size_t)(row0 + ai * HALF + m * 16) * D + col0;
#pragma unroll
                    for (int bj = 0; bj < 2; ++bj) { const f32x4 v0 = acc[ai][bj][m][0], v1 = acc[ai][bj][m][1];
                        v4u w; w.x = pk2(v0[0], v0[1]); w.y = pk2(v0[2], v0[3]); w.z = pk2(v1[0], v1[1]); w.w = pk2(v1[2], v1[3]);
                        *(v4u*)(rowp + bj * HALF) = w; } }
        } else {
            const int col0 = (u.pn - 8) * HALF + wc * 32 + 8 * fq;
#pragma unroll
            for (int ai = 0; ai < 2; ++ai)
#pragma unroll
                for (int m = 0; m < 4; ++m) { bf16* rowp = CZ + (size_t)(row0 + ai * HALF + m * 16) * D + col0;
                    const f32x4 p0 = acc[ai][0][m][0] * acc[ai][1][m][0], p1 = acc[ai][0][m][1] * acc[ai][1][m][1];
                    v4u w; w.x = pk2(p0[0], p0[1]); w.y = pk2(p0[2], p0[3]); w.z = pk2(p1[0], p1[1]); w.w = pk2(p1[2], p1[3]);
                    *(v4u*)rowp = w; }
        }
    }
};

DI unsigned off_b(unsigned row, unsigned ch) { return 256u * row + 16u * (ch ^ (((row & 3) << 2) | ((row >> 2) & 3))); }
DI bf16x8 row_frag(const LAS unsigned char* img, int lane, int s) { return *(const LAS bf16x8*)(img + off_b(lane & 31, 2 * s + (lane >> 5))); }
template <bool KROW>
DI bf16x8 tr_frag(const LAS unsigned char* img, int lane, int c, int ks) {
    const unsigned h = lane >> 5, blk = (lane >> 4) & 1, q = (lane & 15) >> 2, p = lane & 3;
    const unsigned r0 = KROW ? (16 * ks + 4 * h + q) : (16 * ks + 8 * h + q), r1 = KROW ? (r0 + 8) : (r0 + 4);
    const unsigned ch = 4 * c + 2 * blk + (p >> 1), sub = 8 * (p & 1);
    const s16x4 lo = __builtin_amdgcn_ds_read_tr16_b64_v4i16((LAS s16x4*)(img + off_b(r0, ch) + sub));
    const s16x4 hi = __builtin_amdgcn_ds_read_tr16_b64_v4i16((LAS s16x4*)(img + off_b(r1, ch) + sub));
    return __builtin_shufflevector(lo, hi, 0, 1, 2, 3, 4, 5, 6, 7);
}
DI void tr_frag4_krow(bf16x8 (&a)[4], const LAS unsigned char* img, int lane, int ks) {
    const unsigned h = lane >> 5, blk = (lane >> 4) & 1, q = (lane & 15) >> 2, p = lane & 3;
    const unsigned r0 = 16 * ks + 4 * h + q, r1 = r0 + 8, sub = 8 * (p & 1);
    const unsigned base = (unsigned)(unsigned long)img;
    unsigned al[4], ah[4];
#pragma unroll
    for (int c = 0; c < 4; ++c) { const unsigned ch = 4 * c + 2 * blk + (p >> 1); al[c] = base + off_b(r0, ch) + sub; ah[c] = base + off_b(r1, ch) + sub; }
    s16x4 l0, l1, l2, l3, h0, h1, h2, h3;
    asm volatile("ds_read_b64_tr_b16 %0, %8\n\tds_read_b64_tr_b16 %1, %9\n\tds_read_b64_tr_b16 %2, %10\n\tds_read_b64_tr_b16 %3, %11\n\t"
                 "ds_read_b64_tr_b16 %4, %12\n\tds_read_b64_tr_b16 %5, %13\n\tds_read_b64_tr_b16 %6, %14\n\tds_read_b64_tr_b16 %7, %15\n\ts_waitcnt lgkmcnt(0)"
                 : "=&v"(l0), "=&v"(l1), "=&v"(l2), "=&v"(l3), "=&v"(h0), "=&v"(h1), "=&v"(h2), "=&v"(h3)
                 : "v"(al[0]), "v"(al[1]), "v"(al[2]), "v"(al[3]), "v"(ah[0]), "v"(ah[1]), "v"(ah[2]), "v"(ah[3]) : "memory");
    a[0] = __builtin_shufflevector(l0, h0, 0, 1, 2, 3, 4, 5, 6, 7); a[1] = __builtin_shufflevector(l1, h1, 0, 1, 2, 3, 4, 5, 6, 7);
    a[2] = __builtin_shufflevector(l2, h2, 0, 1, 2, 3, 4, 5, 6, 7); a[3] = __builtin_shufflevector(l3, h3, 0, 1, 2, 3, 4, 5, 6, 7);
}
template <int OFF>
DI void tr_frag4_pre(bf16x8 (&a)[4], const unsigned (&al)[4], const unsigned (&ah)[4]) {
    s16x4 l0, l1, l2, l3, h0, h1, h2, h3;
    asm volatile("ds_read_b64_tr_b16 %0, %8 offset:%16\n\tds_read_b64_tr_b16 %1, %9 offset:%16\n\tds_read_b64_tr_b16 %2, %10 offset:%16\n\tds_read_b64_tr_b16 %3, %11 offset:%16\n\t"
                 "ds_read_b64_tr_b16 %4, %12 offset:%16\n\tds_read_b64_tr_b16 %5, %13 offset:%16\n\tds_read_b64_tr_b16 %6, %14 offset:%16\n\tds_read_b64_tr_b16 %7, %15 offset:%16\n\ts_waitcnt lgkmcnt(0)"
                 : "=&v"(l0), "=&v"(l1), "=&v"(l2), "=&v"(l3), "=&v"(h0), "=&v"(h1), "=&v"(h2), "=&v"(h3)
                 : "v"(al[0]), "v"(al[1]), "v"(al[2]), "v"(al[3]), "v"(ah[0]), "v"(ah[1]), "v"(ah[2]), "v"(ah[3]), "n"(OFF) : "memory");
    a[0] = __builtin_shufflevector(l0, h0, 0, 1, 2, 3, 4, 5, 6, 7); a[1] = __builtin_shufflevector(l1, h1, 0, 1, 2, 3, 4, 5, 6, 7);
    a[2] = __builtin_shufflevector(l2, h2, 0, 1, 2, 3, 4, 5, 6, 7); a[3] = __builtin_shufflevector(l3, h3, 0, 1, 2, 3, 4, 5, 6, 7);
}
DI int crow(int reg, int h) { return (reg & 3) + 8 * (reg >> 2) + 4 * h; }
#define MFMA32(a, b, c) __builtin_amdgcn_mfma_f32_32x32x16_bf16((a), (b), (c), 0, 0, 0)

struct Params { const float* in[23]; float* out; unsigned char* ws; int ph_lo, ph_hi, li, pad; };
typedef const __attribute__((address_space(4))) Params* KP;
DI KP kparams() { KP p = (KP)__builtin_amdgcn_kernarg_segment_ptr(); asm volatile("" : "+s"(p)); return p; }
enum { I_X = 0, I_C, I_CTX, I_CCTX, I_ADAW, I_ADAB, I_N1G, I_N2G, I_ABWIN, I_ABWOUT, I_AWS, I_ABS, I_AVG, I_BQG, I_BKG, I_RPB, I_CWIN, I_CONVW, I_CWOUT, I_ROUTER, I_WGATE, I_WUP, I_WDOWN };

struct XItem { const float* src; unsigned char* dst; int N, Kd, k0, dstrow0, f8; };
DI void xpose_load(const XItem& d, f32x4 (&v)[16], int lane) {
    const GAS f32x4* src = (const GAS f32x4*)d.src; const int lr = lane >> 4, lc = lane & 15;
#pragma unroll
    for (int i = 0; i < 16; ++i) v[i] = __builtin_nontemporal_load(src + (size_t)(lr + 4 * i) * (d.N / 4) + lc);
}
DI void xpose_store(const XItem& d, const f32x4 (&v)[16], LAS float* scr, int lane) {
    const int lr = lane >> 4, lc = lane & 15;
#pragma unroll
    for (int i = 0; i < 16; ++i) { LAS float* p = scr + (lr + 4 * i) * 65 + 4 * lc; p[0] = v[i].x; p[1] = v[i].y; p[2] = v[i].z; p[3] = v[i].w; }
    LDS_WAIT(); asm volatile("" ::: "memory");
    if (d.f8) {
        const int c = lane & 3;
#pragma unroll
        for (int i = 0; i < 4; ++i) { const int n = 16 * i + (lane >> 2); const LAS float* s = scr + (16 * c) * 65 + n;
            v4u o;
            o.x = pk4_fp8(s[0 * 65] * F8_WSCALE, s[1 * 65] * F8_WSCALE, s[2 * 65] * F8_WSCALE, s[3 * 65] * F8_WSCALE); o.y = pk4_fp8(s[4 * 65] * F8_WSCALE, s[5 * 65] * F8_WSCALE, s[6 * 65] * F8_WSCALE, s[7 * 65] * F8_WSCALE);
            o.z = pk4_fp8(s[8 * 65] * F8_WSCALE, s[9 * 65] * F8_WSCALE, s[10 * 65] * F8_WSCALE, s[11 * 65] * F8_WSCALE); o.w = pk4_fp8(s[12 * 65] * F8_WSCALE, s[13 * 65] * F8_WSCALE, s[14 * 65] * F8_WSCALE, s[15 * 65] * F8_WSCALE);
            *(GAS v4u*)(d.dst + (size_t)(d.dstrow0 + n) * d.Kd + d.k0 + 16 * c) = o; }
    } else {
        const int c = lane & 7;
#pragma unroll
        for (int i = 0; i < 8; ++i) { const int n = 8 * i + (lane >> 3); const LAS float* s = scr + (8 * c) * 65 + n;
            v4u o; o.x = pk2(s[0 * 65], s[1 * 65]); o.y = pk2(s[2 * 65], s[3 * 65]); o.z = pk2(s[4 * 65], s[5 * 65]); o.w = pk2(s[6 * 65], s[7 * 65]);
            *(GAS v4u*)((bf16*)d.dst + (size_t)(d.dstrow0 + n) * d.Kd + d.k0 + 8 * c) = o; }
    }
    LDS_WAIT(); asm volatile("" ::: "memory");
}
DI int ilv_row(int j, int hv) { return ((j >> 7) << 8) + hv * 128 + (j & 127); }

#define F8L(l) ((l) == 0 ? (MK_FP8_L0 != 0) : (MK_FP8_L1 != 0))
DI void xpose_range(KP P, LAS unsigned char* lds, int lane, int wave, int mode, int w, int nw) {
    unsigned char* ws = P->ws;
    LAS float* scr = (LAS float*)(lds + LDS_SCR + wave * 16640);
    constexpr int I0 = 32 * 80, I1 = 32 * 32, I2 = 32 * 96, I3 = 32 * 32, IM = 512, I4 = 32 * IM, IB = I0 + I1 + I2 + I3, IH = I4 / 2;
    const int nlist = mode == 0 ? IB : ((mode == 4 || mode == 3) ? 3 * IH : (3 * IH) / 2);
    auto item_id = [&](int j) -> int {
        if (mode == 0) return j;
        if (mode == 4) return IB + (j / IH) * I4 + (j % IH);
        if (mode == 3) return IB + (j / IH) * I4 + IH + (j % IH);
        const int q = j + (mode == 2 ? (3 * IH) / 2 : 0); return IB + (q / IH) * I4 + IH + (q % IH);
    };
    auto decode = [&](int it, XItem& d) {
        int r = it;
        if (r < I0) { const int kb = r / 80, nb = r % 80; const bool f8 = nb >= 32;
            d = XItem{P->in[I_ABWIN] + (size_t)(kb * 64) * 5120 + nb * 64, f8 ? ws + WS_WIN0F8 : ws + WS_WIN0, 5120, 2048, kb * 64, f8 ? nb * 64 - 2048 : nb * 64, f8 ? 1 : 0}; return; } r -= I0;
        if (r < I1) { const int kb = r / 32, nb = r % 32; d = XItem{P->in[I_ABWOUT] + (size_t)(kb * 64) * 2048 + nb * 64, ws + WS_WOUT0, 2048, 2048, kb * 64, nb * 64, 0}; return; } r -= I1;
        if (r < I2) { const int kb = r / 96, nb = r % 96; const int n0 = nb * 64;
            const int drow = n0 < 2048 ? n0 : (n0 < 4096 ? 2048 + ilv_row(n0 - 2048, 0) : 2048 + ilv_row(n0 - 4096, 1));
            d = XItem{P->in[I_CWIN] + (size_t)(kb * 64) * 6144 + n0, ws + WS_WCIN, 6144, 2048, kb * 64, drow, 0}; return; } r -= I2;
        if (r < I3) { const int kb = r / 32, nb = r % 32; d = XItem{P->in[I_CWOUT] + (size_t)(kb * 64) * 2048 + nb * 64, ws + WS_WCOUT, 2048, 2048, kb * 64, nb * 64, 0}; return; } r -= I3;
        if (r < 2 * I4) { const bool up = r >= I4; if (up) r -= I4; const int mt = r / IM, q = r % IM, kb = q / 16, nb = q % 16;
            d = XItem{(up ? P->in[I_WUP] : P->in[I_WGATE]) + (size_t)mt * 2048 * 1024 + (size_t)(kb * 64) * 1024 + nb * 64,
                      ws + WS_GU + (size_t)(mt >> 4) * 16 * 2048 * 2048 * 2 + (size_t)(mt & 15) * 2048 * 2048, 1024, 2048, kb * 64, ilv_row(nb * 64, up ? 1 : 0), 1}; return; } r -= 2 * I4;
        { const int mt = r / IM, q = r % IM, kb = q / 32, nb = q % 32;
            d = XItem{P->in[I_WDOWN] + (size_t)mt * 1024 * 2048 + (size_t)(kb * 64) * 2048 + nb * 64,
                      ws + WS_DN + (size_t)(mt >> 4) * 16 * 2048 * 1024 * 2 + (size_t)(mt & 15) * 2048 * 1024, 2048, 1024, kb * 64, nb * 64, 1}; }
    };
    f32x4 va[16], vb[16]; XItem da, db;
    int it = w;
    if (it < nlist) { decode(item_id(it), da); xpose_load(da, va, lane); }
    while (it < nlist) {
        const int it1 = it + nw; if (it1 < nlist) { decode(item_id(it1), db); xpose_load(db, vb, lane); }
        xpose_store(da, va, scr, lane);
        if (it1 >= nlist) break;
        const int it2 = it1 + nw; if (it2 < nlist) { decode(item_id(it2), da); xpose_load(da, va, lane); }
        xpose_store(db, vb, scr, lane);
        it = it2;
    }
}

DI void phase_prologue(KP P, LAS unsigned char* lds, int tid, int lane, int wave) {
    unsigned char* ws = P->ws;
    for (int u = blockIdx.x; u < 192; u += gridDim.x) {
        const int l = u / 96, cb = u % 96;
        LAS float* sv = (LAS float*)(lds + LDS_SCR);
        LAS float* part = (LAS float*)(lds + LDS_SCR + 24576);
        for (int i = tid; i < 3 * 2048; i += 512) { const int r = i >> 11, k = i & 2047; const float c = r < 2 ? P->in[I_C][r * 2048 + k] : P->in[I_CCTX][k]; sv[i] = c / (1.0f + __expf(-c)); }
        __syncthreads();
        const int col4 = tid & 31, ks = tid >> 5;
        const GAS f32x4* w = (const GAS f32x4*)(P->in[I_ADAW] + (size_t)l * 2048 * 12288 + (size_t)(ks * 128) * 12288 + cb * 128) + col4;
        f32x4 a0 = {0.f, 0.f, 0.f, 0.f}, a1 = a0, a2 = a0;
#pragma unroll 8
        for (int k = 0; k < 128; ++k) { const f32x4 wv = __builtin_nontemporal_load(w + (size_t)k * (12288 / 4)); const int kk = ks * 128 + k;
            a0 += wv * sv[kk]; a1 += wv * sv[2048 + kk]; a2 += wv * sv[4096 + kk]; }
        *(LAS f32x4*)(part + (ks * 3 + 0) * 128 + 4 * col4) = a0; *(LAS f32x4*)(part + (ks * 3 + 1) * 128 + 4 * col4) = a1; *(LAS f32x4*)(part + (ks * 3 + 2) * 128 + 4 * col4) = a2;
        __syncthreads();
        if (tid < 384) { const int r = tid >> 7, cc = tid & 127; float s = P->in[I_ADAB][l * 12288 + cb * 128 + cc];
#pragma unroll
            for (int q = 0; q < 16; ++q) s += part[(q * 3 + r) * 128 + cc];
            ((float*)(ws + WS_MOD))[(size_t)(l * 3 + r) * 12288 + cb * 128 + cc] = s; }
        __syncthreads();
    }
    { const float* src = P->in[I_AWS]; bf16* dst = (bf16*)(ws + WS_WSB);
      for (int i = blockIdx.x * 512 + tid; i < 8 * 128 * 128 / 2; i += gridDim.x * 512) { const float a = src[2 * i], b = src[2 * i + 1]; ((unsigned*)dst)[i] = pk2(a, b); } }
    xpose_range(P, lds, lane, wave, 0, blockIdx.x * NWAVES + wave, gridDim.x * NWAVES);
}


DI void norm_mod_row(f32x4 (&v)[8], const float* __restrict__ g, const float* __restrict__ shift, const float* __restrict__ scale, int lane) {
    float ss = 0.f;
#pragma unroll
    for (int j = 0; j < 8; ++j) ss += (v[j].x * v[j].x + v[j].y * v[j].y) + (v[j].z * v[j].z + v[j].w * v[j].w);
    const float rstd = 1.0f / sqrtf(wave_sum(ss) * (1.0f / D) + EPS);
#pragma unroll
    for (int j = 0; j < 8; ++j) { const int c = 256 * j + 4 * lane; const f32x4 gg = *(const f32x4*)(g + c), sc = *(const f32x4*)(scale + c), sh = *(const f32x4*)(shift + c);
        v[j] = (v[j] * rstd * gg) * (1.0f + sc) + sh; }
}
DI void store_row_bf16(bf16* __restrict__ orow, const f32x4 (&v)[8], int lane) {
    GAS v2u* o = (GAS v2u*)orow + lane;
#pragma unroll
    for (int j = 0; j < 8; ++j) { v2u w; w.x = pk2(v[j].x, v[j].y); w.y = pk2(v[j].z, v[j].w); o[64 * j] = w; }
}
DI void store_row_fp8(unsigned char* __restrict__ orow, const f32x4 (&v)[8], int lane) {
    GAS unsigned* o = (GAS unsigned*)orow + lane;
#pragma unroll
    for (int j = 0; j < 8; ++j) o[64 * j] = pk4_fp8(v[j].x, v[j].y, v[j].z, v[j].w);
}
DI void load_row_bf16(f32x4 (&v)[8], const bf16* __restrict__ xrow, int lane) {
    const GAS v2u* xr = (const GAS v2u*)xrow + lane;
#pragma unroll
    for (int j = 0; j < 8; ++j) { const v2u w = xr[64 * j]; v[j] = (f32x4){bf_lo(w.x), bf_hi(w.x), bf_lo(w.y), bf_hi(w.y)}; }
}
DI void load_row_f32(f32x4 (&v)[8], const float* __restrict__ xrow, int lane) {
    const GAS f32x4* xr = (const GAS f32x4*)xrow + lane;
#pragma unroll
    for (int j = 0; j < 8; ++j) v[j] = __builtin_nontemporal_load(xr + 64 * j);
}

DI void phase_norm1_l0(KP P, LAS unsigned char* lds, int tid, int lane, int wave) {
    const float* mod = (const float*)(P->ws + WS_MOD); bf16* H = (bf16*)(P->ws + WS_H); unsigned char* H8 = P->ws + WS_H8;
    const bool ctxwg = (gridDim.x >= 64) && (blockIdx.x < 16);
    if (ctxwg) {
        const int pmc = blockIdx.x >> 3, pnc = blockIdx.x & 7;
        const float* m = mod + (size_t)2 * 12288;
        for (int rr = 2 * wave; rr < 256; rr += 2 * NWAVES) {
            f32x4 v[2][8];
#pragma unroll
            for (int q = 0; q < 2; ++q) load_row_f32(v[q], P->in[I_CTX] + (size_t)(pmc * 256 + rr + q) * D, lane);
#pragma unroll
            for (int q = 0; q < 2; ++q) { norm_mod_row(v[q], P->in[I_N1G], m + 0 * 2048, m + 1 * 2048, lane); store_row_fp8(H8 + (size_t)(NT + pmc * 256 + rr + q) * D, v[q], lane); } }
        VM_WAIT(); __syncthreads();
        __builtin_amdgcn_fence(__ATOMIC_ACQUIRE, "agent"); VM_WAIT(); __syncthreads();
        pg8::Gemm g{(const bf16*)H8, (const bf16*)(P->ws + WS_WIN0F8), MTOT, 3072, D / 2}; OneUnit S{128 + pmc, 4 + pnc};
        EpiIn0 E{(bf16*)(P->ws + WS_R2), 2, F8_WINV, P->in[I_BKG], (LAS float*)(lds + LDS_KPART)};
        pg8::gemm_phase<EpiIn0, OneUnit, true, true, true>(lds, g, S, E);
        return;
    }
    const int nskip = (gridDim.x >= 64) ? 16 : 0;
    const int gw = (blockIdx.x - nskip) * NWAVES + wave, NGW = (gridDim.x - nskip) * NWAVES;
    const int nrows = (gridDim.x >= 64) ? NT : MTOT;
    for (int row0 = 2 * gw; row0 < nrows; row0 += 2 * NGW) {
        f32x4 v[2][8];
#pragma unroll
        for (int q = 0; q < 2; ++q) { const int row = row0 + q; load_row_f32(v[q], row < NT ? P->in[I_X] + (size_t)row * D : P->in[I_CTX] + (size_t)(row - NT) * D, lane); }
        const int r = row0 < NT ? (row0 >> 14) : 2;
        const float* m = mod + (size_t)r * 12288;
#pragma unroll
        for (int q = 0; q < 2; ++q) { const int row = row0 + q;
            norm_mod_row(v[q], P->in[I_N1G], m + 0 * 2048, m + 1 * 2048, lane);
            if (row < NT) store_row_bf16(H + (size_t)row * D, v[q], lane);
            store_row_fp8(H8 + (size_t)row * D, v[q], lane); }
    }
}

DI void phase_norm2_router(KP P, int layer, LAS unsigned char* lds, int tid, int lane, int wave) {
    const float* mod = (const float*)(P->ws + WS_MOD) + (size_t)layer * 3 * 12288; unsigned char* H8 = P->ws + WS_H;
    float* AFF = (float*)(P->ws + WS_AFF); const bf16* XLB = (const bf16*)(P->ws + WS_XLB);
    LAS unsigned char* wt = lds + LDS_SCR;
    LAS unsigned char* gsL = lds + LDS_SCR + 131072;
    LAS unsigned char* shL = lds + LDS_SCR + 135168;
    LAS float* part = (LAS float*)(lds + LDS_SCR + 139264);
    const float* n2g = P->in[I_N2G] + (size_t)layer * D; const float* wr = P->in[I_ROUTER] + (size_t)layer * 2048 * 16;
    const int gw = blockIdx.x * NWAVES + wave, NGW = gridDim.x * NWAVES;
    const int i16 = lane & 15, kq = lane >> 4;
    int cur_b = -1;
    for (int rb = gw; rb < NT / 16; rb += NGW) {
        const int b = rb >> 10;
        if (b != cur_b) {
            cur_b = b; __syncthreads();
            const float* m = mod + (size_t)b * 12288; const float* sh = m + 3 * 2048; const float* sc = m + 4 * 2048;
            { const int e = tid & 15;
              for (int kc = tid >> 4; kc < 256; kc += 32) { float w[8];
#pragma unroll
                  for (int jj = 0; jj < 8; ++jj) { const int k = 8 * kc + jj; w[jj] = n2g[k] * (1.0f + sc[k]) * wr[k * 16 + e]; }
                  v4u hi, lo; unsigned h_[4], l_[4];
#pragma unroll
                  for (int q = 0; q < 4; ++q) { h_[q] = pk2(w[2 * q], w[2 * q + 1]); l_[q] = pk2(w[2 * q] - bf_lo(h_[q]), w[2 * q + 1] - bf_hi(h_[q])); }
                  hi.x = h_[0]; hi.y = h_[1]; hi.z = h_[2]; hi.w = h_[3]; lo.x = l_[0]; lo.y = l_[1]; lo.z = l_[2]; lo.w = l_[3];
                  *(LAS v4u*)(wt + ((0 * 16 + e) * 256 + (kc ^ e)) * 16) = hi; *(LAS v4u*)(wt + ((1 * 16 + e) * 256 + (kc ^ e)) * 16) = lo; }
              float pb = 0.f; const int pt = tid >> 4;
              for (int k = 64 * pt; k < 64 * pt + 64; ++k) pb += sh[k] * wr[k * 16 + e];
              part[pt * 16 + e] = pb; }
            if (tid < 256) { float a[8], c[8];
#pragma unroll
                for (int jj = 0; jj < 8; ++jj) { const int k = 8 * tid + jj; a[jj] = n2g[k] * (1.0f + sc[k]); c[jj] = sh[k]; }
                v4u ga, sa; ga.x = pk2(a[0], a[1]); ga.y = pk2(a[2], a[3]); ga.z = pk2(a[4], a[5]); ga.w = pk2(a[6], a[7]); sa.x = pk2(c[0], c[1]); sa.y = pk2(c[2], c[3]); sa.z = pk2(c[4], c[5]); sa.w = pk2(c[6], c[7]);
                *(LAS v4u*)(gsL + tid * 16) = ga; *(LAS v4u*)(shL + tid * 16) = sa; }
            __syncthreads();
            if (tid < 16) { float sacc = 0.f;
#pragma unroll 8
                for (int p = 0; p < 32; ++p) sacc += part[p * 16 + tid];
                part[512 + tid] = sacc; }
            __syncthreads();
        }
        const int row = 16 * rb + i16;
        const GAS v4u* xr = (const GAS v4u*)(XLB + (size_t)row * D) + 2 * kq;
        pg8::f32x4 acc = {0.f, 0.f, 0.f, 0.f}; float ss = 0.f;
#pragma unroll 4
        for (int t = 0; t < 32; ++t) {
            const v4u x0 = xr[8 * t], x1 = xr[8 * t + 1];
            const int c0 = 8 * t + 2 * kq;
            const bf16x8 wh0 = *(const LAS bf16x8*)(wt + ((0 * 16 + i16) * 256 + ((c0 + 0) ^ i16)) * 16), wl0 = *(const LAS bf16x8*)(wt + ((1 * 16 + i16) * 256 + ((c0 + 0) ^ i16)) * 16);
            const bf16x8 wh1 = *(const LAS bf16x8*)(wt + ((0 * 16 + i16) * 256 + ((c0 + 1) ^ i16)) * 16), wl1 = *(const LAS bf16x8*)(wt + ((1 * 16 + i16) * 256 + ((c0 + 1) ^ i16)) * 16);
            const bf16x8 a0 = __builtin_bit_cast(bf16x8, x0), a1 = __builtin_bit_cast(bf16x8, x1);
            acc = __builtin_amdgcn_mfma_f32_16x16x32_bf16(a0, wh0, acc, 0, 0, 0); acc = __builtin_amdgcn_mfma_f32_16x16x32_bf16(a0, wl0, acc, 0, 0, 0);
            acc = __builtin_amdgcn_mfma_f32_16x16x32_bf16(a1, wh1, acc, 0, 0, 0); acc = __builtin_amdgcn_mfma_f32_16x16x32_bf16(a1, wl1, acc, 0, 0, 0);
            float f;
            f = bf_lo(x0.x); ss += f * f; f = bf_hi(x0.x); ss += f * f; f = bf_lo(x0.y); ss += f * f; f = bf_hi(x0.y); ss += f * f;
            f = bf_lo(x0.z); ss += f * f; f = bf_hi(x0.z); ss += f * f; f = bf_lo(x0.w); ss += f * f; f = bf_hi(x0.w); ss += f * f;
            f = bf_lo(x1.x); ss += f * f; f = bf_hi(x1.x); ss += f * f; f = bf_lo(x1.y); ss += f * f; f = bf_hi(x1.y); ss += f * f;
            f = bf_lo(x1.z); ss += f * f; f = bf_hi(x1.z); ss += f * f; f = bf_lo(x1.w); ss += f * f; f = bf_hi(x1.w); ss += f * f;
        }
        ss += __shfl_xor(ss, 16); ss += __shfl_xor(ss, 32);
        const float rstd = 1.0f / sqrtf(ss * (1.0f / D) + EPS);
        const float bias = part[512 + i16];
        float lg[4], mx[4], sm[4];
#pragma unroll
        for (int r = 0; r < 4; ++r) { const float rs = __shfl(rstd, 4 * kq + r); lg[r] = rs * acc[r] + bias; mx[r] = lg[r]; }
#pragma unroll
        for (int o = 1; o < 16; o <<= 1)
#pragma unroll
            for (int r = 0; r < 4; ++r) mx[r] = fmaxf(mx[r], __shfl_xor(mx[r], o));
#pragma unroll
        for (int r = 0; r < 4; ++r) { lg[r] = __expf(lg[r] - mx[r]); sm[r] = lg[r]; }
#pragma unroll
        for (int o = 1; o < 16; o <<= 1)
#pragma unroll
            for (int r = 0; r < 4; ++r) sm[r] += __shfl_xor(sm[r], o);
        { const int n0 = (16 * rb) & (SEQ - 1); pg8::f32x4 o4 = {lg[0] / sm[0], lg[1] / sm[1], lg[2] / sm[2], lg[3] / sm[3]};
          *(GAS pg8::f32x4*)(AFF + ((size_t)(b * 16 + i16)) * SEQ + n0 + 4 * kq) = o4; }
        GAS v4u* hr = (GAS v4u*)(H8 + (size_t)row * D) + kq;
#pragma unroll 4
        for (int t = 0; t < 32; ++t) {
            const v4u x0 = xr[8 * t], x1 = xr[8 * t + 1];
            const v4u g0 = *(const LAS v4u*)(gsL + (8 * t + 2 * kq) * 16), g1 = *(const LAS v4u*)(gsL + (8 * t + 2 * kq + 1) * 16);
            const v4u s0 = *(const LAS v4u*)(shL + (8 * t + 2 * kq) * 16), s1 = *(const LAS v4u*)(shL + (8 * t + 2 * kq + 1) * 16);
            v4u o;
#define H2LO(xw, gw_, sw) (bf_lo(xw) * rstd * bf_lo(gw_) + bf_lo(sw))
#define H2HI(xw, gw_, sw) (bf_hi(xw) * rstd * bf_hi(gw_) + bf_hi(sw))
            o.x = pk4_fp8(H2LO(x0.x, g0.x, s0.x), H2HI(x0.x, g0.x, s0.x), H2LO(x0.y, g0.y, s0.y), H2HI(x0.y, g0.y, s0.y));
            o.y = pk4_fp8(H2LO(x0.z, g0.z, s0.z), H2HI(x0.z, g0.z, s0.z), H2LO(x0.w, g0.w, s0.w), H2HI(x0.w, g0.w, s0.w));
            o.z = pk4_fp8(H2LO(x1.x, g1.x, s1.x), H2HI(x1.x, g1.x, s1.x), H2LO(x1.y, g1.y, s1.y), H2HI(x1.y, g1.y, s1.y));
            o.w = pk4_fp8(H2LO(x1.z, g1.z, s1.z), H2HI(x1.z, g1.z, s1.z), H2LO(x1.w, g1.w, s1.w), H2HI(x1.w, g1.w, s1.w));
#undef H2LO
#undef H2HI
            hr[4 * t] = o;
        }
    }
    __syncthreads();
}

DI void phase_topk(KP P, int layer, LAS unsigned char* lds, int tid, int lane, int wave) {
    LAS unsigned* vals = (LAS unsigned*)(lds + LDS_SCR);
    LAS int* red = (LAS int*)(lds + LDS_SCR + 65536);
    LAS int* slotctr = (LAS int*)(lds + LDS_SCR + 65536 + 64);
    const unsigned* AFF = (const unsigned*)(P->ws + WS_AFF);
    int* IDX = (int*)(P->ws + WS_IDX);
    unsigned* tokcnt = (unsigned*)(P->ws + (layer ? CTL_TOKCNT1 : CTL_TOKCNT0));
    unsigned long long* toklist = (unsigned long long*)(P->ws + WS_TOKLIST);
    if (gridDim.x > 32 && blockIdx.x >= 32) {
        xpose_range(P, lds, lane, wave, layer == 0 ? 4 : 3, (blockIdx.x - 32) * NWAVES + wave, (gridDim.x - 32) * NWAVES);
        return;
    }
    for (int j = blockIdx.x; j < 32; j += gridDim.x) {
        const int b = j >> 4, e = j & 15;
        const unsigned* src = AFF + (size_t)j * SEQ;
#pragma unroll 8
        for (int i = 0; i < 32; ++i) vals[tid + 512 * i] = src[tid + 512 * i];
        if (tid == 0) slotctr[0] = 0;
        __syncthreads();
        int par = 0;
#define TK_COUNT(pred, total) do { int _c = 0; _Pragma("unroll 8") for (int i = 0; i < 32; ++i) { const int idx = tid + 512 * i; const unsigned v = vals[idx]; (void)idx; _c += (pred) ? 1 : 0; } \
        _c = wave_sum_i(_c); if (lane == 0) red[par * 8 + wave] = _c; __syncthreads(); total = 0; _Pragma("unroll") for (int w = 0; w < 8; ++w) total += red[par * 8 + w]; par ^= 1; } while (0)
        unsigned T = 0u;
        for (int bit = 30; bit >= 0; --bit) { const unsigned cand = T | (1u << bit); int total; TK_COUNT(v >= cand, total); if (total >= CAP) T = cand; }
        int ngt; TK_COUNT(v > T, ngt);
        const int need = CAP - ngt;
        int lo = 0, hi = SEQ - 1;
        while (lo < hi) { const int mid = (lo + hi) >> 1; int c; TK_COUNT(v == T && idx <= mid, c); if (c >= need) hi = mid; else lo = mid + 1; }
        const int J = lo;
#undef TK_COUNT
        for (int i = 0; i < 32; ++i) { const int idx = tid + 512 * i; const unsigned v = vals[idx];
            if (v > T || (v == T && idx <= J)) {
                const int slot = __hip_atomic_fetch_add(slotctr, 1, __ATOMIC_RELAXED, __HIP_MEMORY_SCOPE_WORKGROUP);
                IDX[j * CAP + slot] = idx;
                const int tok = b * SEQ + idx; const unsigned rowid = (unsigned)(e * 4096 + b * 2048 + slot);
                const unsigned p = __hip_atomic_fetch_add(tokcnt + tok, 1u, RLX_AGENT);
                toklist[(size_t)tok * 16 + (p & 15u)] = ((unsigned long long)v << 32) | rowid; } }
        __syncthreads();
    }
}

template <bool F8>
DI void phase_gather(KP P, int lane, int wave) {
    const int* IDX = (const int*)(P->ws + WS_IDX); const unsigned char* H = (const unsigned char*)(P->ws + WS_H); unsigned char* XS = (unsigned char*)(P->ws + WS_R2);
    const int gw = blockIdx.x * NWAVES + wave, NGW = gridDim.x * NWAVES;
    constexpr int RB = F8 ? D : 2 * D, NV = RB / 1024;
    for (int rowid = gw; rowid < 65536; rowid += NGW) {
        const int e = rowid >> 12, b = (rowid >> 11) & 1, slot = rowid & 2047;
        const int n = IDX[(b * 16 + e) * CAP + slot];
        const GAS v4u* s = (const GAS v4u*)(H + (size_t)(b * SEQ + n) * RB) + lane; GAS v4u* d = (GAS v4u*)(XS + (size_t)rowid * RB) + lane;
        v4u t[NV];
#pragma unroll
        for (int j = 0; j < NV; ++j) t[j] = s[64 * j];
#pragma unroll
        for (int j = 0; j < NV; ++j) d[64 * j] = t[j];
    }
}

DI void unpack8(float (&f)[8], const v4u w) { f[0] = bf_lo(w.x); f[1] = bf_hi(w.x); f[2] = bf_lo(w.y); f[3] = bf_hi(w.y); f[4] = bf_lo(w.z); f[5] = bf_hi(w.z); f[6] = bf_lo(w.w); f[7] = bf_hi(w.w); }
typedef float f32x2_t __attribute__((ext_vector_type(2)));
DI void unpack8_fp8(float (&f)[8], const v2u w) {
    const f32x2_t a = __builtin_amdgcn_cvt_pk_f32_fp8((int)w.x, false), b = __builtin_amdgcn_cvt_pk_f32_fp8((int)w.x, true), c = __builtin_amdgcn_cvt_pk_f32_fp8((int)w.y, false), d = __builtin_amdgcn_cvt_pk_f32_fp8((int)w.y, true);
    f[0] = a.x; f[1] = a.y; f[2] = b.x; f[3] = b.y; f[4] = c.x; f[5] = c.y; f[6] = d.x; f[7] = d.y; }
template <bool NEXT_NORM>
DI void phase_combine(KP P, int layer, int lane, int wave) {
    const float* mod = (const float*)(P->ws + WS_MOD) + (size_t)layer * 3 * 12288;
    const float* modn = (const float*)(P->ws + WS_MOD) + (size_t)(layer + 1) * 3 * 12288;
    const unsigned* tokcnt = (const unsigned*)(P->ws + (layer ? CTL_TOKCNT1 : CTL_TOKCNT0));
    const unsigned long long* toklist = (const unsigned long long*)(P->ws + WS_TOKLIST);
    const unsigned char* YB = (const unsigned char*)(P->ws + WS_R3); bf16* H = (bf16*)(P->ws + WS_H); bf16* XLB = (bf16*)(P->ws + WS_XLB);
    const int gw = blockIdx.x * NWAVES + wave, NGW = gridDim.x * NWAVES;
    for (int tb = gw; tb < NT; tb += 16 * NGW) {
        int cntv = 0; { const int tk = tb + (lane & 15) * NGW; if (tk < NT) cntv = (int)tokcnt[tk]; }
        unsigned long long en0 = 0ull, en1 = 0ull, en2 = 0ull, en3 = 0ull; { const int tk = tb + (lane >> 2) * NGW;
            if (tk < NT) { const unsigned long long* ep = toklist + (size_t)tk * 16 + 4 * (lane & 3); en0 = ep[0]; en1 = ep[1]; en2 = ep[2]; en3 = ep[3]; } }
        v4u xn[4];
#pragma unroll
        for (int jj = 0; jj < 4; ++jj) xn[jj] = *(const GAS v4u*)(XLB + (size_t)tb * D + 512 * jj + 8 * lane);
        for (int i = 0; i < 16; ++i) {
            const int tok = tb + i * NGW; if (tok >= NT) break;
            const int b = tok >> 14;
            v4u xc[4];
#pragma unroll
            for (int jj = 0; jj < 4; ++jj) xc[jj] = xn[jj];
            if (i + 1 < 16 && tok + NGW < NT) {
#pragma unroll
                for (int jj = 0; jj < 4; ++jj) xn[jj] = *(const GAS v4u*)(XLB + (size_t)(tok + NGW) * D + 512 * jj + 8 * lane); }
            int cnt = __builtin_amdgcn_readlane(cntv, i); cnt = cnt > 16 ? 16 : cnt;
            float a[4][8];
#pragma unroll
            for (int jj = 0; jj < 4; ++jj)
#pragma unroll
                for (int e = 0; e < 8; ++e) a[jj][e] = 0.f;
            for (int p = 0; p < cnt; p += 2) {
                unsigned r0, r1; float g0, g1;
                { const int q = p & 3, sl = 4 * i + (p >> 2); const unsigned long long xa = (q & 1) ? en1 : en0, xb = (q & 1) ? en3 : en2, x = (q & 2) ? xb : xa;
                  r0 = (unsigned)__builtin_amdgcn_readlane((int)(unsigned)x, sl); g0 = __uint_as_float((unsigned)__builtin_amdgcn_readlane((int)(unsigned)(x >> 32), sl)); }
                if (p + 1 < cnt) { const int p1 = p + 1, q = p1 & 3, sl = 4 * i + (p1 >> 2); const unsigned long long xa = (q & 1) ? en1 : en0, xb = (q & 1) ? en3 : en2, x = (q & 2) ? xb : xa;
                  r1 = (unsigned)__builtin_amdgcn_readlane((int)(unsigned)x, sl); g1 = __uint_as_float((unsigned)__builtin_amdgcn_readlane((int)(unsigned)(x >> 32), sl)); }
                else { r1 = r0; g1 = 0.f; }
                v2u y0[4], y1[4];
#pragma unroll
                for (int jj = 0; jj < 4; ++jj) { y0[jj] = *(const GAS v2u*)(YB + (size_t)r0 * D + 512 * jj + 8 * lane); y1[jj] = *(const GAS v2u*)(YB + (size_t)r1 * D + 512 * jj + 8 * lane); }
#pragma unroll
                for (int jj = 0; jj < 4; ++jj) { float f0[8], f1[8]; unpack8_fp8(f0, y0[jj]); unpack8_fp8(f1, y1[jj]);
#pragma unroll
                    for (int e = 0; e < 8; ++e) a[jj][e] += g0 * f0[e] + g1 * f1[e]; }
            }
            const float* g2 = mod + (size_t)b * 12288 + 5 * 2048;
            float v[4][8]; float ss = 0.f;
#pragma unroll
            for (int jj = 0; jj < 4; ++jj) { const int c = 512 * jj + 8 * lane; const f32x4 ga = *(const f32x4*)(g2 + c), gb = *(const f32x4*)(g2 + c + 4); float x[8]; unpack8(x, xc[jj]);
                v[jj][0] = x[0] + ga.x * a[jj][0]; v[jj][1] = x[1] + ga.y * a[jj][1]; v[jj][2] = x[2] + ga.z * a[jj][2]; v[jj][3] = x[3] + ga.w * a[jj][3];
                v[jj][4] = x[4] + gb.x * a[jj][4]; v[jj][5] = x[5] + gb.y * a[jj][5]; v[jj][6] = x[6] + gb.z * a[jj][6]; v[jj][7] = x[7] + gb.w * a[jj][7];
#pragma unroll
                for (int e = 0; e < 8; ++e) ss += v[jj][e] * v[jj][e]; }
            if constexpr (NEXT_NORM) {
#pragma unroll
                for (int jj = 0; jj < 4; ++jj) { v4u o; o.x = pk2(v[jj][0], v[jj][1]); o.y = pk2(v[jj][2], v[jj][3]); o.z = pk2(v[jj][4], v[jj][5]); o.w = pk2(v[jj][6], v[jj][7]);
                    *(GAS v4u*)(XLB + (size_t)tok * D + 512 * jj + 8 * lane) = o; }
                const float rstd = 1.0f / sqrtf(wave_sum(ss) * (1.0f / D) + EPS);
                const float* m = modn + (size_t)b * 12288; const float* gn = P->in[I_N1G] + (size_t)(layer + 1) * D;
#pragma unroll
                for (int jj = 0; jj < 4; ++jj) { const int c = 512 * jj + 8 * lane; float h[8];
#pragma unroll
                    for (int hf2 = 0; hf2 < 2; ++hf2) { const f32x4 gg = *(const f32x4*)(gn + c + 4 * hf2), sc = *(const f32x4*)(m + 2048 + c + 4 * hf2), sh = *(const f32x4*)(m + c + 4 * hf2);
                        h[4 * hf2 + 0] = v[jj][4 * hf2 + 0] * rstd * gg.x * (1.0f + sc.x) + sh.x; h[4 * hf2 + 1] = v[jj][4 * hf2 + 1] * rstd * gg.y * (1.0f + sc.y) + sh.y;
                        h[4 * hf2 + 2] = v[jj][4 * hf2 + 2] * rstd * gg.z * (1.0f + sc.z) + sh.z; h[4 * hf2 + 3] = v[jj][4 * hf2 + 3] * rstd * gg.w * (1.0f + sc.w) + sh.w; }
                    v4u o; o.x = pk2(h[0], h[1]); o.y = pk2(h[2], h[3]); o.z = pk2(h[4], h[5]); o.w = pk2(h[6], h[7]);
                    *(GAS v4u*)(H + (size_t)tok * D + 512 * jj + 8 * lane) = o; }
            } else {
#pragma unroll
                for (int jj = 0; jj < 4; ++jj) { GAS f32x4* o = (GAS f32x4*)(P->out + (size_t)tok * D + 512 * jj + 8 * lane);
                    __builtin_nontemporal_store((f32x4){v[jj][0], v[jj][1], v[jj][2], v[jj][3]}, o); __builtin_nontemporal_store((f32x4){v[jj][4], v[jj][5], v[jj][6], v[jj][7]}, o + 1); }
            }
        }
    }
}

DI void phase_knorm(KP P, int lane, int wave) {
    bf16* KK = (bf16*)(P->ws + WS_R2) + 3 * R2_T; const float* gk = P->in[I_BKG];
    const int gw = blockIdx.x * NWAVES + wave, NGW = gridDim.x * NWAVES;
    const int d0 = (lane & 7) * 16;
    float gkr[16];
#pragma unroll
    for (int i = 0; i < 16; ++i) gkr[i] = gk[d0 + i];
    for (int row = gw; row < MTOT; row += NGW) {
        GAS v4u* p = (GAS v4u*)(KK + (size_t)row * 1024) + 2 * lane;
        const v4u w0 = p[0], w1 = p[1];
        float f[16];
        f[0] = bf_lo(w0.x); f[1] = bf_hi(w0.x); f[2] = bf_lo(w0.y); f[3] = bf_hi(w0.y); f[4] = bf_lo(w0.z); f[5] = bf_hi(w0.z); f[6] = bf_lo(w0.w); f[7] = bf_hi(w0.w);
        f[8] = bf_lo(w1.x); f[9] = bf_hi(w1.x); f[10] = bf_lo(w1.y); f[11] = bf_hi(w1.y); f[12] = bf_lo(w1.z); f[13] = bf_hi(w1.z); f[14] = bf_lo(w1.w); f[15] = bf_hi(w1.w);
        float ss = 0.f;
#pragma unroll
        for (int i = 0; i < 16; ++i) ss += f[i] * f[i];
        ss += __shfl_xor(ss, 1); ss += __shfl_xor(ss, 2); ss += __shfl_xor(ss, 4);
        const float rstd = 1.0f / sqrtf(ss * (1.0f / 128.0f) + EPS);
#pragma unroll
        for (int i = 0; i < 16; ++i) f[i] = f[i] * rstd * gkr[i];
        v4u o0, o1; o0.x = pk2(f[0], f[1]); o0.y = pk2(f[2], f[3]); o0.z = pk2(f[4], f[5]); o0.w = pk2(f[6], f[7]); o1.x = pk2(f[8], f[9]); o1.y = pk2(f[10], f[11]); o1.z = pk2(f[12], f[13]); o1.w = pk2(f[14], f[15]);
        p[0] = o0; p[1] = o1;
    }
}

DI void phase_gmlp(KP P, LAS unsigned char* lds, int tid, int lane, int wave) {
    const bf16* U = (const bf16*)(P->ws + WS_R2); const bf16* V = U + R2_T; const bf16* WSB = (const bf16*)(P->ws + WS_WSB);
    bf16* CAT = (bf16*)(P->ws + WS_R3);
    LAS unsigned char* wimg = lds + LDS_SCR;
    LAS unsigned char* vimg = lds + LDS_SCR + 32768;
    const int ql = lane & 31, hf = lane >> 5;
    const int G = gridDim.x;
    const bool wonce = (G & 7) == 0;
    v4u vraw[4];
    int u = blockIdx.x;
    if (u < 2048) { const int g = u & 7, cn = (u >> 3) & 127, b = u >> 10; const int tok0 = b * SEQ + cn * 128;
#pragma unroll
        for (int i = 0; i < 4; ++i) { const int cidx = tid + 512 * i, q = cidx >> 4, ch = cidx & 15; vraw[i] = *(const GAS v4u*)(V + (size_t)(tok0 + q) * 1024 + g * 128 + ch * 8); } }
    for (int it = 0; u < 2048; u += G, ++it) {
        const int g = u & 7, cn = (u >> 3) & 127, b = u >> 10;
        const int tok0 = b * SEQ + cn * 128;
        const float* gv = P->in[I_AVG] + g * 128;
        if (it == 0 || !wonce) {
#pragma unroll
            for (int i = 0; i < 4; ++i) { const int cidx = tid + 512 * i, q = cidx >> 4, ch = cidx & 15;
                const v4u wraw = *(const GAS v4u*)(WSB + (size_t)(g * 128 + q) * 128 + ch * 8);
                *(LAS v4u*)(wimg + (q >> 5) * 8192 + off_b(q & 31, ch)) = wraw; } }
#pragma unroll
        for (int i = 0; i < 4; ++i) { const int cidx = tid + 512 * i, q = cidx >> 4, ch = cidx & 15;
            const v4u raw = vraw[i];
            float f[8]; f[0] = bf_lo(raw.x); f[1] = bf_hi(raw.x); f[2] = bf_lo(raw.y); f[3] = bf_hi(raw.y); f[4] = bf_lo(raw.z); f[5] = bf_hi(raw.z); f[6] = bf_lo(raw.w); f[7] = bf_hi(raw.w);
            float ss = 0.f;
#pragma unroll
            for (int k = 0; k < 8; ++k) ss += f[k] * f[k];
            ss += __shfl_xor(ss, 1); ss += __shfl_xor(ss, 2); ss += __shfl_xor(ss, 4); ss += __shfl_xor(ss, 8);
            const float rstd = 1.0f / sqrtf(ss * (1.0f / 128.0f) + EPS);
            const f32x4 g0 = *(const f32x4*)(gv + ch * 8), g1 = *(const f32x4*)(gv + ch * 8 + 4);
            v4u o; o.x = pk2(f[0] * rstd * g0.x, f[1] * rstd * g0.y); o.y = pk2(f[2] * rstd * g0.z, f[3] * rstd * g0.w); o.z = pk2(f[4] * rstd * g1.x, f[5] * rstd * g1.y); o.w = pk2(f[6] * rstd * g1.z, f[7] * rstd * g1.w);
            *(LAS v4u*)(vimg + (q >> 5) * 8192 + off_b(q & 31, ch)) = o; }
        __syncthreads();
        const int cb = wave & 3, pb0 = 2 * (wave >> 2);
        { const int un = u + G; if (un < 2048) { const int gn = un & 7, cnn = (un >> 3) & 127, bn = un >> 10; const int tokn = bn * SEQ + cnn * 128;
#pragma unroll
            for (int i = 0; i < 4; ++i) { const int cidx = tid + 512 * i, q = cidx >> 4, ch = cidx & 15; vraw[i] = *(const GAS v4u*)(V + (size_t)(tokn + q) * 1024 + gn * 128 + ch * 8); } } }
        v2u uu[2][4]; float bsv[2];
#pragma unroll
        for (int x = 0; x < 2; ++x) { const int p = 32 * (pb0 + x) + ql; bsv[x] = P->in[I_ABS][g * 128 + p];
#pragma unroll
            for (int rq = 0; rq < 4; ++rq) uu[x][rq] = *(const GAS v2u*)(U + (size_t)(tok0 + p) * 1024 + g * 128 + 32 * cb + 8 * rq + 4 * hf); }
        f32x16 acc0, acc1;
#pragma unroll
        for (int i = 0; i < 16; ++i) { acc0[i] = 0.f; acc1[i] = 0.f; }
#pragma unroll
        for (int ks = 0; ks < 8; ++ks) {
            const bf16x8 a = tr_frag<false>(vimg + (ks >> 1) * 8192, lane, cb, ks & 1);
            const bf16x8 b0 = row_frag(wimg + (pb0 + 0) * 8192, lane, ks), b1 = row_frag(wimg + (pb0 + 1) * 8192, lane, ks);
            acc0 = MFMA32(a, b0, acc0); acc1 = MFMA32(a, b1, acc1);
        }
#pragma unroll
        for (int x = 0; x < 2; ++x) { const int p = 32 * (pb0 + x) + ql; const int tok = tok0 + p; const float bs = bsv[x];
            v2u oo[4];
#pragma unroll
            for (int rq = 0; rq < 4; ++rq) {
                const v2u w = uu[x][rq];
                const float s0 = (x ? acc1[4 * rq + 0] : acc0[4 * rq + 0]) + bs, s1 = (x ? acc1[4 * rq + 1] : acc0[4 * rq + 1]) + bs, s2 = (x ? acc1[4 * rq + 2] : acc0[4 * rq + 2]) + bs, s3 = (x ? acc1[4 * rq + 3] : acc0[4 * rq + 3]) + bs;
                oo[rq].x = pk2(bf_lo(w.x) * s0, bf_hi(w.x) * s1); oo[rq].y = pk2(bf_lo(w.y) * s2, bf_hi(w.y) * s3); }
#pragma unroll
            for (int rq = 0; rq < 4; rq += 2) {
                const auto rx = __builtin_amdgcn_permlane32_swap(oo[rq].x, oo[rq + 1].x, false, false); const auto ry = __builtin_amdgcn_permlane32_swap(oo[rq].y, oo[rq + 1].y, false, false);
                v4u o; o.x = rx[0]; o.y = ry[0]; o.z = rx[1]; o.w = ry[1];
                *(GAS v4u*)(CAT + (size_t)tok * D + g * 128 + 32 * cb + 8 * (rq + hf)) = o; } }
        __syncthreads();
    }
}

DI void phase_attn(KP P, LAS unsigned char* lds, int tid, int lane, int wave) {
    const bf16* Qb = (const bf16*)(P->ws + WS_R2) + 2 * R2_T; const bf16* KK = Qb + R2_T; const bf16* VV = KK + R2_T;
    bf16* CAT = (bf16*)(P->ws + WS_R3);
    LAS unsigned char* kbuf = lds + LDS_SCR;
    LAS unsigned char* vbuf = lds + LDS_SCR + 49152;
    LAS float* rpbL = (LAS float*)(lds + LDS_SCR + 98304 + 1024);
    const int ql = lane & 31, hf = lane >> 5;
    const float* gq = P->in[I_BQG];
    const int rp = wave >> 2, cb = wave & 3;
    const int c0 = min(max(16 * cb - 8, 0), 32);
    const int u00 = c0 >> 3; const bool oddw = (u00 & 1) != 0; const unsigned offw = 4096u * (unsigned)(u00 >> 1);
    unsigned trl[4], trh[4];
    { const unsigned h = lane >> 5, blk = (lane >> 4) & 1, q = (lane & 15) >> 2, p = lane & 3, r0 = 4 * h + q, sub = 8 * (p & 1);
#pragma unroll
      for (int c = 0; c < 4; ++c) { const unsigned ch = 4 * c + 2 * blk + (p >> 1); trl[c] = off_b(r0, ch) + sub; trh[c] = off_b(r0 + 8, ch) + sub; } }
    unsigned kfl[8];
    { const unsigned key = (unsigned)(c0 + ql);
#pragma unroll
      for (int s = 0; s < 8; ++s) kfl[s] = (key >> 5) * 8192u + off_b(key & 31u, 2 * s + hf); }
    for (int u = blockIdx.x; u < 1024; u += gridDim.x) {
        const int h = u & 7, rg = (u >> 3) & 63, b = u >> 9;
        const int qr = 4 * rg + 2 * rp + (ql >> 4), qc = 16 * cb + (ql & 15);
        const int tq = b * SEQ + qr * GRIDW + qc;
        bf16x8 Qf[8];
        { v4u raw[8]; float ss = 0.f;
#pragma unroll
          for (int s = 0; s < 8; ++s) { raw[s] = *(const GAS v4u*)(Qb + (size_t)tq * 1024 + h * 128 + 16 * s + 8 * hf);
              const float a0 = bf_lo(raw[s].x), a1 = bf_hi(raw[s].x), a2 = bf_lo(raw[s].y), a3 = bf_hi(raw[s].y), a4 = bf_lo(raw[s].z), a5 = bf_hi(raw[s].z), a6 = bf_lo(raw[s].w), a7 = bf_hi(raw[s].w);
              ss += (a0 * a0 + a1 * a1) + (a2 * a2 + a3 * a3) + (a4 * a4 + a5 * a5) + (a6 * a6 + a7 * a7); }
          ss += __shfl_xor(ss, 32);
          const float qs = (1.0f / sqrtf(ss * (1.0f / 128.0f) + EPS)) * (0.08838834764831845f * LOG2E);
#pragma unroll
          for (int s = 0; s < 8; ++s) { const f32x4 g0 = *(const f32x4*)(gq + 16 * s + 8 * hf), g1 = *(const f32x4*)(gq + 16 * s + 8 * hf + 4);
              v4u o; o.x = pk2(bf_lo(raw[s].x) * qs * g0.x, bf_hi(raw[s].x) * qs * g0.y); o.y = pk2(bf_lo(raw[s].y) * qs * g0.z, bf_hi(raw[s].y) * qs * g0.w);
              o.z = pk2(bf_lo(raw[s].z) * qs * g1.x, bf_hi(raw[s].z) * qs * g1.y); o.w = pk2(bf_lo(raw[s].w) * qs * g1.z, bf_hi(raw[s].w) * qs * g1.w);
              Qf[s] = __builtin_bit_cast(bf16x8, o); } }
        if (tid < 465) rpbL[tid] = P->in[I_RPB][h * 465 + tid] * LOG2E;
        const int rs_q = min(max(qr - 4, 0), NROWS - 8);
        const int wlo = min(max(4 * rg + 2 * rp - 4, 0), NROWS - 8), whi = min(max(4 * rg + 2 * rp + 1 - 4, 0), NROWS - 8) + 7;
        const int krlo = min(max(4 * rg - 4, 0), NROWS - 8), krhi = min(max(4 * rg + 3 - 4, 0), NROWS - 8) + 7, ntl = krhi - krlo + 1, T = ntl + 4;
        const int cs = min(max(qc - 8, 0), GRIDW - 16);
        f32x16 O[4];
#pragma unroll
        for (int db = 0; db < 4; ++db)
#pragma unroll
            for (int i = 0; i < 16; ++i) O[db][i] = 0.f;
        float m_run = -5e29f, l_run = 0.f;
#define ATT_DMA(t, slot) do { const int _tb = (t) < ntl ? b * SEQ + (krlo + (t)) * GRIDW : NT + b * CTXL + 64 * ((t) - ntl); \
        _Pragma("unroll") for (int _i = 0; _i < 2; ++_i) { const int _c = tid + 512 * _i, _key = _c >> 4, _chp = _c & 15, _row = _key & 31; const int _ch = _chp ^ (((_row & 3) << 2) | ((_row >> 2) & 3)); \
            const size_t _o = (size_t)(_tb + _key) * 1024 + h * 128 + _ch * 8; const unsigned _l = (unsigned)(slot) * 16384u + (unsigned)(wave * 64 + 512 * _i) * 16u; \
            __builtin_amdgcn_global_load_lds((const unsigned*)(KK + _o), (LAS unsigned*)(kbuf + _l), 16, 0, 0); \
            __builtin_amdgcn_global_load_lds((const unsigned*)(VV + _o), (LAS unsigned*)(vbuf + _l), 16, 0, 0); } } while (0)
        ATT_DMA(0, 0); ATT_DMA(1, 1);
        asm volatile("s_waitcnt vmcnt(4) lgkmcnt(0)" ::: "memory"); __builtin_amdgcn_s_barrier(); asm volatile("" ::: "memory");
        for (int t = 0; t < T; ++t) {
            const int slot = t % 3;
            if (t + 2 < T) ATT_DMA(t + 2, (t + 2) % 3);
            const bool local = t < ntl; const int kr = krlo + t;
            const bool active = !local || (kr >= wlo && kr <= whi);
            if (active) {
                const LAS unsigned char* kb_ = kbuf + slot * 16384; const LAS unsigned char* vb_ = vbuf + slot * 16384;
                f32x16 S0, S1;
#pragma unroll
                for (int i = 0; i < 16; ++i) { S0[i] = 0.f; S1[i] = 0.f; }
                if (local) {
#pragma unroll
                    for (int s = 0; s < 8; ++s) { const bf16x8 a0 = *(const LAS bf16x8*)(kb_ + kfl[s]); S0 = MFMA32(a0, Qf[s], S0); }
                    const bool rowok = (kr >= rs_q) && (kr <= rs_q + 7);
                    int cl = rowok ? (cs - c0 - 4 * hf) : 0x40000000; int bbase = min(max(kr - qr + 7, 0), 14) * 31 + 15 + c0 + 4 * hf - qc;
                    asm volatile("" : "+v"(cl), "+v"(bbase));
                    const LAS float* bp = rpbL + bbase;
                    float bia0[16];
#pragma unroll
                    for (int r = 0; r < 16; ++r) bia0[r] = bp[(r & 3) + 8 * (r >> 2)];
#pragma unroll
                    for (int r = 0; r < 16; ++r) asm volatile("" : "+v"(bia0[r]));
#pragma unroll
                    for (int r = 0; r < 16; ++r) { const int k0 = (r & 3) + 8 * (r >> 2); const bool ok = (unsigned)(k0 - cl) < 16u; S0[r] = ok ? S0[r] + bia0[r] : -1e30f; }
                } else {
#pragma unroll
                    for (int s = 0; s < 8; ++s) { const bf16x8 a0 = row_frag(kb_, lane, s), a1 = row_frag(kb_ + 8192, lane, s); S0 = MFMA32(a0, Qf[s], S0); S1 = MFMA32(a1, Qf[s], S1); }
                }
                float mt = S0[0];
#pragma unroll
                for (int r = 1; r < 16; ++r) mt = fmaxf(mt, S0[r]);
                if (!local) {
#pragma unroll
                    for (int r = 0; r < 16; ++r) mt = fmaxf(mt, S1[r]); }
                mt = fmaxf(mt, __shfl_xor(mt, 32));
                const float m_new = fmaxf(m_run, mt), alpha = fast_exp2(m_run - m_new);
                m_run = m_new;
                float ps = 0.f;
#pragma unroll
                for (int r = 0; r < 16; ++r) { S0[r] = fast_exp2(S0[r] - m_new); ps += S0[r]; }
                if (!local) {
#pragma unroll
                    for (int r = 0; r < 16; ++r) { S1[r] = fast_exp2(S1[r] - m_new); ps += S1[r]; } }
                l_run = l_run * alpha + ps;
                if (__builtin_amdgcn_ballot_w64(alpha != 1.0f) != 0ull) {
#pragma unroll
                    for (int db = 0; db < 4; ++db)
#pragma unroll
                        for (int i = 0; i < 16; ++i) O[db][i] *= alpha; }
                const unsigned vb_a = (unsigned)(unsigned long)vb_;
                unsigned tal[4], tah[4];
#pragma unroll
                for (int c = 0; c < 4; ++c) { tal[c] = vb_a + trl[c]; tah[c] = vb_a + trh[c]; }
                unsigned al0[4], ah0[4];
#pragma unroll
                for (int c = 0; c < 4; ++c) { al0[c] = local ? ((oddw ? tah[c] : tal[c]) + offw) : tal[c]; ah0[c] = local ? ((oddw ? tal[c] + 4096u : tah[c]) + offw) : tah[c]; }
#pragma unroll
                for (int s2 = 0; s2 < 2; ++s2) {
                    v4u pp; pp.x = pk2(S0[8 * s2 + 0], S0[8 * s2 + 1]); pp.y = pk2(S0[8 * s2 + 2], S0[8 * s2 + 3]); pp.z = pk2(S0[8 * s2 + 4], S0[8 * s2 + 5]); pp.w = pk2(S0[8 * s2 + 6], S0[8 * s2 + 7]);
                    const bf16x8 pf = __builtin_bit_cast(bf16x8, pp);
                    bf16x8 av[4];
                    if (s2 == 0) tr_frag4_pre<0>(av, al0, ah0); else tr_frag4_pre<4096>(av, al0, ah0);
#pragma unroll
                    for (int db = 0; db < 4; ++db) O[db] = MFMA32(av[db], pf, O[db]);
                }
                if (!local) {
#pragma unroll
                    for (int s2 = 0; s2 < 2; ++s2) {
                        v4u pp; pp.x = pk2(S1[8 * s2 + 0], S1[8 * s2 + 1]); pp.y = pk2(S1[8 * s2 + 2], S1[8 * s2 + 3]); pp.z = pk2(S1[8 * s2 + 4], S1[8 * s2 + 5]); pp.w = pk2(S1[8 * s2 + 6], S1[8 * s2 + 7]);
                        const bf16x8 pf = __builtin_bit_cast(bf16x8, pp);
                        bf16x8 av[4];
                        if (s2 == 0) tr_frag4_pre<8192>(av, tal, tah); else tr_frag4_pre<12288>(av, tal, tah);
#pragma unroll
                        for (int db = 0; db < 4; ++db) O[db] = MFMA32(av[db], pf, O[db]);
                    }
                }
            }
            if (t + 2 < T) asm volatile("s_waitcnt vmcnt(4)" ::: "memory"); else asm volatile("s_waitcnt vmcnt(0)" ::: "memory");
            asm volatile("s_waitcnt lgkmcnt(0)" ::: "memory"); __builtin_amdgcn_s_barrier(); asm volatile("" ::: "memory");
        }
#undef ATT_DMA
        const float inv = 1.0f / (l_run + __shfl_xor(l_run, 32));
        bf16* orow = CAT + (size_t)tq * D + 1024 + h * 128;
#pragma unroll
        for (int db = 0; db < 4; ++db)
#pragma unroll
            for (int rq = 0; rq < 4; rq += 2) {
                const unsigned ax = pk2(O[db][4 * rq + 0] * inv, O[db][4 * rq + 1] * inv), ay = pk2(O[db][4 * rq + 2] * inv, O[db][4 * rq + 3] * inv);
                const unsigned bx = pk2(O[db][4 * rq + 4] * inv, O[db][4 * rq + 5] * inv), by = pk2(O[db][4 * rq + 6] * inv, O[db][4 * rq + 7] * inv);
                const auto rx = __builtin_amdgcn_permlane32_swap(ax, bx, false, false); const auto ry = __builtin_amdgcn_permlane32_swap(ay, by, false, false);
                v4u o; o.x = rx[0]; o.y = ry[0]; o.z = rx[1]; o.w = ry[1];
                *(GAS v4u*)(orow + 32 * db + 8 * (rq + hf)) = o; }
    }
}

DI void phase_conv(KP P, int lane, int wave) {
    const bf16* BG = (const bf16*)(P->ws + WS_R2); const bf16* CZ = BG + (size_t)NT * D; bf16* WC = (bf16*)(P->ws + WS_R3);
    const float* cw = P->in[I_CONVW];
    const int gw = blockIdx.x * NWAVES + wave, NGW = gridDim.x * NWAVES;
    for (int it = gw; it < (NT / 8) * 4; it += NGW) {
        const int rho = it >> 2, cq = it & 3, tb = (rho & 7) * 512 + (511 - (rho >> 3));
        const int tok0 = tb * 8, c0 = cq * 512 + lane * 8;
        const int n0 = tok0 & (SEQ - 1);
        v4u z[10], g[8];
#pragma unroll
        for (int q = 0; q < 10; ++q) { const int n = n0 + q - 1; const bool in = (n >= 0) && (n < SEQ);
            z[q] = in ? *(const GAS v4u*)(CZ + (size_t)(tok0 + q - 1) * D + c0) : (v4u){0u, 0u, 0u, 0u}; }
#pragma unroll
        for (int q = 0; q < 8; ++q) g[q] = *(const GAS v4u*)(BG + (size_t)(tok0 + q) * D + c0);
        const f32x4 w0a = *(const f32x4*)(cw + c0), w0b = *(const f32x4*)(cw + c0 + 4), w1a = *(const f32x4*)(cw + D + c0), w1b = *(const f32x4*)(cw + D + c0 + 4), w2a = *(const f32x4*)(cw + 2 * D + c0), w2b = *(const f32x4*)(cw + 2 * D + c0 + 4);
#pragma unroll
        for (int q = 0; q < 8; ++q) { const v4u a = z[q], m = z[q + 1], p = z[q + 2], b_ = g[q]; v4u o;
#define CV(lohi, wsel, widx, word) (lohi(b_.word) * (w0##wsel[widx] * lohi(a.word) + w1##wsel[widx] * lohi(m.word) + w2##wsel[widx] * lohi(p.word)))
            o.x = pk2(CV(bf_lo, a, 0, x), CV(bf_hi, a, 1, x)); o.y = pk2(CV(bf_lo, a, 2, y), CV(bf_hi, a, 3, y));
            o.z = pk2(CV(bf_lo, b, 0, z), CV(bf_hi, b, 1, z)); o.w = pk2(CV(bf_lo, b, 2, w), CV(bf_hi, b, 3, w));
#undef CV
            *(GAS v4u*)(WC + (size_t)(tok0 + q) * D + c0) = o; }
    }
}

constexpr int NPHASE = 21;
__global__ void __launch_bounds__(NWAVES * 64, 2) mega_fwd(Params P_) {
    KP P = kparams();
    extern __shared__ __attribute__((aligned(16))) unsigned char lds_raw[];
    LAS unsigned char* lds = (LAS unsigned char*)lds_raw;
    volatile LAS unsigned* MISC = (volatile LAS unsigned*)(lds + MISC_OFF);
    const int tid = threadIdx.x, lane = tid & 63, wave = __builtin_amdgcn_readfirstlane(tid >> 6);
    for (int u = tid; u < (LDS_BYTES - LDSCTL_OFF) / 4; u += NWAVES * 64) ((LAS unsigned*)(lds + LDSCTL_OFF))[u] = 0u;
    __syncthreads();
    unsigned* barw = (unsigned*)(P->ws + WS_CTL + CTL_BAR);
    XcdBarrier bar; bar.bar = barw; bar.x = 0; bar.st = nullptr;
    if (P->ph_hi - P->ph_lo > 1) bar = xcd_barrier_post(barw, MISC + 8);
#define IN(k) (kparams()->ph_lo <= (k) && (k) < kparams()->ph_hi)
#define RUN(k, ...) do { if (IN(k)) { KP P = kparams(); unsigned char* ws = P->ws; (void)ws; __VA_ARGS__; if constexpr ((k) == MK_DUP) { __VA_ARGS__; } } } while (0)
#define SEAM(k) do { if (IN(k) && IN((k) + 1)) xcd_barrier(bar); } while (0)
    unsigned char* ws = P->ws;
    const int G = gridDim.x, cid = blockIdx.x;
    const float* MOD = (const float*)(ws + WS_MOD);

    RUN(0, phase_prologue(P, lds, tid, lane, wave); __syncthreads()); SEAM(0);

    RUN(1, phase_norm1_l0(P, lds, tid, lane, wave));

    SEAM(1);
#define GEMM_IN0() do { { pg8::Gemm g{(const bf16*)(ws + WS_H), (const bf16*)(ws + WS_WIN0), NT, 2048, D}; pg8::StaticOrder<false> S; S.init(NT, 2048, G, cid); \
        EpiIn0 E{(bf16*)(ws + WS_R2), 0, 1.0f, P->in[I_BKG], (LAS float*)(lds + LDS_KPART)}; pg8::gemm_phase<EpiIn0, pg8::StaticOrder<false>, true, true>(lds, g, S, E); } \
      { const bool withctx = G < 64; pg8::Gemm g{(const bf16*)(ws + WS_H8), (const bf16*)(ws + WS_WIN0F8), withctx ? MTOT : NT, 3072, D / 2}; pg8::StaticOrder<false> S; S.init(withctx ? MTOT : NT, 3072, G, cid); \
        EpiIn0 E{(bf16*)(ws + WS_R2), 2, F8_WINV, P->in[I_BKG], (LAS float*)(lds + LDS_KPART)}; pg8::gemm_phase<EpiIn0, pg8::StaticOrder<false>, true, true, true>(lds, g, S, E); } } while (0)
    RUN(2, GEMM_IN0()); SEAM(2);
    RUN(4, phase_attn(P, lds, tid, lane, wave)); if (IN(4)) __syncthreads();
    RUN(3, phase_gmlp(P, lds, tid, lane, wave)); SEAM(4);
#define GEMM_OUT0() do { pg8::Gemm g{(const bf16*)(ws + WS_R3), (const bf16*)(ws + WS_WOUT0), NT, D, D}; pg8::StaticOrder<false> S; S.init(NT, D, G, cid); \
        EpiResid<true> E{(const void*)P->in[I_X], (bf16*)(ws + WS_XLB), MOD + 2 * 2048}; pg8::gemm_phase<EpiResid<true>, pg8::StaticOrder<false>, true, true>(lds, g, S, E); } while (0)
    RUN(5, GEMM_OUT0()); SEAM(5);
#define GEMM_GU(L) do { static_assert(F8L(L), "gathered gate|up GEMM is fp8 only"); \
        pg8::Gemm g{(const bf16*)(ws + WS_H), (const bf16*)(ws + WS_GU) + (size_t)(L) * 16 * 2048 * 2048, 65536, 2048, D / 2}; pg8::StaticOrder<true> S; S.init(65536, 2048, G, cid); \
        LAS int* tbl = (LAS int*)(lds + LDS_GTBL); const int* IDXg = (const int*)(ws + WS_IDX); \
        for (int e_ = tid; e_ < 8 * 256; e_ += NWAVES * 64) { const int ui_ = e_ >> 8, r_ = e_ & 255; pg8::Unit u_; \
            if (S.next(ui_, u_)) { const int rowid = u_.pm * 256 + r_, ex = rowid >> 12, b_ = (rowid >> 11) & 1, slot = rowid & 2047; tbl[e_] = b_ * SEQ + IDXg[(b_ * 16 + ex) * CAP + slot]; } } \
        __syncthreads(); \
        EpiSwiglu<true> E{(void*)(ws + WS_HID)}; pg8::gemm_phase_gather_f8<EpiSwiglu<true>, pg8::StaticOrder<true>>(lds, g, S, E, tbl); } while (0)
#define GEMM_DN(L) do { constexpr bool F8 = F8L(L); pg8::Gemm g{(const bf16*)(ws + WS_HID), (const bf16*)(ws + WS_DN) + (size_t)(L) * 16 * 2048 * 1024, 65536, 2048, F8 ? FF / 2 : FF}; pg8::StaticOrder<true> S; S.init(65536, 2048, G, cid); \
        EpiPlain E{(unsigned char*)(ws + WS_R3), D, F8 ? F8_WINV : 1.0f, NOSTDN}; pg8::gemm_phase<EpiPlain, pg8::StaticOrder<true>, true, true, F8>(lds, g, S, E); } while (0)
#define NOSTDN 0
#define MOE_PHASES(L, base) \
    RUN(base + 0, phase_norm2_router(P, L, lds, tid, lane, wave)); SEAM(base + 0); \
    if (IN(base + 1)) { phase_topk(P, L, lds, tid, lane, wave); } SEAM(base + 1); \
    RUN(base + 3, GEMM_GU(L)); SEAM(base + 3); \
    RUN(base + 4, GEMM_DN(L)); SEAM(base + 4);
    MOE_PHASES(0, 6)
#if MK_DUP == 110
#undef NOSTDN
#define NOSTDN (P->pad + MK_NOST)
    if (IN(10)) { KP P = kparams(); unsigned char* ws = P->ws; GEMM_DN(0); }
#undef NOSTDN
#define NOSTDN 0
#endif
    if (IN(11)) { phase_combine<true>(P, 0, lane, wave); } SEAM(11);
#define GEMM_CIN() do { pg8::Gemm g{(const bf16*)(ws + WS_H), (const bf16*)(ws + WS_WCIN), NT, 6144, D}; pg8::StaticOrder<false> S; S.init(NT, 6144, G, cid); S.hot = NOST; \
        EpiCin E{(bf16*)(ws + WS_R2), (bf16*)(ws + WS_R2) + (size_t)NT * D, NOST}; pg8::gemm_phase<EpiCin, pg8::StaticOrder<false>, true, true>(lds, g, S, E); } while (0)
#define NOST 0
    RUN(12, GEMM_CIN()); SEAM(12);
#undef NOST
#if MK_DUP == 112
#define NOST (P->pad + 1)
    if (IN(12)) { GEMM_CIN(); }
#undef NOST
#endif
    RUN(13, phase_conv(P, lane, wave)); SEAM(13);
    if (IN(14)) {
        pg8::Gemm g{(const bf16*)(ws + WS_R3), (const bf16*)(ws + WS_WCOUT), NT, D, D}; pg8::StaticOrder<false> S; S.init(NT, D, G, cid);
        EpiResid<false> E{(const void*)(ws + WS_XLB), (bf16*)(ws + WS_XLB), MOD + 3 * 12288 + 2 * 2048};
        pg8::gemm_phase<EpiResid<false>, pg8::StaticOrder<false>, true, true>(lds, g, S, E);
    } SEAM(14);
    MOE_PHASES(1, 15)
    if (IN(20)) { phase_combine<false>(P, 1, lane, wave); }
#undef IN
#undef SEAM
}

extern "C" void kernel_launch(void* const* d_in, const int* in_sizes, int n_in, void* d_out, int out_size, void* d_ws, size_t ws_size, hipStream_t stream) {
    static int grid = 0;
    if (grid == 0) {
        if (n_in != 23 || out_size != NT * D || ws_size < WS_END) { fprintf(stderr, "kernel_launch: unexpected shapes (n_in %d out %d ws %zu)\n", n_in, out_size, ws_size); grid = -1; return; }
        int dev = 0, cus = 0, per_cu = 0;
        if (hipGetDevice(&dev) != hipSuccess || hipDeviceGetAttribute(&cus, hipDeviceAttributeMultiprocessorCount, dev) != hipSuccess) { grid = -1; return; }
        if (hipFuncSetAttribute((const void*)mega_fwd, hipFuncAttributeMaxDynamicSharedMemorySize, LDS_BYTES) != hipSuccess) { fprintf(stderr, "kernel_launch: hipFuncSetAttribute failed\n"); grid = -1; return; }
        if (hipOccupancyMaxActiveBlocksPerMultiprocessor(&per_cu, (const void*)mega_fwd, NWAVES * 64, LDS_BYTES) != hipSuccess || per_cu < 1) { fprintf(stderr, "kernel_launch: occupancy query says %d\n", per_cu); }
        (void)hipGetLastError();
        if (cus != 256) { fprintf(stderr, "kernel_launch: built for a 256-CU device (unit counts, the gathered-row table and the context projection assume 256 workgroups); found %d\n", cus); grid = -1; return; }
        grid = cus;
    }
    if (grid < 0) return;
    (void)hipMemsetAsync((char*)d_ws + WS_CTL, 0, CTL_ZERO_BYTES, stream);
    Params p{};
    for (int i = 0; i < 23; ++i) p.in[i] = (const float*)d_in[i];
    p.out = (float*)d_out; p.ws = (unsigned char*)d_ws; p.pad = 0;
    const int last = MK_STOP < NPHASE - 1 ? MK_STOP : NPHASE - 1;
#if MK_SPLIT
    for (int k = 0; k <= last; ++k) { p.ph_lo = k; p.ph_hi = k + 1; p.li = 0; hipLaunchKernelGGL(mega_fwd, dim3(grid), dim3(NWAVES * 64), LDS_BYTES, stream, p); }
#else
    p.ph_lo = 0; p.ph_hi = last + 1; p.li = 0;
    hipLaunchKernelGGL(mega_fwd, dim3(grid), dim3(NWAVES * 64), LDS_BYTES, stream, p);
#endif
}
```

```cpp
#include <hip/hip_runtime.h>
#include <cstdio>
#include <cstdint>

#ifndef MK_SPLIT
#define MK_SPLIT 0
#endif
#ifndef MK_STOP
#define MK_STOP 99
#endif
#ifndef MK_FP8_L0
#define MK_FP8_L0 1
#endif
#ifndef MK_FP8_L1
#define MK_FP8_L1 1
#endif
#ifndef MK_NOST
#define MK_NOST 2
#endif
#ifndef MK_DUP
#define MK_DUP -1
#endif

namespace pg8 {
#define PG8_LAS __attribute__((address_space(3)))
typedef unsigned short bf16_t;
typedef short bf16x8 __attribute__((ext_vector_type(8)));
typedef float f32x4 __attribute__((ext_vector_type(4)));
typedef unsigned u32x4 __attribute__((ext_vector_type(4)));
constexpr int BM = 256, BK = 64, HALF = 128, HTB = HALF * BK * 2, STAGE_BYTES = 8 * HTB, NXCD = 8, WGM = 8;

__host__ __device__ __forceinline__ int lds_byte(int r, int c) { const int st = (r >> 4) * 2 + (c >> 5), rr = r & 15, cc = c & 31, ob = rr * 64 + cc * 2; return st * 1024 + (ob ^ (((ob >> 9) & 1) << 5)); }
__host__ __device__ __forceinline__ void stage_rc(int b, int& R, int& C) { const int st = b / 1024, sb = b % 1024, swz = sb ^ (((sb >> 9) & 1) << 5); R = (st >> 1) * 16 + swz / 64; C = (st & 1) * 32 + (swz % 64) / 2; }
__host__ __device__ __forceinline__ int perm32(int rho) { const int n = rho >> 4, i = rho & 15; return 8 * (i >> 2) + 4 * n + (i & 3); }

struct Unit { int pm, pn, pb; };
struct Gemm { const bf16_t* A; const bf16_t* Bt; int M, N, K; };

template <bool GROUPED>
struct StaticOrder {
    int nM, nN, nwg, G, c, hot;
    __host__ __device__ void init(int M, int N, int G_, int c_) { nM = M / BM; nN = N / BM; nwg = nM * nN; G = G_; c = c_; hot = 0; }
    __host__ __device__ __forceinline__ bool next(int i, Unit& u) const {
        const long L = (long)i * G + c; if (L >= nwg) return false;
        int wgid = (int)L; { const int q = nwg / NXCD, r = nwg % NXCD, xcd = wgid % NXCD, off = wgid / NXCD; wgid = (xcd < r ? xcd * (q + 1) : r * (q + 1) + (xcd - r) * q) + off; }
        const int nig = WGM * nN, gid = wgid / nig, fm = gid * WGM, gsz = (nM - fm) < WGM ? (nM - fm) : WGM;
        u.pm = fm + ((wgid % nig) % gsz); u.pn = (wgid % nig) / gsz;
        u.pb = GROUPED ? ((u.pm >> 4) * 8 + u.pn) : u.pn;
        if (hot) { u.pm = 0; u.pn = 0; u.pb = 0; }
        return true;
    }
    __device__ __forceinline__ void a_ready(const Unit&) const {}
    __device__ __forceinline__ void done(const Unit&) const {}
};

__device__ __forceinline__ unsigned cvt_pk_bf16(float lo, float hi) { unsigned r; asm volatile("v_cvt_pk_bf16_f32 %0, %1, %2" : "=v"(r) : "v"(lo), "v"(hi)); return r; }

typedef int i32x4 __attribute__((ext_vector_type(4)));
typedef int i32x8 __attribute__((ext_vector_type(8)));
__device__ __forceinline__ i32x8 cat8(bf16x8 lo, bf16x8 hi) { return __builtin_shufflevector(__builtin_bit_cast(i32x4, lo), __builtin_bit_cast(i32x4, hi), 0, 1, 2, 3, 4, 5, 6, 7); }
template <class Epi, class Sched, bool ALIGN_EPI = false, bool SP2 = false, bool FP8 = false>
__device__ __forceinline__ void gemm_phase(PG8_LAS unsigned char* lds, const Gemm g, const Sched& S, const Epi& E) {
    const int tid = threadIdx.x, wid = __builtin_amdgcn_readfirstlane(tid >> 6), lane = tid & 63, wr = wid >> 2, wc = wid & 3, fr = lane & 15, fq = lane >> 4;
    const int K = g.K, nt = K / BK;
    constexpr bool WIDE = (Epi::PERM == 2);
    unsigned voffA[2], voffB[2];
#pragma unroll
    for (int i = 0; i < 2; ++i) { int R, C; stage_rc(tid * 16 + i * 8192, R, C); const int Rb = WIDE ? (64 * (R >> 5) + perm32(R & 31)) : (Epi::PERM ? ((R & ~31) + perm32(R & 31)) : R);
        voffA[i] = (unsigned)(R * K + C) * 2u; voffB[i] = (unsigned)(Rb * K + C) * 2u; }
    const size_t kstep = (size_t)(BK * 2);
    const size_t hstep = (size_t)HALF * K * 2;
    const size_t tstep = 2 * hstep;
    const size_t hstepB = WIDE ? (size_t)32 * K * 2 : hstep;
    const unsigned ldsw = (unsigned)wid * 1024u;
    const int aoff = lds_byte(wr * 64 + fr, fq * 8), boff = lds_byte(wc * 32 + fr, fq * 8);
#define PG8_SA(b, h) (((b) * 2 + (h)) * HTB)
#define PG8_SB(b, h) ((4 + (b) * 2 + (h)) * HTB)
#define PG8_STAGE(bufoff, gbase, voff) do { _Pragma("unroll") for (int _i = 0; _i < 2; ++_i) \
        __builtin_amdgcn_global_load_lds((const unsigned*)((const char*)(gbase) + (voff)[_i]), (PG8_LAS unsigned*)(lds + (bufoff) + ldsw + _i * 8192), 16, 0, 0); } while (0)
#define PG8_LDA(dst, b, h) do { _Pragma("unroll") for (int m = 0; m < 4; ++m) _Pragma("unroll") for (int k = 0; k < 2; ++k) dst[m][k] = *(const PG8_LAS bf16x8*)(lds + PG8_SA(b, h) + aoff + m * 2048 + k * 1024); } while (0)
#define PG8_LDB(dst, b, h) do { _Pragma("unroll") for (int n = 0; n < 2; ++n) _Pragma("unroll") for (int k = 0; k < 2; ++k) dst[n][k] = *(const PG8_LAS bf16x8*)(lds + PG8_SB(b, h) + boff + n * 2048 + k * 1024); } while (0)
#define PG8_MMA(ai, bj, At, Bt) do { __builtin_amdgcn_s_setprio(1); _Pragma("unroll") for (int m = 0; m < 4; ++m) _Pragma("unroll") for (int n = 0; n < 2; ++n) { \
        if constexpr (FP8) { const i32x8 _a = cat8(Bt[n][0], Bt[n][1]), _b = cat8(At[m][0], At[m][1]); asm volatile("v_mfma_f32_16x16x128_f8f6f4 %0, %1, %2, %0" : "+v"(acc[ai][bj][m][n]) : "v"(_a), "v"(_b)); } \
        else { _Pragma("unroll") for (int k = 0; k < 2; ++k) acc[ai][bj][m][n] = __builtin_amdgcn_mfma_f32_16x16x32_bf16(Bt[n][k], At[m][k], acc[ai][bj][m][n], 0, 0, 0); } } \
        __builtin_amdgcn_s_setprio(0); } while (0)
#define PG8_WAIT_V(n) asm volatile("s_waitcnt vmcnt(" #n ")" ::: "memory")
#define PG8_WAIT_L(n) asm volatile("s_waitcnt lgkmcnt(" #n ")" ::: "memory")
#define PG8_BAR __builtin_amdgcn_s_barrier()
#define PG8_SCHED __builtin_amdgcn_sched_barrier(0)
    Unit cur, nxt; int ui = 0;
    if (!S.next(0, cur)) return;
    f32x4 acc[2][2][4][2];
#pragma unroll
    for (int a = 0; a < 2; ++a)
#pragma unroll
        for (int b = 0; b < 2; ++b)
#pragma unroll
            for (int m = 0; m < 4; ++m)
#pragma unroll
                for (int n = 0; n < 2; ++n) acc[a][b][m][n] = (f32x4){0.f, 0.f, 0.f, 0.f};
    bf16x8 At[4][2], B0[2][2], B1[2][2];
    const char* cA = (const char*)g.A + (size_t)cur.pm * tstep; const char* cB = (const char*)g.Bt + (size_t)cur.pb * tstep;
    S.a_ready(cur);
    if constexpr (SP2) {
        PG8_STAGE(PG8_SB(0, 0), cB, voffB); PG8_STAGE(PG8_SB(0, 1), cB + hstepB, voffB); PG8_STAGE(PG8_SA(0, 0), cA, voffA); PG8_STAGE(PG8_SA(0, 1), cA + hstep, voffA);
        if (wr == 1) PG8_BAR;
        PG8_WAIT_V(2); PG8_BAR;
        PG8_STAGE(PG8_SB(1, 0), cB + kstep, voffB); PG8_STAGE(PG8_SA(1, 0), cA + kstep, voffA); PG8_STAGE(PG8_SB(1, 1), cB + hstepB + kstep, voffB);
        PG8_WAIT_V(6); PG8_BAR;
    } else {
        PG8_STAGE(PG8_SB(0, 0), cB, voffB); PG8_STAGE(PG8_SA(0, 0), cA, voffA); PG8_STAGE(PG8_SB(0, 1), cB + hstepB, voffB); PG8_STAGE(PG8_SA(0, 1), cA + hstep, voffA);
        if (wr == 1) PG8_BAR;
        PG8_WAIT_V(4); PG8_BAR;
        PG8_STAGE(PG8_SB(1, 0), cB + kstep, voffB); PG8_STAGE(PG8_SA(1, 0), cA + kstep, voffA); PG8_STAGE(PG8_SB(1, 1), cB + hstepB + kstep, voffB);
        PG8_WAIT_V(6); PG8_BAR;
    }
    for (;;) {
        const bool has_next = S.next(ui + 1, nxt);
        const char* nA = has_next ? (const char*)g.A + (size_t)nxt.pm * tstep : cA; const char* nB = has_next ? (const char*)g.Bt + (size_t)nxt.pb * tstep : cB;
        for (int t = 0; t < nt; t += 2) {
            const bool last = (t == nt - 2);
            const char* a1 = cA + (size_t)(t + 1) * kstep;
            const char* a2 = last ? nA : cA + (size_t)(t + 2) * kstep; const char* b2 = last ? nB : cB + (size_t)(t + 2) * kstep;
            const char* a3 = a2 + kstep; const char* b3 = b2 + kstep;
            if (last && has_next) S.a_ready(nxt);
            if constexpr (SP2) {
            PG8_LDB(B0, 0, 0); PG8_LDB(B1, 0, 1); PG8_SCHED; PG8_LDA(At, 0, 0); PG8_STAGE(PG8_SA(1, 1), a1 + hstep, voffA);
            PG8_WAIT_V(8); PG8_WAIT_L(0); PG8_BAR; PG8_MMA(0, 0, At, B0); PG8_MMA(0, 1, At, B1); PG8_BAR; PG8_SCHED;
            PG8_LDA(At, 0, 1); PG8_STAGE(PG8_SB(0, 0), b2, voffB); PG8_STAGE(PG8_SB(0, 1), b2 + hstepB, voffB); PG8_STAGE(PG8_SA(0, 0), a2, voffA);
            PG8_WAIT_V(8); PG8_WAIT_L(0); PG8_BAR; PG8_MMA(1, 0, At, B0); PG8_MMA(1, 1, At, B1); PG8_BAR; PG8_SCHED;
            PG8_LDB(B0, 1, 0); PG8_LDB(B1, 1, 1); PG8_SCHED; PG8_LDA(At, 1, 0); PG8_STAGE(PG8_SA(0, 1), a2 + hstep, voffA);
            PG8_WAIT_V(8); PG8_WAIT_L(0); PG8_BAR; PG8_MMA(0, 0, At, B0); PG8_MMA(0, 1, At, B1); PG8_BAR; PG8_SCHED;
            PG8_LDA(At, 1, 1); PG8_STAGE(PG8_SB(1, 0), b3, voffB); PG8_STAGE(PG8_SB(1, 1), b3 + hstepB, voffB); PG8_STAGE(PG8_SA(1, 0), a3, voffA);
            PG8_WAIT_V(8); PG8_WAIT_L(0); PG8_BAR; PG8_MMA(1, 0, At, B0); PG8_MMA(1, 1, At, B1); PG8_BAR; PG8_SCHED;
            } else {
            PG8_LDB(B0, 0, 0); PG8_SCHED; PG8_LDA(At, 0, 0); PG8_STAGE(PG8_SA(1, 1), a1 + hstep, voffA);
            PG8_WAIT_L(8); PG8_BAR; PG8_WAIT_L(0); PG8_MMA(0, 0, At, B0); PG8_BAR; PG8_SCHED;
            PG8_LDB(B1, 0, 1); PG8_STAGE(PG8_SB(0, 0), b2, voffB);
            PG8_BAR; PG8_WAIT_L(0); PG8_MMA(0, 1, At, B1); PG8_BAR;
            PG8_LDA(At, 0, 1); PG8_STAGE(PG8_SA(0, 0), a2, voffA);
            PG8_BAR; PG8_WAIT_L(0); PG8_MMA(1, 0, At, B0); PG8_BAR; PG8_SCHED;
            PG8_STAGE(PG8_SB(0, 1), b2 + hstepB, voffB);
            PG8_WAIT_V(6); PG8_BAR; PG8_MMA(1, 1, At, B1); PG8_BAR;
            PG8_LDB(B0, 1, 0); PG8_SCHED; PG8_LDA(At, 1, 0); PG8_STAGE(PG8_SA(0, 1), a2 + hstep, voffA);
            PG8_WAIT_L(8); PG8_BAR; PG8_WAIT_L(0); PG8_MMA(0, 0, At, B0); PG8_BAR; PG8_SCHED;
            PG8_LDB(B1, 1, 1); PG8_STAGE(PG8_SB(1, 0), b3, voffB);
            PG8_BAR; PG8_WAIT_L(0); PG8_MMA(0, 1, At, B1); PG8_BAR;
            PG8_LDA(At, 1, 1); PG8_STAGE(PG8_SA(1, 0), a3, voffA);
            PG8_BAR; PG8_WAIT_L(0); PG8_MMA(1, 0, At, B0); PG8_BAR; PG8_SCHED;
            PG8_STAGE(PG8_SB(1, 1), b3 + hstepB, voffB);
            PG8_WAIT_V(6); PG8_BAR; PG8_MMA(1, 1, At, B1); PG8_BAR;
            }
        }
        if constexpr (ALIGN_EPI) { if (wr == 0) PG8_BAR; }
        if constexpr (FP8) asm volatile("s_nop 7\n\ts_nop 7\n\ts_nop 7" ::: "memory");
        E(acc, cur, wr, wc, fr, fq);
        if (!has_next) break;
#pragma unroll
        for (int a = 0; a < 2; ++a)
#pragma unroll
            for (int b = 0; b < 2; ++b)
#pragma unroll
                for (int m = 0; m < 4; ++m)
#pragma unroll
                    for (int n = 0; n < 2; ++n) acc[a][b][m][n] = (f32x4){0.f, 0.f, 0.f, 0.f};
        cur = nxt; cA = nA; cB = nB; ++ui;
        if constexpr (ALIGN_EPI) { if (wr == 1) PG8_BAR; }
    }
    PG8_WAIT_V(0);
    if constexpr (!ALIGN_EPI) { if (wr == 0) PG8_BAR; }
    PG8_BAR;
#undef PG8_SA
#undef PG8_SB
#undef PG8_STAGE
#undef PG8_LDA
#undef PG8_LDB
#undef PG8_MMA
#undef PG8_WAIT_V
#undef PG8_WAIT_L
#undef PG8_BAR
#undef PG8_SCHED
}

template <class Epi, class Sched>
__device__ __forceinline__ void gemm_phase_gather_f8(PG8_LAS unsigned char* lds, const Gemm g, const Sched& S, const Epi& E, const PG8_LAS int* tbl) {
    const int tid = threadIdx.x, wid = __builtin_amdgcn_readfirstlane(tid >> 6), lane = tid & 63, wr = wid >> 2, wc = wid & 3, fr = lane & 15, fq = lane >> 4;
    const int K = g.K, nt = K / BK;
    const unsigned rowb = (unsigned)K * 2u;
    unsigned voffB[2]; int RA[2]; unsigned CA[2];
#pragma unroll
    for (int i = 0; i < 2; ++i) { int R, C; stage_rc(tid * 16 + i * 8192, R, C); const int Rb = Epi::PERM ? ((R & ~31) + perm32(R & 31)) : R;
        RA[i] = R; CA[i] = (unsigned)C * 2u; voffB[i] = (unsigned)(Rb * K + C) * 2u; }
    const size_t kstep = (size_t)(BK * 2);
    const size_t hstep = (size_t)HALF * K * 2;
    const size_t tstep = 2 * hstep;
    const unsigned ldsw = (unsigned)wid * 1024u;
    const int aoff = lds_byte(wr * 64 + fr, fq * 8), boff = lds_byte(wc * 32 + fr, fq * 8);
#define PG8_SA(b, h) (((b) * 2 + (h)) * HTB)
#define PG8_SB(b, h) ((4 + (b) * 2 + (h)) * HTB)
#define PG8_STAGE(bufoff, gbase, voff) do { _Pragma("unroll") for (int _i = 0; _i < 2; ++_i) \
        __builtin_amdgcn_global_load_lds((const unsigned*)((const char*)(gbase) + (voff)[_i]), (PG8_LAS unsigned*)(lds + (bufoff) + ldsw + _i * 8192), 16, 0, 0); } while (0)
#define PG8_STAGE_G(bufoff, koff, o0, o1) do { \
        __builtin_amdgcn_global_load_lds((const unsigned*)(gA + (koff) + (o0)), (PG8_LAS unsigned*)(lds + (bufoff) + ldsw), 16, 0, 0); \
        __builtin_amdgcn_global_load_lds((const unsigned*)(gA + (koff) + (o1)), (PG8_LAS unsigned*)(lds + (bufoff) + ldsw + 8192), 16, 0, 0); } while (0)
#define PG8_LDA(dst, b, h) do { _Pragma("unroll") for (int m = 0; m < 4; ++m) _Pragma("unroll") for (int k = 0; k < 2; ++k) dst[m][k] = *(const PG8_LAS bf16x8*)(lds + PG8_SA(b, h) + aoff + m * 2048 + k * 1024); } while (0)
#define PG8_LDB(dst, b, h) do { _Pragma("unroll") for (int n = 0; n < 2; ++n) _Pragma("unroll") for (int k = 0; k < 2; ++k) dst[n][k] = *(const PG8_LAS bf16x8*)(lds + PG8_SB(b, h) + boff + n * 2048 + k * 1024); } while (0)
#define PG8_MMA(ai, bj, At, Bt) do { __builtin_amdgcn_s_setprio(1); _Pragma("unroll") for (int m = 0; m < 4; ++m) _Pragma("unroll") for (int n = 0; n < 2; ++n) { \
        const i32x8 _a = cat8(Bt[n][0], Bt[n][1]), _b = cat8(At[m][0], At[m][1]); asm volatile("v_mfma_f32_16x16x128_f8f6f4 %0, %1, %2, %0" : "+v"(acc[ai][bj][m][n]) : "v"(_a), "v"(_b)); } \
        __builtin_amdgcn_s_setprio(0); } while (0)
#define PG8_WAIT_V(n) asm volatile("s_waitcnt vmcnt(" #n ")" ::: "memory")
#define PG8_WAIT_L(n) asm volatile("s_waitcnt lgkmcnt(" #n ")" ::: "memory")
#define PG8_BAR __builtin_amdgcn_s_barrier()
#define PG8_SCHED __builtin_amdgcn_sched_barrier(0)
#define PG8_OFFS(dst, ui_) do { _Pragma("unroll") for (int _h = 0; _h < 2; ++_h) _Pragma("unroll") for (int _i = 0; _i < 2; ++_i) \
        dst[_h][_i] = (unsigned)tbl[(ui_) * 256 + _h * HALF + RA[_i]] * rowb + CA[_i]; } while (0)
    Unit cur, nxt; int ui = 0;
    if (!S.next(0, cur)) return;
    const char* gA = (const char*)g.A;
    unsigned oc[2][2], on[2][2];
    PG8_OFFS(oc, 0);
    f32x4 acc[2][2][4][2];
#pragma unroll
    for (int a = 0; a < 2; ++a)
#pragma unroll
        for (int b = 0; b < 2; ++b)
#pragma unroll
            for (int m = 0; m < 4; ++m)
#pragma unroll
                for (int n = 0; n < 2; ++n) acc[a][b][m][n] = (f32x4){0.f, 0.f, 0.f, 0.f};
    bf16x8 At[4][2], B0[2][2], B1[2][2];
    const char* cB = (const char*)g.Bt + (size_t)cur.pb * tstep;
    PG8_STAGE(PG8_SB(0, 0), cB, voffB); PG8_STAGE(PG8_SB(0, 1), cB + hstep, voffB); PG8_STAGE_G(PG8_SA(0, 0), 0, oc[0][0], oc[0][1]); PG8_STAGE_G(PG8_SA(0, 1), 0, oc[1][0], oc[1][1]);
    if (wr == 1) PG8_BAR;
    PG8_WAIT_V(2); PG8_BAR;
    PG8_STAGE(PG8_SB(1, 0), cB + kstep, voffB); PG8_STAGE_G(PG8_SA(1, 0), kstep, oc[0][0], oc[0][1]); PG8_STAGE(PG8_SB(1, 1), cB + hstep + kstep, voffB);
    PG8_WAIT_V(6); PG8_BAR;
    for (;;) {
        const bool has_next = S.next(ui + 1, nxt);
        const char* nB = has_next ? (const char*)g.Bt + (size_t)nxt.pb * tstep : cB;
        if (has_next) PG8_OFFS(on, ui + 1);
        else {
#pragma unroll
            for (int _h = 0; _h < 2; ++_h)
#pragma unroll
                for (int _i = 0; _i < 2; ++_i) on[_h][_i] = oc[_h][_i]; }
        for (int t = 0; t < nt; t += 2) {
            const bool last = (t == nt - 2);
            const size_t k1 = (size_t)(t + 1) * kstep, k2 = last ? 0 : (size_t)(t + 2) * kstep, k3 = k2 + kstep;
            const char* b2 = last ? nB : cB + (size_t)(t + 2) * kstep; const char* b3 = b2 + kstep;
            const unsigned o00 = last ? on[0][0] : oc[0][0], o01 = last ? on[0][1] : oc[0][1], o10 = last ? on[1][0] : oc[1][0], o11 = last ? on[1][1] : oc[1][1];
            PG8_LDB(B0, 0, 0); PG8_LDB(B1, 0, 1); PG8_SCHED; PG8_LDA(At, 0, 0); PG8_STAGE_G(PG8_SA(1, 1), k1, oc[1][0], oc[1][1]);
            PG8_WAIT_V(8); PG8_WAIT_L(0); PG8_BAR; PG8_MMA(0, 0, At, B0); PG8_MMA(0, 1, At, B1); PG8_BAR; PG8_SCHED;
            PG8_LDA(At, 0, 1); PG8_STAGE(PG8_SB(0, 0), b2, voffB); PG8_STAGE(PG8_SB(0, 1), b2 + hstep, voffB); PG8_STAGE_G(PG8_SA(0, 0), k2, o00, o01);
            PG8_WAIT_V(8); PG8_WAIT_L(0); PG8_BAR; PG8_MMA(1, 0, At, B0); PG8_MMA(1, 1, At, B1); PG8_BAR; PG8_SCHED;
            PG8_LDB(B0, 1, 0); PG8_LDB(B1, 1, 1); PG8_SCHED; PG8_LDA(At, 1, 0); PG8_STAGE_G(PG8_SA(0, 1), k2, o10, o11);
            PG8_WAIT_V(8); PG8_WAIT_L(0); PG8_BAR; PG8_MMA(0, 0, At, B0); PG8_MMA(0, 1, At, B1); PG8_BAR; PG8_SCHED;
            PG8_LDA(At, 1, 1); PG8_STAGE(PG8_SB(1, 0), b3, voffB); PG8_STAGE(PG8_SB(1, 1), b3 + hstep, voffB); PG8_STAGE_G(PG8_SA(1, 0), k3, o00, o01);
            PG8_WAIT_V(8); PG8_WAIT_L(0); PG8_BAR; PG8_MMA(1, 0, At, B0); PG8_MMA(1, 1, At, B1); PG8_BAR; PG8_SCHED;
        }
        if (wr == 0) PG8_BAR;
        asm volatile("s_nop 7\n\ts_nop 7\n\ts_nop 7" ::: "memory");
        E(acc, cur, wr, wc, fr, fq);
        if (!has_next) break;
#pragma unroll
        for (int a = 0; a < 2; ++a)
#pragma unroll
            for (int b = 0; b < 2; ++b)
#pragma unroll
                for (int m = 0; m < 4; ++m)
#pragma unroll
                    for (int n = 0; n < 2; ++n) acc[a][b][m][n] = (f32x4){0.f, 0.f, 0.f, 0.f};
        cur = nxt; cB = nB; ++ui;
#pragma unroll
        for (int _h = 0; _h < 2; ++_h)
#pragma unroll
            for (int _i = 0; _i < 2; ++_i) oc[_h][_i] = on[_h][_i];
        if (wr == 1) PG8_BAR;
    }
    PG8_WAIT_V(0);
    PG8_BAR;
#undef PG8_SA
#undef PG8_SB
#undef PG8_STAGE
#undef PG8_STAGE_G
#undef PG8_LDA
#undef PG8_LDB
#undef PG8_MMA
#undef PG8_WAIT_V
#undef PG8_WAIT_L
#undef PG8_BAR
#undef PG8_SCHED
#undef PG8_OFFS
}
}

constexpr int D = 2048, NB = 2, SEQ = 16384, NT = NB * SEQ, CTXL = 256, NCTX = NB * CTXL, MTOT = NT + NCTX;
constexpr int NEXP = 16, CAP = 2048, FF = 1024, GRIDW = 64, NROWS = 256;
constexpr float EPS = 1e-6f;
constexpr float LOG2E = 1.4426950408889634f;
constexpr int NWAVES = 8;

constexpr size_t MiB = 1u << 20;
constexpr size_t WS_CTL = 0, CTL_ZERO_BYTES = 1 * MiB;
constexpr size_t CTL_TOKCNT0 = 262144, CTL_TOKCNT1 = 393216, CTL_BAR = 524288;
constexpr size_t WS_MOD = 1 * MiB;
constexpr size_t WS_AFF = 2 * MiB;
constexpr size_t WS_IDX = 4 * MiB;
constexpr size_t WS_TOKLIST = 5 * MiB;
constexpr size_t WS_WSB = 9 * MiB;
constexpr size_t WS_WIN0 = 10 * MiB, WS_WOUT0 = 30 * MiB, WS_WCIN = 38 * MiB, WS_WCOUT = 62 * MiB;
constexpr size_t WS_GU = 70 * MiB;
constexpr size_t WS_DN = 326 * MiB;
constexpr size_t WS_H = 454 * MiB;
constexpr size_t WS_R2 = 584 * MiB;
constexpr size_t WS_R3 = 968 * MiB;
constexpr size_t WS_H8 = 1224 * MiB;
constexpr size_t WS_END = 1289 * MiB;
constexpr size_t WS_WIN0F8 = WS_WIN0 + 8 * MiB;
constexpr size_t WS_XLB = WS_R2 + 256 * MiB;
constexpr size_t WS_HID = WS_R2 + 128 * MiB;
static_assert(MK_FP8_L0 && MK_FP8_L1, "the workspace map assumes fp8 MoE activations");
constexpr size_t R2_T = (size_t)MTOT * 1024;

constexpr int LDS_SCR = 0;
constexpr int LDSCTL_OFF = 146944, MISC_OFF = LDSCTL_OFF;
constexpr int LDS_KPART = 131072;
constexpr int LDS_GTBL = 138752;
constexpr int LDS_BYTES = 147456;

#define GAS __attribute__((address_space(1)))
#define LAS __attribute__((address_space(3)))
#define DI __device__ __forceinline__
typedef unsigned short bf16;
typedef unsigned v4u __attribute__((ext_vector_type(4)));
typedef unsigned v2u __attribute__((ext_vector_type(2)));
typedef float f32x4 __attribute__((ext_vector_type(4)));
typedef float f32x16 __attribute__((ext_vector_type(16)));
typedef short bf16x8 __attribute__((ext_vector_type(8)));
typedef short s16x4 __attribute__((ext_vector_type(4)));
typedef GAS unsigned gu32;
#define RLX_AGENT __ATOMIC_RELAXED, __HIP_MEMORY_SCOPE_AGENT
#define LDS_WAIT() asm volatile("s_waitcnt lgkmcnt(0)" ::: "memory")
#define VM_WAIT() asm volatile("s_waitcnt vmcnt(0)" ::: "memory")
DI float bf_lo(unsigned u) { return __uint_as_float(u << 16); }
DI float bf_hi(unsigned u) { return __uint_as_float(u & 0xffff0000u); }
DI unsigned pk2(float lo, float hi) { return pg8::cvt_pk_bf16(lo, hi); }
constexpr float F8_WSCALE = 64.0f, F8_WINV = 1.0f / 64.0f;
DI float clamp448(float x) { return __builtin_amdgcn_fmed3f(x, -448.0f, 448.0f); }
DI unsigned pk4_fp8(float a, float b, float c, float d) { int p = __builtin_amdgcn_cvt_pk_fp8_f32(clamp448(a), clamp448(b), 0, false); p = __builtin_amdgcn_cvt_pk_fp8_f32(clamp448(c), clamp448(d), p, true); return (unsigned)p; }
DI float wave_sum(float v) {
#pragma unroll
    for (int o = 1; o < 64; o <<= 1) v += __shfl_xor(v, o);
    return v;
}
DI int wave_sum_i(int v) {
#pragma unroll
    for (int o = 1; o < 64; o <<= 1) v += __shfl_xor(v, o);
    return v;
}
DI float fast_rcp(float x) { return __builtin_amdgcn_rcpf(x); }
DI float fast_exp2(float x) { return __builtin_amdgcn_exp2f(x); }
DI float sigmoidf_(float z) { return fast_rcp(1.0f + fast_exp2(-z * LOG2E)); }
DI float gelu_tanh(float x) { const float z = 1.5957691216057308f * (x + 0.044715f * x * x * x); return x * sigmoidf_(z); }
DI float siluf_(float x) { return x * sigmoidf_(x); }

#define XB_TMO      128
#define XB_XCNT(j)  (256  + 64 * (j))
#define XB_XSUB(j)  (1280 + 64 * (j))
#define XB_XGEN(j)  (2304 + 64 * (j))
#define XB_TOP      3328
#define XB_TOPGEN   3392
#define XCD_BAR_WORDS 3456
#define XB_SPIN_CAP (1u << 18)

__device__ __forceinline__ unsigned xb_ld(unsigned* p)              { return __hip_atomic_load(p, __ATOMIC_RELAXED, __HIP_MEMORY_SCOPE_AGENT); }
__device__ __forceinline__ unsigned xb_add(unsigned* p, unsigned v) { return __hip_atomic_fetch_add(p, v, __ATOMIC_RELAXED, __HIP_MEMORY_SCOPE_AGENT); }
__device__ __forceinline__ unsigned xb_xcc_id() { return (unsigned)__builtin_amdgcn_s_getreg((3 << 11) | 20) & 0xFu; }
#define XB_SPIN(cond, bar) do { unsigned _sp = 0; while (cond) { __builtin_amdgcn_s_sleep(1); \
    if ((++_sp & 255u) == 0u) { if (xb_ld(&(bar)[XB_TMO])) break; if (_sp > XB_SPIN_CAP) { atomicAdd(&(bar)[XB_TMO], 1u); break; } } } } while (0)

struct XcdBarrier {
    unsigned* bar; unsigned x;
    volatile LAS unsigned* st;
};
__device__ __forceinline__ XcdBarrier xcd_barrier_post(unsigned* bar, volatile LAS unsigned* st) {
    XcdBarrier b; b.bar = bar; b.x = xb_xcc_id(); b.st = st;
    if (threadIdx.x == 0) (void)xb_add(&bar[XB_XCNT(b.x)], 1u);
    return b;
}
__device__ __forceinline__ void xcd_barrier_complete(unsigned* bar, unsigned x, unsigned& nloc, unsigned& nx) {
    const unsigned G = gridDim.x * gridDim.y * gridDim.z;
    unsigned sum, cnt, mine, sp = 0u;
    for (;;) {
        sum = 0u; cnt = 0u; mine = 0u;
#pragma unroll
        for (unsigned j = 0; j < 16; ++j) { const unsigned c = xb_ld(&bar[XB_XCNT(j)]); sum += c; cnt += (c > 0u) ? 1u : 0u; mine = (j == x) ? c : mine; }
        if (sum == G) break;
        __builtin_amdgcn_s_sleep(1);
        if ((++sp & 255u) == 0u) { if (xb_ld(&bar[XB_TMO])) break; if (sp > XB_SPIN_CAP) { atomicAdd(&bar[XB_TMO], 1u); break; } }
    }
    nloc = mine > 0u ? mine : 1u; nx = cnt > 0u ? cnt : 1u;
}
__device__ __forceinline__ void xcd_barrier(const XcdBarrier& b) {
    asm volatile("s_waitcnt vmcnt(0)" ::: "memory");
    __syncthreads();
    if (threadIdx.x == 0) {
        unsigned* bar = b.bar;
        __builtin_amdgcn_s_waitcnt(0);
        unsigned nloc = b.st[0], nx = b.st[1];
        if (nloc == 0u) { xcd_barrier_complete(bar, b.x, nloc, nx); b.st[0] = nloc; b.st[1] = nx; }
        const unsigned old = xb_add(&bar[XB_XSUB(b.x)], 1u);
        const unsigned gen = old / nloc;
        if (old + 1u == (gen + 1u) * nloc) {
            __builtin_amdgcn_fence(__ATOMIC_RELEASE, "agent");
            asm volatile("s_waitcnt vmcnt(0)" ::: "memory");
            const unsigned og = xb_add(&bar[XB_TOP], 1u);
            const unsigned tg = og / nx;
            if (og + 1u == (tg + 1u) * nx) xb_add(&bar[XB_TOPGEN], 1u);
            else XB_SPIN(xb_ld(&bar[XB_TOPGEN]) == tg, bar);
            __builtin_amdgcn_fence(__ATOMIC_ACQUIRE, "agent");
            xb_add(&bar[XB_XGEN(b.x)], 1u);
            asm volatile("s_waitcnt vmcnt(0)" ::: "memory");
        } else {
            XB_SPIN(xb_ld(&bar[XB_XGEN(b.x)]) == gen, bar);
            __builtin_amdgcn_fence(__ATOMIC_ACQUIRE, "agent");
            asm volatile("s_waitcnt vmcnt(0)" ::: "memory");
        }
    }
    __syncthreads();
}

using pg8::Unit; using pg8::BM; using pg8::HALF;
struct EpiIn0 {
    static constexpr int PERM = 2;
    bf16* O; int tbase; float sc; const float* gk; LAS float* part;
    DI void operator()(const f32x4 (&acc)[2][2][4][2], const Unit& u, int wr, int wc, int fr, int fq) const {
        const int row0 = u.pm * BM + wr * 64 + fr; const int t = tbase + (u.pn >> 2); const int colt = (u.pn & 3) * BM;
        bf16* base = O + (size_t)t * R2_T; const int col0 = colt + wc * 64 + 8 * fq; const bool act = t < 2;
        if (t == 3) {
            float ssv[2][4];
#pragma unroll
            for (int ai = 0; ai < 2; ++ai)
#pragma unroll
                for (int m = 0; m < 4; ++m) { float q = 0.f;
#pragma unroll
                    for (int bj = 0; bj < 2; ++bj)
#pragma unroll
                        for (int n = 0; n < 2; ++n) { const f32x4 v = acc[ai][bj][m][n] * sc; q += (v[0] * v[0] + v[1] * v[1]) + (v[2] * v[2] + v[3] * v[3]); }
                    q += __shfl_xor(q, 16); q += __shfl_xor(q, 32); ssv[ai][m] = q;
                    if (fq == 0) part[(ai * HALF + wr * 64 + m * 16 + fr) * 4 + wc] = q; }
            asm volatile("s_waitcnt lgkmcnt(0)" ::: "memory"); __builtin_amdgcn_s_barrier(); asm volatile("" ::: "memory");
            f32x4 gv[2][2];
#pragma unroll
            for (int bj = 0; bj < 2; ++bj)
#pragma unroll
                for (int n = 0; n < 2; ++n) gv[bj][n] = *(const f32x4*)(gk + 64 * (wc & 1) + 32 * bj + 8 * fq + 4 * n);
#pragma unroll
            for (int ai = 0; ai < 2; ++ai)
#pragma unroll
                for (int m = 0; m < 4; ++m) { const float tot = ssv[ai][m] + part[(ai * HALF + wr * 64 + m * 16 + fr) * 4 + (wc ^ 1)];
                    const float rstd = 1.0f / sqrtf(tot * (1.0f / 128.0f) + EPS);
                    bf16* rowp = base + (size_t)(row0 + ai * HALF + m * 16) * 1024 + col0;
#pragma unroll
                    for (int bj = 0; bj < 2; ++bj) { const f32x4 v0 = acc[ai][bj][m][0] * (sc * rstd) * gv[bj][0], v1 = acc[ai][bj][m][1] * (sc * rstd) * gv[bj][1];
                        v4u w; w.x = pk2(v0[0], v0[1]); w.y = pk2(v0[2], v0[3]); w.z = pk2(v1[0], v1[1]); w.w = pk2(v1[2], v1[3]);
                        *(v4u*)(rowp + bj * 32) = w; } }
            return;
        }
#pragma unroll
        for (int ai = 0; ai < 2; ++ai)
#pragma unroll
            for (int m = 0; m < 4; ++m) { bf16* rowp = base + (size_t)(row0 + ai * HALF + m * 16) * 1024 + col0;
#pragma unroll
                for (int bj = 0; bj < 2; ++bj) { f32x4 v0 = acc[ai][bj][m][0] * sc, v1 = acc[ai][bj][m][1] * sc;
                    if (act) {
#pragma unroll
                        for (int j = 0; j < 4; ++j) { v0[j] = gelu_tanh(v0[j]); v1[j] = gelu_tanh(v1[j]); } }
                    v4u w; w.x = pk2(v0[0], v0[1]); w.y = pk2(v0[2], v0[3]); w.z = pk2(v1[0], v1[1]); w.w = pk2(v1[2], v1[3]);
                    if (act) __builtin_nontemporal_store(w, (v4u*)(rowp + bj * 32)); else *(v4u*)(rowp + bj * 32) = w; } }
    }
};
struct OneUnit {
    int pm, pn;
    __device__ __forceinline__ bool next(int i, Unit& u) const { if (i != 0) return false; u.pm = pm; u.pn = pn; u.pb = pn; return true; }
    DI void a_ready(const Unit&) const {}
    DI void done(const Unit&) const {}
};
template <bool BASE_F32>
struct EpiResid {
    static constexpr int PERM = 2;
    const void* base; bf16* out; const float* gate0;
    DI void operator()(const f32x4 (&acc)[2][2][4][2], const Unit& u, int wr, int wc, int fr, int fq) const {
        const int row0 = u.pm * BM + wr * 64 + fr, col0 = u.pn * BM + wc * 64 + 8 * fq;
        const float* gate = gate0 + (size_t)((u.pm * BM) >> 14) * 12288;
        f32x4 gv[2][2];
#pragma unroll
        for (int bj = 0; bj < 2; ++bj)
#pragma unroll
            for (int n = 0; n < 2; ++n) gv[bj][n] = *(const f32x4*)(gate + col0 + bj * 32 + n * 4);
#pragma unroll
        for (int ai = 0; ai < 2; ++ai)
#pragma unroll
            for (int m = 0; m < 4; ++m) { const size_t off = (size_t)(row0 + ai * HALF + m * 16) * D + col0;
#pragma unroll
                for (int bj = 0; bj < 2; ++bj) { f32x4 b0, b1;
                    if constexpr (BASE_F32) { b0 = __builtin_nontemporal_load((const f32x4*)((const float*)base + off + bj * 32)); b1 = __builtin_nontemporal_load((const f32x4*)((const float*)base + off + bj * 32 + 4)); }
                    else { const v4u w = *(const v4u*)((const bf16*)base + off + bj * 32); b0 = (f32x4){bf_lo(w.x), bf_hi(w.x), bf_lo(w.y), bf_hi(w.y)}; b1 = (f32x4){bf_lo(w.z), bf_hi(w.z), bf_lo(w.w), bf_hi(w.w)}; }
                    const f32x4 v0 = b0 + gv[bj][0] * acc[ai][bj][m][0], v1 = b1 + gv[bj][1] * acc[ai][bj][m][1];
                    v4u o; o.x = pk2(v0[0], v0[1]); o.y = pk2(v0[2], v0[3]); o.z = pk2(v1[0], v1[1]); o.w = pk2(v1[2], v1[3]);
                    *(v4u*)(out + off + bj * 32) = o; } }
    }
};
template <bool F8>
struct EpiSwiglu {
    static constexpr int PERM = 1;
    void* O;
    DI void operator()(const f32x4 (&acc)[2][2][4][2], const Unit& u, int wr, int wc, int fr, int fq) const {
        const int row0 = u.pm * BM + wr * 64 + fr, col0 = u.pn * HALF + wc * 32 + 8 * fq;
        const float sc = F8 ? F8_WINV : 1.0f;
        if constexpr (F8) {
            const int colw = u.pn * HALF + wc * 32 + 8 * (fq & ~1);
#pragma unroll
            for (int ai = 0; ai < 2; ++ai)
#pragma unroll
                for (int mp = 0; mp < 2; ++mp) { v2u w[2];
#pragma unroll
                    for (int x = 0; x < 2; ++x) { const int m = 2 * mp + x;
                        f32x4 g0 = acc[ai][0][m][0] * sc, g1 = acc[ai][0][m][1] * sc; const f32x4 u0 = acc[ai][1][m][0] * sc, u1 = acc[ai][1][m][1] * sc;
#pragma unroll
                        for (int j = 0; j < 4; ++j) { g0[j] = siluf_(g0[j]) * u0[j]; g1[j] = siluf_(g1[j]) * u1[j]; }
                        w[x].x = pk4_fp8(g0[0], g0[1], g0[2], g0[3]); w[x].y = pk4_fp8(g1[0], g1[1], g1[2], g1[3]); }
                    const auto rx = __builtin_amdgcn_permlane16_swap(w[0].x, w[1].x, false, false); const auto ry = __builtin_amdgcn_permlane16_swap(w[0].y, w[1].y, false, false);
                    v4u o; o.x = rx[0]; o.y = ry[0]; o.z = rx[1]; o.w = ry[1];
                    *(v4u*)((unsigned char*)O + (size_t)(row0 + ai * HALF + (2 * mp + (fq & 1)) * 16) * FF + colw) = o; }
            return;
        }
#pragma unroll
        for (int ai = 0; ai < 2; ++ai)
#pragma unroll
            for (int m = 0; m < 4; ++m) { const size_t eo = (size_t)(row0 + ai * HALF + m * 16) * FF + col0;
                f32x4 g0 = acc[ai][0][m][0] * sc, g1 = acc[ai][0][m][1] * sc; const f32x4 u0 = acc[ai][1][m][0] * sc, u1 = acc[ai][1][m][1] * sc;
#pragma unroll
                for (int j = 0; j < 4; ++j) { g0[j] = siluf_(g0[j]) * u0[j]; g1[j] = siluf_(g1[j]) * u1[j]; }
                { v4u w; w.x = pk2(g0[0], g0[1]); w.y = pk2(g0[2], g0[3]); w.z = pk2(g1[0], g1[1]); w.w = pk2(g1[2], g1[3]); *(v4u*)((bf16*)O + eo) = w; } }
    }
};
struct EpiPlain {
    static constexpr int PERM = 2;
    unsigned char* O; int ldc; float sc; int nostore;
    DI void operator()(const f32x4 (&acc)[2][2][4][2], const Unit& u, int wr, int wc, int fr, int fq) const {
        if (nostore == 1) return;
        const int row0 = u.pm * BM + wr * 64 + fr, col0 = u.pn * BM + wc * 64 + ((fq & 1) ? 24 + 8 * fq : 8 * fq);
#pragma unroll
        for (int ai = 0; ai < 2; ++ai)
#pragma unroll
            for (int m = 0; m < 4; ++m) { unsigned char* rowp = O + (size_t)(row0 + ai * HALF + m * 16) * ldc + col0;
                v2u w[2];
#pragma unroll
                for (int bj = 0; bj < 2; ++bj) { const f32x4 v0 = acc[ai][bj][m][0] * sc, v1 = acc[ai][bj][m][1] * sc;
                    w[bj].x = pk4_fp8(v0[0], v0[1], v0[2], v0[3]); w[bj].y = pk4_fp8(v1[0], v1[1], v1[2], v1[3]); }
                const auto rx = __builtin_amdgcn_permlane16_swap(w[0].x, w[1].x, false, false); const auto ry = __builtin_amdgcn_permlane16_swap(w[0].y, w[1].y, false, false);
                v4u o; o.x = rx[0]; o.y = ry[0]; o.z = rx[1]; o.w = ry[1];
                __builtin_nontemporal_store(o, (v4u*)rowp); }
    }
};
struct EpiCin {
    static constexpr int PERM = 1;
    bf16* BG; bf16* CZ; int nostore;
    DI void operator()(const f32x4 (&acc)[2][2][4][2], const Unit& u, int wr, int wc, int fr, int fq) const {
        if (nostore) return;
        const int row0 = u.pm * BM + wr * 64 + fr;
        if (u.pn < 8) {
            const int col0 = u.pn * BM + wc * 32 + 8 * fq;
#pragma unroll
            for (int ai = 0; ai < 2; ++ai)
#pragma unroll
                for (int m = 0; m < 4; ++m) { bf16* rowp = BG + (size_t)(row0 + ai * HALF + m * 16) * D + col0;
#pragma unroll
                    for (int bj = 0; bj < 2; ++bj) { const f32x4 v0 = acc[ai][bj][m][0], v1 = acc[ai][bj][m][1];
                        v4u w; w.x = pk2(v0[0], v0[1]); w.y = pk2(v0[2], v0[3]); w.z = pk2(v1[0], v1[1]); w.w = pk2(v1[2], v1[3]);
                        *(v4u*)(rowp + bj * HALF) = w; } }
        } else {
            const int col0 = (u.pn - 8) * HALF + wc * 32 + 8 * fq;
#pragma unroll
            for (int ai = 0; ai < 2; ++ai)
#pragma unroll
                for (int m = 0; m < 4; ++m) { bf16* rowp = CZ + (size_t)(row0 + ai * HALF + m * 16) * D + col0;
                    const f32x4 p0 = acc[ai][0][m][0] * acc[ai][1][m][0], p1 = acc[ai][0][m][1] * acc[ai][1][m][1];
                    v4u w; w.x = pk2(p0[0], p0[1]); w.y = pk2(p0[2], p0[3]); w.z = pk2(p1[0], p1[1]); w.w = pk2(p1[2], p1[3]);
                    *(v4u*)rowp = w; }
        }
    }
};

DI unsigned off_b(unsigned row, unsigned ch) { return 256u * row + 16u * (ch ^ (((row & 3) << 2) | ((row >> 2) & 3))); }
DI bf16x8 row_frag(const LAS unsigned char* img, int lane, int s) { return *(const LAS bf16x8*)(img + off_b(lane & 31, 2 * s + (lane >> 5))); }
template <bool KROW>
DI bf16x8 tr_frag(const LAS unsigned char* img, int lane, int c, int ks) {
    const unsigned h = lane >> 5, blk = (lane >> 4) & 1, q = (lane & 15) >> 2, p = lane & 3;
    const unsigned r0 = KROW ? (16 * ks + 4 * h + q) : (16 * ks + 8 * h + q), r1 = KROW ? (r0 + 8) : (r0 + 4);
    const unsigned ch = 4 * c + 2 * blk + (p >> 1), sub = 8 * (p & 1);
    const s16x4 lo = __builtin_amdgcn_ds_read_tr16_b64_v4i16((LAS s16x4*)(img + off_b(r0, ch) + sub));
    const s16x4 hi = __builtin_amdgcn_ds_read_tr16_b64_v4i16((LAS s16x4*)(img + off_b(r1, ch) + sub));
    return __builtin_shufflevector(lo, hi, 0, 1, 2, 3, 4, 5, 6, 7);
}
DI void tr_frag4_krow(bf16x8 (&a)[4], const LAS unsigned char* img, int lane, int ks) {
    const unsigned h = lane >> 5, blk = (lane >> 4) & 1, q = (lane & 15) >> 2, p = lane & 3;
    const unsigned r0 = 16 * ks + 4 * h + q, r1 = r0 + 8, sub = 8 * (p & 1);
    const unsigned base = (unsigned)(unsigned long)img;
    unsigned al[4], ah[4];
#pragma unroll
    for (int c = 0; c < 4; ++c) { const unsigned ch = 4 * c + 2 * blk + (p >> 1); al[c] = base + off_b(r0, ch) + sub; ah[c] = base + off_b(r1, ch) + sub; }
    s16x4 l0, l1, l2, l3, h0, h1, h2, h3;
    asm volatile("ds_read_b64_tr_b16 %0, %8\n\tds_read_b64_tr_b16 %1, %9\n\tds_read_b64_tr_b16 %2, %10\n\tds_read_b64_tr_b16 %3, %11\n\t"
                 "ds_read_b64_tr_b16 %4, %12\n\tds_read_b64_tr_b16 %5, %13\n\tds_read_b64_tr_b16 %6, %14\n\tds_read_b64_tr_b16 %7, %15\n\ts_waitcnt lgkmcnt(0)"
                 : "=&v"(l0), "=&v"(l1), "=&v"(l2), "=&v"(l3), "=&v"(h0), "=&v"(h1), "=&v"(h2), "=&v"(h3)
                 : "v"(al[0]), "v"(al[1]), "v"(al[2]), "v"(al[3]), "v"(ah[0]), "v"(ah[1]), "v"(ah[2]), "v"(ah[3]) : "memory");
    a[0] = __builtin_shufflevector(l0, h0, 0, 1, 2, 3, 4, 5, 6, 7); a[1] = __builtin_shufflevector(l1, h1, 0, 1, 2, 3, 4, 5, 6, 7);
    a[2] = __builtin_shufflevector(l2, h2, 0, 1, 2, 3, 4, 5, 6, 7); a[3] = __builtin_shufflevector(l3, h3, 0, 1, 2, 3, 4, 5, 6, 7);
}
template <int OFF>
DI void tr_frag4_pre(bf16x8 (&a)[4], const unsigned (&al)[4], const unsigned (&ah)[4]) {
    s16x4 l0, l1, l2, l3, h0, h1, h2, h3;
    asm volatile("ds_read_b64_tr_b16 %0, %8 offset:%16\n\tds_read_b64_tr_b16 %1, %9 offset:%16\n\tds_read_b64_tr_b16 %2, %10 offset:%16\n\tds_read_b64_tr_b16 %3, %11 offset:%16\n\t"
                 "ds_read_b64_tr_b16 %4, %12 offset:%16\n\tds_read_b64_tr_b16 %5, %13 offset:%16\n\tds_read_b64_tr_b16 %6, %14 offset:%16\n\tds_read_b64_tr_b16 %7, %15 offset:%16\n\ts_waitcnt lgkmcnt(0)"
                 : "=&v"(l0), "=&v"(l1), "=&v"(l2), "=&v"(l3), "=&v"(h0), "=&v"(h1), "=&v"(h2), "=&v"(h3)
                 : "v"(al[0]), "v"(al[1]), "v"(al[2]), "v"(al[3]), "v"(ah[0]), "v"(ah[1]), "v"(ah[2]), "v"(ah[3]), "n"(OFF) : "memory");
    a[0] = __builtin_shufflevector(l0, h0, 0, 1, 2, 3, 4, 5, 6, 7); a[1] = __builtin_shufflevector(l1, h1, 0, 1, 2, 3, 4, 5, 6, 7);
    a[2] = __builtin_shufflevector(l2, h2, 0, 1, 2, 3, 4, 5, 6, 7); a[3] = __builtin_shufflevector(l3, h3, 0, 1, 2, 3, 4, 5, 6, 7);
}
DI int crow(int reg, int h) { return (reg & 3) + 8 * (reg >> 2) + 4 * h; }
#define MFMA32(a, b, c) __builtin_amdgcn_mfma_f32_32x32x16_bf16((a), (b), (c), 0, 0, 0)

struct Params { const float* in[23]; float* out; unsigned char* ws; int ph_lo, ph_hi, li, pad; };
typedef const __attribute__((address_space(4))) Params* KP;
DI KP kparams() { KP p = (KP)__builtin_amdgcn_kernarg_segment_ptr(); asm volatile("" : "+s"(p)); return p; }
enum { I_X = 0, I_C, I_CTX, I_CCTX, I_ADAW, I_ADAB, I_N1G, I_N2G, I_ABWIN, I_ABWOUT, I_AWS, I_ABS, I_AVG, I_BQG, I_BKG, I_RPB, I_CWIN, I_CONVW, I_CWOUT, I_ROUTER, I_WGATE, I_WUP, I_WDOWN };

struct XItem { const float* src; unsigned char* dst; int N, Kd, k0, dstrow0, f8; };
DI void xpose_load(const XItem& d, f32x4 (&v)[16], int lane) {
    const GAS f32x4* src = (const GAS f32x4*)d.src; const int lr = lane >> 4, lc = lane & 15;
#pragma unroll
    for (int i = 0; i < 16; ++i) v[i] = __builtin_nontemporal_load(src + (size_t)(lr + 4 * i) * (d.N / 4) + lc);
}
DI void xpose_store(const XItem& d, const f32x4 (&v)[16], LAS float* scr, int lane) {
    const int lr = lane >> 4, lc = lane & 15;
#pragma unroll
    for (int i = 0; i < 16; ++i) { LAS float* p = scr + (lr + 4 * i) * 65 + 4 * lc; p[0] = v[i].x; p[1] = v[i].y; p[2] = v[i].z; p[3] = v[i].w; }
    LDS_WAIT(); asm volatile("" ::: "memory");
    if (d.f8) {
        const int c = lane & 3;
#pragma unroll
        for (int i = 0; i < 4; ++i) { const int n = 16 * i + (lane >> 2); const LAS float* s = scr + (16 * c) * 65 + n;
            v4u o;
            o.x = pk4_fp8(s[0 * 65] * F8_WSCALE, s[1 * 65] * F8_WSCALE, s[2 * 65] * F8_WSCALE, s[3 * 65] * F8_WSCALE); o.y = pk4_fp8(s[4 * 65] * F8_WSCALE, s[5 * 65] * F8_WSCALE, s[6 * 65] * F8_WSCALE, s[7 * 65] * F8_WSCALE);
            o.z = pk4_fp8(s[8 * 65] * F8_WSCALE, s[9 * 65] * F8_WSCALE, s[10 * 65] * F8_WSCALE, s[11 * 65] * F8_WSCALE); o.w = pk4_fp8(s[12 * 65] * F8_WSCALE, s[13 * 65] * F8_WSCALE, s[14 * 65] * F8_WSCALE, s[15 * 65] * F8_WSCALE);
            *(GAS v4u*)(d.dst + (size_t)(d.dstrow0 + n) * d.Kd + d.k0 + 16 * c) = o; }
    } else {
        const int c = lane & 7;
#pragma unroll
        for (int i = 0; i < 8; ++i) { const int n = 8 * i + (lane >> 3); const LAS float* s = scr + (8 * c) * 65 + n;
            v4u o; o.x = pk2(s[0 * 65], s[1 * 65]); o.y = pk2(s[2 * 65], s[3 * 65]); o.z = pk2(s[4 * 65], s[5 * 65]); o.w = pk2(s[6 * 65], s[7 * 65]);
            *(GAS v4u*)((bf16*)d.dst + (size_t)(d.dstrow0 + n) * d.Kd + d.k0 + 8 * c) = o; }
    }
    LDS_WAIT(); asm volatile("" ::: "memory");
}
DI int ilv_row(int j, int hv) { return ((j >> 7) << 8) + hv * 128 + (j & 127); }

#define F8L(l) ((l) == 0 ? (MK_FP8_L0 != 0) : (MK_FP8_L1 != 0))
DI void xpose_range(KP P, LAS unsigned char* lds, int lane, int wave, int mode, int w, int nw) {
    unsigned char* ws = P->ws;
    LAS float* scr = (LAS float*)(lds + LDS_SCR + wave * 16640);
    constexpr int I0 = 32 * 80, I1 = 32 * 32, I2 = 32 * 96, I3 = 32 * 32, IM = 512, I4 = 32 * IM, IB = I0 + I1 + I2 + I3, IH = I4 / 2;
    const int nlist = mode == 0 ? IB : ((mode == 4 || mode == 3) ? 3 * IH : (3 * IH) / 2);
    auto item_id = [&](int j) -> int {
        if (mode == 0) return j;
        if (mode == 4) return IB + (j / IH) * I4 + (j % IH);
        if (mode == 3) return IB + (j / IH) * I4 + IH + (j % IH);
        const int q = j + (mode == 2 ? (3 * IH) / 2 : 0); return IB + (q / IH) * I4 + IH + (q % IH);
    };
    auto decode = [&](int it, XItem& d) {
        int r = it;
        if (r < I0) { const int kb = r / 80, nb = r % 80; const bool f8 = nb >= 32;
            d = XItem{P->in[I_ABWIN] + (size_t)(kb * 64) * 5120 + nb * 64, f8 ? ws + WS_WIN0F8 : ws + WS_WIN0, 5120, 2048, kb * 64, f8 ? nb * 64 - 2048 : nb * 64, f8 ? 1 : 0}; return; } r -= I0;
        if (r < I1) { const int kb = r / 32, nb = r % 32; d = XItem{P->in[I_ABWOUT] + (size_t)(kb * 64) * 2048 + nb * 64, ws + WS_WOUT0, 2048, 2048, kb * 64, nb * 64, 0}; return; } r -= I1;
        if (r < I2) { const int kb = r / 96, nb = r % 96; const int n0 = nb * 64;
            const int drow = n0 < 2048 ? n0 : (n0 < 4096 ? 2048 + ilv_row(n0 - 2048, 0) : 2048 + ilv_row(n0 - 4096, 1));
            d = XItem{P->in[I_CWIN] + (size_t)(kb * 64) * 6144 + n0, ws + WS_WCIN, 6144, 2048, kb * 64, drow, 0}; return; } r -= I2;
        if (r < I3) { const int kb = r / 32, nb = r % 32; d = XItem{P->in[I_CWOUT] + (size_t)(kb * 64) * 2048 + nb * 64, ws + WS_WCOUT, 2048, 2048, kb * 64, nb * 64, 0}; return; } r -= I3;
        if (r < 2 * I4) { const bool up = r >= I4; if (up) r -= I4; const int mt = r / IM, q = r % IM, kb = 2 * (q / 32) + (q & 1), nb = (q >> 1) & 15;
            d = XItem{(up ? P->in[I_WUP] : P->in[I_WGATE]) + (size_t)mt * 2048 * 1024 + (size_t)(kb * 64) * 1024 + nb * 64,
                      ws + WS_GU + (size_t)(mt >> 4) * 16 * 2048 * 2048 * 2 + (size_t)(mt & 15) * 2048 * 2048, 1024, 2048, kb * 64, ilv_row(nb * 64, up ? 1 : 0), 1}; return; } r -= 2 * I4;
        { const int mt = r / IM, q = r % IM, kb = 2 * (q / 64) + (q & 1), nb = (q >> 1) & 31;
            d = XItem{P->in[I_WDOWN] + (size_t)mt * 1024 * 2048 + (size_t)(kb * 64) * 2048 + nb * 64,
                      ws + WS_DN + (size_t)(mt >> 4) * 16 * 2048 * 1024 * 2 + (size_t)(mt & 15) * 2048 * 1024, 2048, 1024, kb * 64, nb * 64, 1}; }
    };
    f32x4 va[16], vb[16]; XItem da, db;
    int it = w;
    if (it < nlist) { decode(item_id(it), da); xpose_load(da, va, lane); }
    while (it < nlist) {
        const int it1 = it + nw; if (it1 < nlist) { decode(item_id(it1), db); xpose_load(db, vb, lane); }
        xpose_store(da, va, scr, lane);
        if (it1 >= nlist) break;
        const int it2 = it1 + nw; if (it2 < nlist) { decode(item_id(it2), da); xpose_load(da, va, lane); }
        xpose_store(db, vb, scr, lane);
        it = it2;
    }
}

DI void phase_prologue(KP P, LAS unsigned char* lds, int tid, int lane, int wave) {
    unsigned char* ws = P->ws;
    for (int u = blockIdx.x; u < 192; u += gridDim.x) {
        const int l = u / 96, cb = u % 96;
        LAS float* sv = (LAS float*)(lds + LDS_SCR);
        LAS float* part = (LAS float*)(lds + LDS_SCR + 24576);
        for (int i = tid; i < 3 * 2048; i += 512) { const int r = i >> 11, k = i & 2047; const float c = r < 2 ? P->in[I_C][r * 2048 + k] : P->in[I_CCTX][k]; sv[i] = c / (1.0f + __expf(-c)); }
        __syncthreads();
        const int col4 = tid & 31, ks = tid >> 5;
        const GAS f32x4* w = (const GAS f32x4*)(P->in[I_ADAW] + (size_t)l * 2048 * 12288 + (size_t)(ks * 128) * 12288 + cb * 128) + col4;
        f32x4 a0 = {0.f, 0.f, 0.f, 0.f}, a1 = a0, a2 = a0;
#pragma unroll 8
        for (int k = 0; k < 128; ++k) { const f32x4 wv = __builtin_nontemporal_load(w + (size_t)k * (12288 / 4)); const int kk = ks * 128 + k;
            a0 += wv * sv[kk]; a1 += wv * sv[2048 + kk]; a2 += wv * sv[4096 + kk]; }
        *(LAS f32x4*)(part + (ks * 3 + 0) * 128 + 4 * col4) = a0; *(LAS f32x4*)(part + (ks * 3 + 1) * 128 + 4 * col4) = a1; *(LAS f32x4*)(part + (ks * 3 + 2) * 128 + 4 * col4) = a2;
        __syncthreads();
        if (tid < 384) { const int r = tid >> 7, cc = tid & 127; float s = P->in[I_ADAB][l * 12288 + cb * 128 + cc];
#pragma unroll
            for (int q = 0; q < 16; ++q) s += part[(q * 3 + r) * 128 + cc];
            ((float*)(ws + WS_MOD))[(size_t)(l * 3 + r) * 12288 + cb * 128 + cc] = s; }
        __syncthreads();
    }
    { const float* src = P->in[I_AWS]; bf16* dst = (bf16*)(ws + WS_WSB);
      for (int i = blockIdx.x * 512 + tid; i < 8 * 128 * 128 / 2; i += gridDim.x * 512) { const float a = src[2 * i], b = src[2 * i + 1]; ((unsigned*)dst)[i] = pk2(a, b); } }
    xpose_range(P, lds, lane, wave, 0, blockIdx.x * NWAVES + wave, gridDim.x * NWAVES);
}


DI void norm_mod_row(f32x4 (&v)[8], const float* __restrict__ g, const float* __restrict__ shift, const float* __restrict__ scale, int lane) {
    float ss = 0.f;
#pragma unroll
    for (int j = 0; j < 8; ++j) ss += (v[j].x * v[j].x + v[j].y * v[j].y) + (v[j].z * v[j].z + v[j].w * v[j].w);
    const float rstd = 1.0f / sqrtf(wave_sum(ss) * (1.0f / D) + EPS);
#pragma unroll
    for (int j = 0; j < 8; ++j) { const int c = 256 * j + 4 * lane; const f32x4 gg = *(const f32x4*)(g + c), sc = *(const f32x4*)(scale + c), sh = *(const f32x4*)(shift + c);
        v[j] = (v[j] * rstd * gg) * (1.0f + sc) + sh; }
}
DI void store_row_bf16(bf16* __restrict__ orow, const f32x4 (&v)[8], int lane) {
    GAS v2u* o = (GAS v2u*)orow + lane;
#pragma unroll
    for (int j = 0; j < 8; ++j) { v2u w; w.x = pk2(v[j].x, v[j].y); w.y = pk2(v[j].z, v[j].w); o[64 * j] = w; }
}
DI void store_row_fp8(unsigned char* __restrict__ orow, const f32x4 (&v)[8], int lane) {
    GAS unsigned* o = (GAS unsigned*)orow + lane;
#pragma unroll
    for (int j = 0; j < 8; ++j) o[64 * j] = pk4_fp8(v[j].x, v[j].y, v[j].z, v[j].w);
}
DI void load_row_bf16(f32x4 (&v)[8], const bf16* __restrict__ xrow, int lane) {
    const GAS v2u* xr = (const GAS v2u*)xrow + lane;
#pragma unroll
    for (int j = 0; j < 8; ++j) { const v2u w = xr[64 * j]; v[j] = (f32x4){bf_lo(w.x), bf_hi(w.x), bf_lo(w.y), bf_hi(w.y)}; }
}
DI void load_row_f32(f32x4 (&v)[8], const float* __restrict__ xrow, int lane) {
    const GAS f32x4* xr = (const GAS f32x4*)xrow + lane;
#pragma unroll
    for (int j = 0; j < 8; ++j) v[j] = __builtin_nontemporal_load(xr + 64 * j);
}

DI void phase_norm1_l0(KP P, LAS unsigned char* lds, int tid, int lane, int wave) {
    const float* mod = (const float*)(P->ws + WS_MOD); bf16* H = (bf16*)(P->ws + WS_H); unsigned char* H8 = P->ws + WS_H8;
    const bool ctxwg = (gridDim.x >= 64) && (blockIdx.x < 16);
    if (ctxwg) {
        const int pmc = blockIdx.x >> 3, pnc = blockIdx.x & 7;
        const float* m = mod + (size_t)2 * 12288;
        for (int rr = 2 * wave; rr < 256; rr += 2 * NWAVES) {
            f32x4 v[2][8];
#pragma unroll
            for (int q = 0; q < 2; ++q) load_row_f32(v[q], P->in[I_CTX] + (size_t)(pmc * 256 + rr + q) * D, lane);
#pragma unroll
            for (int q = 0; q < 2; ++q) { norm_mod_row(v[q], P->in[I_N1G], m + 0 * 2048, m + 1 * 2048, lane); store_row_fp8(H8 + (size_t)(NT + pmc * 256 + rr + q) * D, v[q], lane); } }
        VM_WAIT(); __syncthreads();
        __builtin_amdgcn_fence(__ATOMIC_ACQUIRE, "agent"); VM_WAIT(); __syncthreads();
        pg8::Gemm g{(const bf16*)H8, (const bf16*)(P->ws + WS_WIN0F8), MTOT, 3072, D / 2}; OneUnit S{128 + pmc, 4 + pnc};
        EpiIn0 E{(bf16*)(P->ws + WS_R2), 2, F8_WINV, P->in[I_BKG], (LAS float*)(lds + LDS_KPART)};
        pg8::gemm_phase<EpiIn0, OneUnit, true, true, true>(lds, g, S, E);
        return;
    }
    const int nskip = (gridDim.x >= 64) ? 16 : 0;
    const int gw = (blockIdx.x - nskip) * NWAVES + wave, NGW = (gridDim.x - nskip) * NWAVES;
    const int nrows = (gridDim.x >= 64) ? NT : MTOT;
    for (int row0 = 2 * gw; row0 < nrows; row0 += 2 * NGW) {
        f32x4 v[2][8];
#pragma unroll
        for (int q = 0; q < 2; ++q) { const int row = row0 + q; load_row_f32(v[q], row < NT ? P->in[I_X] + (size_t)row * D : P->in[I_CTX] + (size_t)(row - NT) * D, lane); }
        const int r = row0 < NT ? (row0 >> 14) : 2;
        const float* m = mod + (size_t)r * 12288;
#pragma unroll
        for (int q = 0; q < 2; ++q) { const int row = row0 + q;
            norm_mod_row(v[q], P->in[I_N1G], m + 0 * 2048, m + 1 * 2048, lane);
            if (row < NT) store_row_bf16(H + (size_t)row * D, v[q], lane);
            store_row_fp8(H8 + (size_t)row * D, v[q], lane); }
    }
}

DI void phase_norm2_router(KP P, int layer, LAS unsigned char* lds, int tid, int lane, int wave) {
    const float* mod = (const float*)(P->ws + WS_MOD) + (size_t)layer * 3 * 12288; unsigned char* H8 = P->ws + WS_H;
    float* AFF = (float*)(P->ws + WS_AFF); const bf16* XLB = (const bf16*)(P->ws + WS_XLB);
    LAS unsigned char* wt = lds + LDS_SCR;
    LAS unsigned char* gsL = lds + LDS_SCR + 131072;
    LAS unsigned char* shL = lds + LDS_SCR + 135168;
    LAS float* part = (LAS float*)(lds + LDS_SCR + 139264);
    const float* n2g = P->in[I_N2G] + (size_t)layer * D; const float* wr = P->in[I_ROUTER] + (size_t)layer * 2048 * 16;
    const int gw = blockIdx.x * NWAVES + wave, NGW = gridDim.x * NWAVES;
    const int i16 = lane & 15, kq = lane >> 4;
    int cur_b = -1;
    for (int rb = gw; rb < NT / 16; rb += NGW) {
        const int b = rb >> 10;
        if (b != cur_b) {
            cur_b = b; __syncthreads();
            const float* m = mod + (size_t)b * 12288; const float* sh = m + 3 * 2048; const float* sc = m + 4 * 2048;
            { const int e = tid & 15;
              for (int kc = tid >> 4; kc < 256; kc += 32) { float w[8];
#pragma unroll
                  for (int jj = 0; jj < 8; ++jj) { const int k = 8 * kc + jj; w[jj] = n2g[k] * (1.0f + sc[k]) * wr[k * 16 + e]; }
                  v4u hi, lo; unsigned h_[4], l_[4];
#pragma unroll
                  for (int q = 0; q < 4; ++q) { h_[q] = pk2(w[2 * q], w[2 * q + 1]); l_[q] = pk2(w[2 * q] - bf_lo(h_[q]), w[2 * q + 1] - bf_hi(h_[q])); }
                  hi.x = h_[0]; hi.y = h_[1]; hi.z = h_[2]; hi.w = h_[3]; lo.x = l_[0]; lo.y = l_[1]; lo.z = l_[2]; lo.w = l_[3];
                  *(LAS v4u*)(wt + ((0 * 16 + e) * 256 + (kc ^ e)) * 16) = hi; *(LAS v4u*)(wt + ((1 * 16 + e) * 256 + (kc ^ e)) * 16) = lo; }
              float pb = 0.f; const int pt = tid >> 4;
              for (int k = 64 * pt; k < 64 * pt + 64; ++k) pb += sh[k] * wr[k * 16 + e];
              part[pt * 16 + e] = pb; }
            if (tid < 256) { float a[8], c[8];
#pragma unroll
                for (int jj = 0; jj < 8; ++jj) { const int k = 8 * tid + jj; a[jj] = n2g[k] * (1.0f + sc[k]); c[jj] = sh[k]; }
                v4u ga, sa; ga.x = pk2(a[0], a[1]); ga.y = pk2(a[2], a[3]); ga.z = pk2(a[4], a[5]); ga.w = pk2(a[6], a[7]); sa.x = pk2(c[0], c[1]); sa.y = pk2(c[2], c[3]); sa.z = pk2(c[4], c[5]); sa.w = pk2(c[6], c[7]);
                *(LAS v4u*)(gsL + tid * 16) = ga; *(LAS v4u*)(shL + tid * 16) = sa; }
            __syncthreads();
            if (tid < 16) { float sacc = 0.f;
#pragma unroll 8
                for (int p = 0; p < 32; ++p) sacc += part[p * 16 + tid];
                part[512 + tid] = sacc; }
            __syncthreads();
        }
        const int row = 16 * rb + i16;
        const GAS v4u* xr = (const GAS v4u*)(XLB + (size_t)row * D) + 2 * kq;
        pg8::f32x4 acc = {0.f, 0.f, 0.f, 0.f}; float ss = 0.f;
#pragma unroll 4
        for (int t = 0; t < 32; ++t) {
            const v4u x0 = xr[8 * t], x1 = xr[8 * t + 1];
            const int c0 = 8 * t + 2 * kq;
            const bf16x8 wh0 = *(const LAS bf16x8*)(wt + ((0 * 16 + i16) * 256 + ((c0 + 0) ^ i16)) * 16), wl0 = *(const LAS bf16x8*)(wt + ((1 * 16 + i16) * 256 + ((c0 + 0) ^ i16)) * 16);
            const bf16x8 wh1 = *(const LAS bf16x8*)(wt + ((0 * 16 + i16) * 256 + ((c0 + 1) ^ i16)) * 16), wl1 = *(const LAS bf16x8*)(wt + ((1 * 16 + i16) * 256 + ((c0 + 1) ^ i16)) * 16);
            const bf16x8 a0 = __builtin_bit_cast(bf16x8, x0), a1 = __builtin_bit_cast(bf16x8, x1);
            acc = __builtin_amdgcn_mfma_f32_16x16x32_bf16(a0, wh0, acc, 0, 0, 0); acc = __builtin_amdgcn_mfma_f32_16x16x32_bf16(a0, wl0, acc, 0, 0, 0);
            acc = __builtin_amdgcn_mfma_f32_16x16x32_bf16(a1, wh1, acc, 0, 0, 0); acc = __builtin_amdgcn_mfma_f32_16x16x32_bf16(a1, wl1, acc, 0, 0, 0);
            float f;
            f = bf_lo(x0.x); ss += f * f; f = bf_hi(x0.x); ss += f * f; f = bf_lo(x0.y); ss += f * f; f = bf_hi(x0.y); ss += f * f;
            f = bf_lo(x0.z); ss += f * f; f = bf_hi(x0.z); ss += f * f; f = bf_lo(x0.w); ss += f * f; f = bf_hi(x0.w); ss += f * f;
            f = bf_lo(x1.x); ss += f * f; f = bf_hi(x1.x); ss += f * f; f = bf_lo(x1.y); ss += f * f; f = bf_hi(x1.y); ss += f * f;
            f = bf_lo(x1.z); ss += f * f; f = bf_hi(x1.z); ss += f * f; f = bf_lo(x1.w); ss += f * f; f = bf_hi(x1.w); ss += f * f;
        }
        ss += __shfl_xor(ss, 16); ss += __shfl_xor(ss, 32);
        const float rstd = 1.0f / sqrtf(ss * (1.0f / D) + EPS);
        const float bias = part[512 + i16];
        float lg[4], mx[4], sm[4];
#pragma unroll
        for (int r = 0; r < 4; ++r) { const float rs = __shfl(rstd, 4 * kq + r); lg[r] = rs * acc[r] + bias; mx[r] = lg[r]; }
#pragma unroll
        for (int o = 1; o < 16; o <<= 1)
#pragma unroll
            for (int r = 0; r < 4; ++r) mx[r] = fmaxf(mx[r], __shfl_xor(mx[r], o));
#pragma unroll
        for (int r = 0; r < 4; ++r) { lg[r] = __expf(lg[r] - mx[r]); sm[r] = lg[r]; }
#pragma unroll
        for (int o = 1; o < 16; o <<= 1)
#pragma unroll
            for (int r = 0; r < 4; ++r) sm[r] += __shfl_xor(sm[r], o);
        { const int n0 = (16 * rb) & (SEQ - 1); pg8::f32x4 o4 = {lg[0] / sm[0], lg[1] / sm[1], lg[2] / sm[2], lg[3] / sm[3]};
          *(GAS pg8::f32x4*)(AFF + ((size_t)(b * 16 + i16)) * SEQ + n0 + 4 * kq) = o4; }
        GAS v4u* hr = (GAS v4u*)(H8 + (size_t)row * D) + kq;
#pragma unroll 4
        for (int t = 0; t < 32; ++t) {
            const v4u x0 = xr[8 * t], x1 = xr[8 * t + 1];
            const v4u g0 = *(const LAS v4u*)(gsL + (8 * t + 2 * kq) * 16), g1 = *(const LAS v4u*)(gsL + (8 * t + 2 * kq + 1) * 16);
            const v4u s0 = *(const LAS v4u*)(shL + (8 * t + 2 * kq) * 16), s1 = *(const LAS v4u*)(shL + (8 * t + 2 * kq + 1) * 16);
            v4u o;
#define H2LO(xw, gw_, sw) (bf_lo(xw) * rstd * bf_lo(gw_) + bf_lo(sw))
#define H2HI(xw, gw_, sw) (bf_hi(xw) * rstd * bf_hi(gw_) + bf_hi(sw))
            o.x = pk4_fp8(H2LO(x0.x, g0.x, s0.x), H2HI(x0.x, g0.x, s0.x), H2LO(x0.y, g0.y, s0.y), H2HI(x0.y, g0.y, s0.y));
            o.y = pk4_fp8(H2LO(x0.z, g0.z, s0.z), H2HI(x0.z, g0.z, s0.z), H2LO(x0.w, g0.w, s0.w), H2HI(x0.w, g0.w, s0.w));
            o.z = pk4_fp8(H2LO(x1.x, g1.x, s1.x), H2HI(x1.x, g1.x, s1.x), H2LO(x1.y, g1.y, s1.y), H2HI(x1.y, g1.y, s1.y));
            o.w = pk4_fp8(H2LO(x1.z, g1.z, s1.z), H2HI(x1.z, g1.z, s1.z), H2LO(x1.w, g1.w, s1.w), H2HI(x1.w, g1.w, s1.w));
#undef H2LO
#undef H2HI
            hr[4 * t] = o;
        }
    }
    __syncthreads();
}

DI void phase_topk(KP P, int layer, LAS unsigned char* lds, int tid, int lane, int wave) {
    LAS unsigned* vals = (LAS unsigned*)(lds + LDS_SCR);
    LAS int* red = (LAS int*)(lds + LDS_SCR + 65536);
    LAS int* slotctr = (LAS int*)(lds + LDS_SCR + 65536 + 64);
    const unsigned* AFF = (const unsigned*)(P->ws + WS_AFF);
    int* IDX = (int*)(P->ws + WS_IDX);
    unsigned* tokcnt = (unsigned*)(P->ws + (layer ? CTL_TOKCNT1 : CTL_TOKCNT0));
    unsigned long long* toklist = (unsigned long long*)(P->ws + WS_TOKLIST);
    if (gridDim.x > 32 && blockIdx.x >= 32) {
        xpose_range(P, lds, lane, wave, layer == 0 ? 4 : 3, (blockIdx.x - 32) * NWAVES + wave, (gridDim.x - 32) * NWAVES);
        return;
    }
    for (int j = blockIdx.x; j < 32; j += gridDim.x) {
        const int b = j >> 4, e = j & 15;
        const unsigned* src = AFF + (size_t)j * SEQ;
#pragma unroll 8
        for (int i = 0; i < 32; ++i) vals[tid + 512 * i] = src[tid + 512 * i];
        if (tid == 0) slotctr[0] = 0;
        __syncthreads();
        int par = 0;
#define TK_COUNT(pred, total) do { int _c = 0; _Pragma("unroll 8") for (int i = 0; i < 32; ++i) { const int idx = tid + 512 * i; const unsigned v = vals[idx]; (void)idx; _c += (pred) ? 1 : 0; } \
        _c = wave_sum_i(_c); if (lane == 0) red[par * 8 + wave] = _c; __syncthreads(); total = 0; _Pragma("unroll") for (int w = 0; w < 8; ++w) total += red[par * 8 + w]; par ^= 1; } while (0)
        unsigned T = 0u;
        for (int bit = 30; bit >= 0; --bit) { const unsigned cand = T | (1u << bit); int total; TK_COUNT(v >= cand, total); if (total >= CAP) T = cand; }
        int ngt; TK_COUNT(v > T, ngt);
        const int need = CAP - ngt;
        int lo = 0, hi = SEQ - 1;
        while (lo < hi) { const int mid = (lo + hi) >> 1; int c; TK_COUNT(v == T && idx <= mid, c); if (c >= need) hi = mid; else lo = mid + 1; }
        const int J = lo;
#undef TK_COUNT
        for (int i = 0; i < 32; ++i) { const int idx = tid + 512 * i; const unsigned v = vals[idx];
            if (v > T || (v == T && idx <= J)) {
                const int slot = __hip_atomic_fetch_add(slotctr, 1, __ATOMIC_RELAXED, __HIP_MEMORY_SCOPE_WORKGROUP);
                IDX[j * CAP + slot] = idx;
                const int tok = b * SEQ + idx; const unsigned rowid = (unsigned)(e * 4096 + b * 2048 + slot);
                const unsigned p = __hip_atomic_fetch_add(tokcnt + tok, 1u, RLX_AGENT);
                toklist[(size_t)tok * 16 + (p & 15u)] = ((unsigned long long)v << 32) | rowid; } }
        __syncthreads();
    }
}

template <bool F8>
DI void phase_gather(KP P, int lane, int wave) {
    const int* IDX = (const int*)(P->ws + WS_IDX); const unsigned char* H = (const unsigned char*)(P->ws + WS_H); unsigned char* XS = (unsigned char*)(P->ws + WS_R2);
    const int gw = blockIdx.x * NWAVES + wave, NGW = gridDim.x * NWAVES;
    constexpr int RB = F8 ? D : 2 * D, NV = RB / 1024;
    for (int rowid = gw; rowid < 65536; rowid += NGW) {
        const int e = rowid >> 12, b = (rowid >> 11) & 1, slot = rowid & 2047;
        const int n = IDX[(b * 16 + e) * CAP + slot];
        const GAS v4u* s = (const GAS v4u*)(H + (size_t)(b * SEQ + n) * RB) + lane; GAS v4u* d = (GAS v4u*)(XS + (size_t)rowid * RB) + lane;
        v4u t[NV];
#pragma unroll
        for (int j = 0; j < NV; ++j) t[j] = s[64 * j];
#pragma unroll
        for (int j = 0; j < NV; ++j) d[64 * j] = t[j];
    }
}

DI void unpack8(float (&f)[8], const v4u w) { f[0] = bf_lo(w.x); f[1] = bf_hi(w.x); f[2] = bf_lo(w.y); f[3] = bf_hi(w.y); f[4] = bf_lo(w.z); f[5] = bf_hi(w.z); f[6] = bf_lo(w.w); f[7] = bf_hi(w.w); }
typedef float f32x2_t __attribute__((ext_vector_type(2)));
DI void unpack8_fp8(float (&f)[8], const v2u w) {
    const f32x2_t a = __builtin_amdgcn_cvt_pk_f32_fp8((int)w.x, false), b = __builtin_amdgcn_cvt_pk_f32_fp8((int)w.x, true), c = __builtin_amdgcn_cvt_pk_f32_fp8((int)w.y, false), d = __builtin_amdgcn_cvt_pk_f32_fp8((int)w.y, true);
    f[0] = a.x; f[1] = a.y; f[2] = b.x; f[3] = b.y; f[4] = c.x; f[5] = c.y; f[6] = d.x; f[7] = d.y; }
template <bool NEXT_NORM>
DI void phase_combine(KP P, int layer, int lane, int wave) {
    const float* mod = (const float*)(P->ws + WS_MOD) + (size_t)layer * 3 * 12288;
    const float* modn = (const float*)(P->ws + WS_MOD) + (size_t)(layer + 1) * 3 * 12288;
    const unsigned* tokcnt = (const unsigned*)(P->ws + (layer ? CTL_TOKCNT1 : CTL_TOKCNT0));
    const unsigned long long* toklist = (const unsigned long long*)(P->ws + WS_TOKLIST);
    const unsigned char* YB = (const unsigned char*)(P->ws + WS_R3); bf16* H = (bf16*)(P->ws + WS_H); bf16* XLB = (bf16*)(P->ws + WS_XLB);
    const int gw = blockIdx.x * NWAVES + wave, NGW = gridDim.x * NWAVES;
    for (int tb = gw; tb < NT; tb += 16 * NGW) {
        int cntv = 0; { const int tk = tb + (lane & 15) * NGW; if (tk < NT) cntv = (int)tokcnt[tk]; }
        unsigned long long en0 = 0ull, en1 = 0ull, en2 = 0ull, en3 = 0ull; { const int tk = tb + (lane >> 2) * NGW;
            if (tk < NT) { const unsigned long long* ep = toklist + (size_t)tk * 16 + 4 * (lane & 3); en0 = ep[0]; en1 = ep[1]; en2 = ep[2]; en3 = ep[3]; } }
        v4u xn[4];
#pragma unroll
        for (int jj = 0; jj < 4; ++jj) xn[jj] = *(const GAS v4u*)(XLB + (size_t)tb * D + 512 * jj + 8 * lane);
        for (int i = 0; i < 16; ++i) {
            const int tok = tb + i * NGW; if (tok >= NT) break;
            const int b = tok >> 14;
            v4u xc[4];
#pragma unroll
            for (int jj = 0; jj < 4; ++jj) xc[jj] = xn[jj];
            if (i + 1 < 16 && tok + NGW < NT) {
#pragma unroll
                for (int jj = 0; jj < 4; ++jj) xn[jj] = *(const GAS v4u*)(XLB + (size_t)(tok + NGW) * D + 512 * jj + 8 * lane); }
            int cnt = __builtin_amdgcn_readlane(cntv, i); cnt = cnt > 16 ? 16 : cnt;
            float a[4][8];
#pragma unroll
            for (int jj = 0; jj < 4; ++jj)
#pragma unroll
                for (int e = 0; e < 8; ++e) a[jj][e] = 0.f;
            for (int p = 0; p < cnt; p += 2) {
                unsigned r0, r1; float g0, g1;
                { const int q = p & 3, sl = 4 * i + (p >> 2); const unsigned long long xa = (q & 1) ? en1 : en0, xb = (q & 1) ? en3 : en2, x = (q & 2) ? xb : xa;
                  r0 = (unsigned)__builtin_amdgcn_readlane((int)(unsigned)x, sl); g0 = __uint_as_float((unsigned)__builtin_amdgcn_readlane((int)(unsigned)(x >> 32), sl)); }
                if (p + 1 < cnt) { const int p1 = p + 1, q = p1 & 3, sl = 4 * i + (p1 >> 2); const unsigned long long xa = (q & 1) ? en1 : en0, xb = (q & 1) ? en3 : en2, x = (q & 2) ? xb : xa;
                  r1 = (unsigned)__builtin_amdgcn_readlane((int)(unsigned)x, sl); g1 = __uint_as_float((unsigned)__builtin_amdgcn_readlane((int)(unsigned)(x >> 32), sl)); }
                else { r1 = r0; g1 = 0.f; }
                v2u y0[4], y1[4];
#pragma unroll
                for (int jj = 0; jj < 4; ++jj) { y0[jj] = *(const GAS v2u*)(YB + (size_t)r0 * D + 512 * jj + 8 * lane); y1[jj] = *(const GAS v2u*)(YB + (size_t)r1 * D + 512 * jj + 8 * lane); }
#pragma unroll
                for (int jj = 0; jj < 4; ++jj) { float f0[8], f1[8]; unpack8_fp8(f0, y0[jj]); unpack8_fp8(f1, y1[jj]);
#pragma unroll
                    for (int e = 0; e < 8; ++e) a[jj][e] += g0 * f0[e] + g1 * f1[e]; }
            }
            const float* g2 = mod + (size_t)b * 12288 + 5 * 2048;
            float v[4][8]; float ss = 0.f;
#pragma unroll
            for (int jj = 0; jj < 4; ++jj) { const int c = 512 * jj + 8 * lane; const f32x4 ga = *(const f32x4*)(g2 + c), gb = *(const f32x4*)(g2 + c + 4); float x[8]; unpack8(x, xc[jj]);
                v[jj][0] = x[0] + ga.x * a[jj][0]; v[jj][1] = x[1] + ga.y * a[jj][1]; v[jj][2] = x[2] + ga.z * a[jj][2]; v[jj][3] = x[3] + ga.w * a[jj][3];
                v[jj][4] = x[4] + gb.x * a[jj][4]; v[jj][5] = x[5] + gb.y * a[jj][5]; v[jj][6] = x[6] + gb.z * a[jj][6]; v[jj][7] = x[7] + gb.w * a[jj][7];
#pragma unroll
                for (int e = 0; e < 8; ++e) ss += v[jj][e] * v[jj][e]; }
            if constexpr (NEXT_NORM) {
#pragma unroll
                for (int jj = 0; jj < 4; ++jj) { v4u o; o.x = pk2(v[jj][0], v[jj][1]); o.y = pk2(v[jj][2], v[jj][3]); o.z = pk2(v[jj][4], v[jj][5]); o.w = pk2(v[jj][6], v[jj][7]);
                    *(GAS v4u*)(XLB + (size_t)tok * D + 512 * jj + 8 * lane) = o; }
                const float rstd = 1.0f / sqrtf(wave_sum(ss) * (1.0f / D) + EPS);
                const float* m = modn + (size_t)b * 12288; const float* gn = P->in[I_N1G] + (size_t)(layer + 1) * D;
#pragma unroll
                for (int jj = 0; jj < 4; ++jj) { const int c = 512 * jj + 8 * lane; float h[8];
#pragma unroll
                    for (int hf2 = 0; hf2 < 2; ++hf2) { const f32x4 gg = *(const f32x4*)(gn + c + 4 * hf2), sc = *(const f32x4*)(m + 2048 + c + 4 * hf2), sh = *(const f32x4*)(m + c + 4 * hf2);
                        h[4 * hf2 + 0] = v[jj][4 * hf2 + 0] * rstd * gg.x * (1.0f + sc.x) + sh.x; h[4 * hf2 + 1] = v[jj][4 * hf2 + 1] * rstd * gg.y * (1.0f + sc.y) + sh.y;
                        h[4 * hf2 + 2] = v[jj][4 * hf2 + 2] * rstd * gg.z * (1.0f + sc.z) + sh.z; h[4 * hf2 + 3] = v[jj][4 * hf2 + 3] * rstd * gg.w * (1.0f + sc.w) + sh.w; }
                    v4u o; o.x = pk2(h[0], h[1]); o.y = pk2(h[2], h[3]); o.z = pk2(h[4], h[5]); o.w = pk2(h[6], h[7]);
                    *(GAS v4u*)(H + (size_t)tok * D + 512 * jj + 8 * lane) = o; }
            } else {
#pragma unroll
                for (int jj = 0; jj < 4; ++jj) { GAS f32x4* o = (GAS f32x4*)(P->out + (size_t)tok * D + 512 * jj + 8 * lane);
                    __builtin_nontemporal_store((f32x4){v[jj][0], v[jj][1], v[jj][2], v[jj][3]}, o); __builtin_nontemporal_store((f32x4){v[jj][4], v[jj][5], v[jj][6], v[jj][7]}, o + 1); }
            }
        }
    }
}

DI void phase_knorm(KP P, int lane, int wave) {
    bf16* KK = (bf16*)(P->ws + WS_R2) + 3 * R2_T; const float* gk = P->in[I_BKG];
    const int gw = blockIdx.x * NWAVES + wave, NGW = gridDim.x * NWAVES;
    const int d0 = (lane & 7) * 16;
    float gkr[16];
#pragma unroll
    for (int i = 0; i < 16; ++i) gkr[i] = gk[d0 + i];
    for (int row = gw; row < MTOT; row += NGW) {
        GAS v4u* p = (GAS v4u*)(KK + (size_t)row * 1024) + 2 * lane;
        const v4u w0 = p[0], w1 = p[1];
        float f[16];
        f[0] = bf_lo(w0.x); f[1] = bf_hi(w0.x); f[2] = bf_lo(w0.y); f[3] = bf_hi(w0.y); f[4] = bf_lo(w0.z); f[5] = bf_hi(w0.z); f[6] = bf_lo(w0.w); f[7] = bf_hi(w0.w);
        f[8] = bf_lo(w1.x); f[9] = bf_hi(w1.x); f[10] = bf_lo(w1.y); f[11] = bf_hi(w1.y); f[12] = bf_lo(w1.z); f[13] = bf_hi(w1.z); f[14] = bf_lo(w1.w); f[15] = bf_hi(w1.w);
        float ss = 0.f;
#pragma unroll
        for (int i = 0; i < 16; ++i) ss += f[i] * f[i];
        ss += __shfl_xor(ss, 1); ss += __shfl_xor(ss, 2); ss += __shfl_xor(ss, 4);
        const float rstd = 1.0f / sqrtf(ss * (1.0f / 128.0f) + EPS);
#pragma unroll
        for (int i = 0; i < 16; ++i) f[i] = f[i] * rstd * gkr[i];
        v4u o0, o1; o0.x = pk2(f[0], f[1]); o0.y = pk2(f[2], f[3]); o0.z = pk2(f[4], f[5]); o0.w = pk2(f[6], f[7]); o1.x = pk2(f[8], f[9]); o1.y = pk2(f[10], f[11]); o1.z = pk2(f[12], f[13]); o1.w = pk2(f[14], f[15]);
        p[0] = o0; p[1] = o1;
    }
}

DI void phase_gmlp(KP P, LAS unsigned char* lds, int tid, int lane, int wave) {
    const bf16* U = (const bf16*)(P->ws + WS_R2); const bf16* V = U + R2_T; const bf16* WSB = (const bf16*)(P->ws + WS_WSB);
    bf16* CAT = (bf16*)(P->ws + WS_R3);
    LAS unsigned char* wimg = lds + LDS_SCR;
    LAS unsigned char* vimg = lds + LDS_SCR + 32768;
    const int ql = lane & 31, hf = lane >> 5;
    const int G = gridDim.x;
    const bool wonce = (G & 7) == 0;
    v4u vraw[4];
    int u = blockIdx.x;
    if (u < 2048) { const int g = u & 7, cn = (u >> 3) & 127, b = u >> 10; const int tok0 = b * SEQ + cn * 128;
#pragma unroll
        for (int i = 0; i < 4; ++i) { const int cidx = tid + 512 * i, q = cidx >> 4, ch = cidx & 15; vraw[i] = *(const GAS v4u*)(V + (size_t)(tok0 + q) * 1024 + g * 128 + ch * 8); } }
    for (int it = 0; u < 2048; u += G, ++it) {
        const int g = u & 7, cn = (u >> 3) & 127, b = u >> 10;
        const int tok0 = b * SEQ + cn * 128;
        const float* gv = P->in[I_AVG] + g * 128;
        if (it == 0 || !wonce) {
#pragma unroll
            for (int i = 0; i < 4; ++i) { const int cidx = tid + 512 * i, q = cidx >> 4, ch = cidx & 15;
                const v4u wraw = *(const GAS v4u*)(WSB + (size_t)(g * 128 + q) * 128 + ch * 8);
                *(LAS v4u*)(wimg + (q >> 5) * 8192 + off_b(q & 31, ch)) = wraw; } }
#pragma unroll
        for (int i = 0; i < 4; ++i) { const int cidx = tid + 512 * i, q = cidx >> 4, ch = cidx & 15;
            const v4u raw = vraw[i];
            float f[8]; f[0] = bf_lo(raw.x); f[1] = bf_hi(raw.x); f[2] = bf_lo(raw.y); f[3] = bf_hi(raw.y); f[4] = bf_lo(raw.z); f[5] = bf_hi(raw.z); f[6] = bf_lo(raw.w); f[7] = bf_hi(raw.w);
            float ss = 0.f;
#pragma unroll
            for (int k = 0; k < 8; ++k) ss += f[k] * f[k];
            ss += __shfl_xor(ss, 1); ss += __shfl_xor(ss, 2); ss += __shfl_xor(ss, 4); ss += __shfl_xor(ss, 8);
            const float rstd = 1.0f / sqrtf(ss * (1.0f / 128.0f) + EPS);
            const f32x4 g0 = *(const f32x4*)(gv + ch * 8), g1 = *(const f32x4*)(gv + ch * 8 + 4);
            v4u o; o.x = pk2(f[0] * rstd * g0.x, f[1] * rstd * g0.y); o.y = pk2(f[2] * rstd * g0.z, f[3] * rstd * g0.w); o.z = pk2(f[4] * rstd * g1.x, f[5] * rstd * g1.y); o.w = pk2(f[6] * rstd * g1.z, f[7] * rstd * g1.w);
            *(LAS v4u*)(vimg + (q >> 5) * 8192 + off_b(q & 31, ch)) = o; }
        __syncthreads();
        const int cb = wave & 3, pb0 = 2 * (wave >> 2);
        { const int un = u + G; if (un < 2048) { const int gn = un & 7, cnn = (un >> 3) & 127, bn = un >> 10; const int tokn = bn * SEQ + cnn * 128;
#pragma unroll
            for (int i = 0; i < 4; ++i) { const int cidx = tid + 512 * i, q = cidx >> 4, ch = cidx & 15; vraw[i] = *(const GAS v4u*)(V + (size_t)(tokn + q) * 1024 + gn * 128 + ch * 8); } } }
        v2u uu[2][4]; float bsv[2];
#pragma unroll
        for (int x = 0; x < 2; ++x) { const int p = 32 * (pb0 + x) + ql; bsv[x] = P->in[I_ABS][g * 128 + p];
#pragma unroll
            for (int rq = 0; rq < 4; ++rq) uu[x][rq] = *(const GAS v2u*)(U + (size_t)(tok0 + p) * 1024 + g * 128 + 32 * cb + 8 * rq + 4 * hf); }
        f32x16 acc0, acc1;
#pragma unroll
        for (int i = 0; i < 16; ++i) { acc0[i] = 0.f; acc1[i] = 0.f; }
#pragma unroll
        for (int ks = 0; ks < 8; ++ks) {
            const bf16x8 a = tr_frag<false>(vimg + (ks >> 1) * 8192, lane, cb, ks & 1);
            const bf16x8 b0 = row_frag(wimg + (pb0 + 0) * 8192, lane, ks), b1 = row_frag(wimg + (pb0 + 1) * 8192, lane, ks);
            acc0 = MFMA32(a, b0, acc0); acc1 = MFMA32(a, b1, acc1);
        }
#pragma unroll
        for (int x = 0; x < 2; ++x) { const int p = 32 * (pb0 + x) + ql; const int tok = tok0 + p; const float bs = bsv[x];
            v2u oo[4];
#pragma unroll
            for (int rq = 0; rq < 4; ++rq) {
                const v2u w = uu[x][rq];
                const float s0 = (x ? acc1[4 * rq + 0] : acc0[4 * rq + 0]) + bs, s1 = (x ? acc1[4 * rq + 1] : acc0[4 * rq + 1]) + bs, s2 = (x ? acc1[4 * rq + 2] : acc0[4 * rq + 2]) + bs, s3 = (x ? acc1[4 * rq + 3] : acc0[4 * rq + 3]) + bs;
                oo[rq].x = pk2(bf_lo(w.x) * s0, bf_hi(w.x) * s1); oo[rq].y = pk2(bf_lo(w.y) * s2, bf_hi(w.y) * s3); }
#pragma unroll
            for (int rq = 0; rq < 4; rq += 2) {
                const auto rx = __builtin_amdgcn_permlane32_swap(oo[rq].x, oo[rq + 1].x, false, false); const auto ry = __builtin_amdgcn_permlane32_swap(oo[rq].y, oo[rq + 1].y, false, false);
                v4u o; o.x = rx[0]; o.y = ry[0]; o.z = rx[1]; o.w = ry[1];
                *(GAS v4u*)(CAT + (size_t)tok * D + g * 128 + 32 * cb + 8 * (rq + hf)) = o; } }
        __syncthreads();
    }
}

DI void phase_attn(KP P, LAS unsigned char* lds, int tid, int lane, int wave) {
    const bf16* Qb = (const bf16*)(P->ws + WS_R2) + 2 * R2_T; const bf16* KK = Qb + R2_T; const bf16* VV = KK + R2_T;
    bf16* CAT = (bf16*)(P->ws + WS_R3);
    LAS unsigned char* kbuf = lds + LDS_SCR;
    LAS unsigned char* vbuf = lds + LDS_SCR + 49152;
    LAS float* rpbL = (LAS float*)(lds + LDS_SCR + 98304 + 1024);
    const int ql = lane & 31, hf = lane >> 5;
    const float* gq = P->in[I_BQG];
    const int rp = wave >> 2, cb = wave & 3;
    const int c0 = min(max(16 * cb - 8, 0), 32);
    const int u00 = c0 >> 3; const bool oddw = (u00 & 1) != 0; const unsigned offw = 4096u * (unsigned)(u00 >> 1);
    unsigned trl[4], trh[4];
    { const unsigned h = lane >> 5, blk = (lane >> 4) & 1, q = (lane & 15) >> 2, p = lane & 3, r0 = 4 * h + q, sub = 8 * (p & 1);
#pragma unroll
      for (int c = 0; c < 4; ++c) { const unsigned ch = 4 * c + 2 * blk + (p >> 1); trl[c] = off_b(r0, ch) + sub; trh[c] = off_b(r0 + 8, ch) + sub; } }
    unsigned kfl[8];
    { const unsigned key = (unsigned)(c0 + ql);
#pragma unroll
      for (int s = 0; s < 8; ++s) kfl[s] = (key >> 5) * 8192u + off_b(key & 31u, 2 * s + hf); }
    for (int u = blockIdx.x; u < 1024; u += gridDim.x) {
        const int h = u & 7, rg = (u >> 3) & 63, b = u >> 9;
        const int qr = 4 * rg + 2 * rp + (ql >> 4), qc = 16 * cb + (ql & 15);
        const int tq = b * SEQ + qr * GRIDW + qc;
        bf16x8 Qf[8];
        { v4u raw[8]; float ss = 0.f;
#pragma unroll
          for (int s = 0; s < 8; ++s) { raw[s] = *(const GAS v4u*)(Qb + (size_t)tq * 1024 + h * 128 + 16 * s + 8 * hf);
              const float a0 = bf_lo(raw[s].x), a1 = bf_hi(raw[s].x), a2 = bf_lo(raw[s].y), a3 = bf_hi(raw[s].y), a4 = bf_lo(raw[s].z), a5 = bf_hi(raw[s].z), a6 = bf_lo(raw[s].w), a7 = bf_hi(raw[s].w);
              ss += (a0 * a0 + a1 * a1) + (a2 * a2 + a3 * a3) + (a4 * a4 + a5 * a5) + (a6 * a6 + a7 * a7); }
          ss += __shfl_xor(ss, 32);
          const float qs = (1.0f / sqrtf(ss * (1.0f / 128.0f) + EPS)) * (0.08838834764831845f * LOG2E);
#pragma unroll
          for (int s = 0; s < 8; ++s) { const f32x4 g0 = *(const f32x4*)(gq + 16 * s + 8 * hf), g1 = *(const f32x4*)(gq + 16 * s + 8 * hf + 4);
              v4u o; o.x = pk2(bf_lo(raw[s].x) * qs * g0.x, bf_hi(raw[s].x) * qs * g0.y); o.y = pk2(bf_lo(raw[s].y) * qs * g0.z, bf_hi(raw[s].y) * qs * g0.w);
              o.z = pk2(bf_lo(raw[s].z) * qs * g1.x, bf_hi(raw[s].z) * qs * g1.y); o.w = pk2(bf_lo(raw[s].w) * qs * g1.z, bf_hi(raw[s].w) * qs * g1.w);
              Qf[s] = __builtin_bit_cast(bf16x8, o); } }
        if (tid < 465) rpbL[tid] = P->in[I_RPB][h * 465 + tid] * LOG2E;
        const int rs_q = min(max(qr - 4, 0), NROWS - 8);
        const int wlo = min(max(4 * rg + 2 * rp - 4, 0), NROWS - 8), whi = min(max(4 * rg + 2 * rp + 1 - 4, 0), NROWS - 8) + 7;
        const int krlo = min(max(4 * rg - 4, 0), NROWS - 8), krhi = min(max(4 * rg + 3 - 4, 0), NROWS - 8) + 7, ntl = krhi - krlo + 1, T = ntl + 4;
        const int cs = min(max(qc - 8, 0), GRIDW - 16);
        f32x16 O[4];
#pragma unroll
        for (int db = 0; db < 4; ++db)
#pragma unroll
            for (int i = 0; i < 16; ++i) O[db][i] = 0.f;
        float m_run = -5e29f, l_run = 0.f;
#define ATT_DMA(t, slot) do { const int _tb = (t) < ntl ? b * SEQ + (krlo + (t)) * GRIDW : NT + b * CTXL + 64 * ((t) - ntl); \
        _Pragma("unroll") for (int _i = 0; _i < 2; ++_i) { const int _c = tid + 512 * _i, _key = _c >> 4, _chp = _c & 15, _row = _key & 31; const int _ch = _chp ^ (((_row & 3) << 2) | ((_row >> 2) & 3)); \
            const size_t _o = (size_t)(_tb + _key) * 1024 + h * 128 + _ch * 8; const unsigned _l = (unsigned)(slot) * 16384u + (unsigned)(wave * 64 + 512 * _i) * 16u; \
            __builtin_amdgcn_global_load_lds((const unsigned*)(KK + _o), (LAS unsigned*)(kbuf + _l), 16, 0, 0); \
            __builtin_amdgcn_global_load_lds((const unsigned*)(VV + _o), (LAS unsigned*)(vbuf + _l), 16, 0, 0); } } while (0)
        ATT_DMA(0, 0); ATT_DMA(1, 1);
        asm volatile("s_waitcnt vmcnt(4) lgkmcnt(0)" ::: "memory"); __builtin_amdgcn_s_barrier(); asm volatile("" ::: "memory");
        for (int t = 0; t < T; ++t) {
            const int slot = t % 3;
            if (t + 2 < T) ATT_DMA(t + 2, (t + 2) % 3);
            const bool local = t < ntl; const int kr = krlo + t;
            const bool active = !local || (kr >= wlo && kr <= whi);
            if (active) {
                const LAS unsigned char* kb_ = kbuf + slot * 16384; const LAS unsigned char* vb_ = vbuf + slot * 16384;
                f32x16 S0, S1;
#pragma unroll
                for (int i = 0; i < 16; ++i) { S0[i] = 0.f; S1[i] = 0.f; }
                if (local) {
#pragma unroll
                    for (int s = 0; s < 8; ++s) { const bf16x8 a0 = *(const LAS bf16x8*)(kb_ + kfl[s]); S0 = MFMA32(a0, Qf[s], S0); }
                    const bool rowok = (kr >= rs_q) && (kr <= rs_q + 7);
                    int cl = rowok ? (cs - c0 - 4 * hf) : 0x40000000; int bbase = min(max(kr - qr + 7, 0), 14) * 31 + 15 + c0 + 4 * hf - qc;
                    asm volatile("" : "+v"(cl), "+v"(bbase));
                    const LAS float* bp = rpbL + bbase;
                    float bia0[16];
#pragma unroll
                    for (int r = 0; r < 16; ++r) bia0[r] = bp[(r & 3) + 8 * (r >> 2)];
#pragma unroll
                    for (int r = 0; r < 16; ++r) asm volatile("" : "+v"(bia0[r]));
#pragma unroll
                    for (int r = 0; r < 16; ++r) { const int k0 = (r & 3) + 8 * (r >> 2); const bool ok = (unsigned)(k0 - cl) < 16u; S0[r] = ok ? S0[r] + bia0[r] : -1e30f; }
                } else {
#pragma unroll
                    for (int s = 0; s < 8; ++s) { const bf16x8 a0 = row_frag(kb_, lane, s), a1 = row_frag(kb_ + 8192, lane, s); S0 = MFMA32(a0, Qf[s], S0); S1 = MFMA32(a1, Qf[s], S1); }
                }
                float mt = S0[0];
#pragma unroll
                for (int r = 1; r < 16; ++r) mt = fmaxf(mt, S0[r]);
                if (!local) {
#pragma unroll
                    for (int r = 0; r < 16; ++r) mt = fmaxf(mt, S1[r]); }
                mt = fmaxf(mt, __shfl_xor(mt, 32));
                const float m_new = fmaxf(m_run, mt), alpha = fast_exp2(m_run - m_new);
                m_run = m_new;
                float ps = 0.f;
#pragma unroll
                for (int r = 0; r < 16; ++r) { S0[r] = fast_exp2(S0[r] - m_new); ps += S0[r]; }
                if (!local) {
#pragma unroll
                    for (int r = 0; r < 16; ++r) { S1[r] = fast_exp2(S1[r] - m_new); ps += S1[r]; } }
                l_run = l_run * alpha + ps;
                if (__builtin_amdgcn_ballot_w64(alpha != 1.0f) != 0ull) {
#pragma unroll
                    for (int db = 0; db < 4; ++db)
#pragma unroll
                        for (int i = 0; i < 16; ++i) O[db][i] *= alpha; }
                const unsigned vb_a = (unsigned)(unsigned long)vb_;
                unsigned tal[4], tah[4];
#pragma unroll
                for (int c = 0; c < 4; ++c) { tal[c] = vb_a + trl[c]; tah[c] = vb_a + trh[c]; }
                unsigned al0[4], ah0[4];
#pragma unroll
                for (int c = 0; c < 4; ++c) { al0[c] = local ? ((oddw ? tah[c] : tal[c]) + offw) : tal[c]; ah0[c] = local ? ((oddw ? tal[c] + 4096u : tah[c]) + offw) : tah[c]; }
#pragma unroll
                for (int s2 = 0; s2 < 2; ++s2) {
                    v4u pp; pp.x = pk2(S0[8 * s2 + 0], S0[8 * s2 + 1]); pp.y = pk2(S0[8 * s2 + 2], S0[8 * s2 + 3]); pp.z = pk2(S0[8 * s2 + 4], S0[8 * s2 + 5]); pp.w = pk2(S0[8 * s2 + 6], S0[8 * s2 + 7]);
                    const bf16x8 pf = __builtin_bit_cast(bf16x8, pp);
                    bf16x8 av[4];
                    if (s2 == 0) tr_frag4_pre<0>(av, al0, ah0); else tr_frag4_pre<4096>(av, al0, ah0);
#pragma unroll
                    for (int db = 0; db < 4; ++db) O[db] = MFMA32(av[db], pf, O[db]);
                }
                if (!local) {
#pragma unroll
                    for (int s2 = 0; s2 < 2; ++s2) {
                        v4u pp; pp.x = pk2(S1[8 * s2 + 0], S1[8 * s2 + 1]); pp.y = pk2(S1[8 * s2 + 2], S1[8 * s2 + 3]); pp.z = pk2(S1[8 * s2 + 4], S1[8 * s2 + 5]); pp.w = pk2(S1[8 * s2 + 6], S1[8 * s2 + 7]);
                        const bf16x8 pf = __builtin_bit_cast(bf16x8, pp);
                        bf16x8 av[4];
                        if (s2 == 0) tr_frag4_pre<8192>(av, tal, tah); else tr_frag4_pre<12288>(av, tal, tah);
#pragma unroll
                        for (int db = 0; db < 4; ++db) O[db] = MFMA32(av[db], pf, O[db]);
                    }
                }
            }
            if (t + 2 < T) asm volatile("s_waitcnt vmcnt(4)" ::: "memory"); else asm volatile("s_waitcnt vmcnt(0)" ::: "memory");
            asm volatile("s_waitcnt lgkmcnt(0)" ::: "memory"); __builtin_amdgcn_s_barrier(); asm volatile("" ::: "memory");
        }
#undef ATT_DMA
        const float inv = 1.0f / (l_run + __shfl_xor(l_run, 32));
        bf16* orow = CAT + (size_t)tq * D + 1024 + h * 128;
#pragma unroll
        for (int db = 0; db < 4; ++db)
#pragma unroll
            for (int rq = 0; rq < 4; rq += 2) {
                const unsigned ax = pk2(O[db][4 * rq + 0] * inv, O[db][4 * rq + 1] * inv), ay = pk2(O[db][4 * rq + 2] * inv, O[db][4 * rq + 3] * inv);
                const unsigned bx = pk2(O[db][4 * rq + 4] * inv, O[db][4 * rq + 5] * inv), by = pk2(O[db][4 * rq + 6] * inv, O[db][4 * rq + 7] * inv);
                const auto rx = __builtin_amdgcn_permlane32_swap(ax, bx, false, false); const auto ry = __builtin_amdgcn_permlane32_swap(ay, by, false, false);
                v4u o; o.x = rx[0]; o.y = ry[0]; o.z = rx[1]; o.w = ry[1];
                *(GAS v4u*)(orow + 32 * db + 8 * (rq + hf)) = o; }
    }
}

DI void phase_conv(KP P, int lane, int wave) {
    const bf16* BG = (const bf16*)(P->ws + WS_R2); const bf16* CZ = BG + (size_t)NT * D; bf16* WC = (bf16*)(P->ws + WS_R3);
    const float* cw = P->in[I_CONVW];
    const int gw = blockIdx.x * NWAVES + wave, NGW = gridDim.x * NWAVES;
    for (int it = gw; it < (NT / 8) * 4; it += NGW) {
        const int rho = it >> 2, cq = it & 3, tb = (rho & 7) * 512 + (511 - (rho >> 3));
        const int tok0 = tb * 8, c0 = cq * 512 + lane * 8;
        const int n0 = tok0 & (SEQ - 1);
        v4u z[10], g[8];
#pragma unroll
        for (int q = 0; q < 10; ++q) { const int n = n0 + q - 1; const bool in = (n >= 0) && (n < SEQ);
            z[q] = in ? *(const GAS v4u*)(CZ + (size_t)(tok0 + q - 1) * D + c0) : (v4u){0u, 0u, 0u, 0u}; }
#pragma unroll
        for (int q = 0; q < 8; ++q) g[q] = *(const GAS v4u*)(BG + (size_t)(tok0 + q) * D + c0);
        const f32x4 w0a = *(const f32x4*)(cw + c0), w0b = *(const f32x4*)(cw + c0 + 4), w1a = *(const f32x4*)(cw + D + c0), w1b = *(const f32x4*)(cw + D + c0 + 4), w2a = *(const f32x4*)(cw + 2 * D + c0), w2b = *(const f32x4*)(cw + 2 * D + c0 + 4);
#pragma unroll
        for (int q = 0; q < 8; ++q) { const v4u a = z[q], m = z[q + 1], p = z[q + 2], b_ = g[q]; v4u o;
#define CV(lohi, wsel, widx, word) (lohi(b_.word) * (w0##wsel[widx] * lohi(a.word) + w1##wsel[widx] * lohi(m.word) + w2##wsel[widx] * lohi(p.word)))
            o.x = pk2(CV(bf_lo, a, 0, x), CV(bf_hi, a, 1, x)); o.y = pk2(CV(bf_lo, a, 2, y), CV(bf_hi, a, 3, y));
            o.z = pk2(CV(bf_lo, b, 0, z), CV(bf_hi, b, 1, z)); o.w = pk2(CV(bf_lo, b, 2, w), CV(bf_hi, b, 3, w));
#undef CV
            *(GAS v4u*)(WC + (size_t)(tok0 + q) * D + c0) = o; }
    }
}

constexpr int NPHASE = 21;
__global__ void __launch_bounds__(NWAVES * 64, 2) mega_fwd(Params P_) {
    KP P = kparams();
    extern __shared__ __attribute__((aligned(16))) unsigned char lds_raw[];
    LAS unsigned char* lds = (LAS unsigned char*)lds_raw;
    volatile LAS unsigned* MISC = (volatile LAS unsigned*)(lds + MISC_OFF);
    const int tid = threadIdx.x, lane = tid & 63, wave = __builtin_amdgcn_readfirstlane(tid >> 6);
    for (int u = tid; u < (LDS_BYTES - LDSCTL_OFF) / 4; u += NWAVES * 64) ((LAS unsigned*)(lds + LDSCTL_OFF))[u] = 0u;
    __syncthreads();
    unsigned* barw = (unsigned*)(P->ws + WS_CTL + CTL_BAR);
    XcdBarrier bar; bar.bar = barw; bar.x = 0; bar.st = nullptr;
    if (P->ph_hi - P->ph_lo > 1) bar = xcd_barrier_post(barw, MISC + 8);
#define IN(k) (kparams()->ph_lo <= (k) && (k) < kparams()->ph_hi)
#define RUN(k, ...) do { if (IN(k)) { KP P = kparams(); unsigned char* ws = P->ws; (void)ws; __VA_ARGS__; if constexpr ((k) == MK_DUP) { __VA_ARGS__; } } } while (0)
#define SEAM(k) do { if (IN(k) && IN((k) + 1)) xcd_barrier(bar); } while (0)
    unsigned char* ws = P->ws;
    const int G = gridDim.x, cid = blockIdx.x;
    const float* MOD = (const float*)(ws + WS_MOD);

    RUN(0, phase_prologue(P, lds, tid, lane, wave); __syncthreads()); SEAM(0);

    RUN(1, phase_norm1_l0(P, lds, tid, lane, wave));

    SEAM(1);
#define GEMM_IN0() do { { pg8::Gemm g{(const bf16*)(ws + WS_H), (const bf16*)(ws + WS_WIN0), NT, 2048, D}; pg8::StaticOrder<false> S; S.init(NT, 2048, G, cid); \
        EpiIn0 E{(bf16*)(ws + WS_R2), 0, 1.0f, P->in[I_BKG], (LAS float*)(lds + LDS_KPART)}; pg8::gemm_phase<EpiIn0, pg8::StaticOrder<false>, true, true>(lds, g, S, E); } \
      { const bool withctx = G < 64; pg8::Gemm g{(const bf16*)(ws + WS_H8), (const bf16*)(ws + WS_WIN0F8), withctx ? MTOT : NT, 3072, D / 2}; pg8::StaticOrder<false> S; S.init(withctx ? MTOT : NT, 3072, G, cid); \
        EpiIn0 E{(bf16*)(ws + WS_R2), 2, F8_WINV, P->in[I_BKG], (LAS float*)(lds + LDS_KPART)}; pg8::gemm_phase<EpiIn0, pg8::StaticOrder<false>, true, true, true>(lds, g, S, E); } } while (0)
    RUN(2, GEMM_IN0()); SEAM(2);
    RUN(4, phase_attn(P, lds, tid, lane, wave)); if (IN(4)) __syncthreads();
    RUN(3, phase_gmlp(P, lds, tid, lane, wave)); SEAM(4);
#define GEMM_OUT0() do { pg8::Gemm g{(const bf16*)(ws + WS_R3), (const bf16*)(ws + WS_WOUT0), NT, D, D}; pg8::StaticOrder<false> S; S.init(NT, D, G, cid); \
        EpiResid<true> E{(const void*)P->in[I_X], (bf16*)(ws + WS_XLB), MOD + 2 * 2048}; pg8::gemm_phase<EpiResid<true>, pg8::StaticOrder<false>, true, true>(lds, g, S, E); } while (0)
    RUN(5, GEMM_OUT0()); SEAM(5);
#define GEMM_GU(L) do { static_assert(F8L(L), "gathered gate|up GEMM is fp8 only"); \
        pg8::Gemm g{(const bf16*)(ws + WS_H), (const bf16*)(ws + WS_GU) + (size_t)(L) * 16 * 2048 * 2048, 65536, 2048, D / 2}; pg8::StaticOrder<true> S; S.init(65536, 2048, G, cid); \
        LAS int* tbl = (LAS int*)(lds + LDS_GTBL); const int* IDXg = (const int*)(ws + WS_IDX); \
        for (int e_ = tid; e_ < 8 * 256; e_ += NWAVES * 64) { const int ui_ = e_ >> 8, r_ = e_ & 255; pg8::Unit u_; \
            if (S.next(ui_, u_)) { const int rowid = u_.pm * 256 + r_, ex = rowid >> 12, b_ = (rowid >> 11) & 1, slot = rowid & 2047; tbl[e_] = b_ * SEQ + IDXg[(b_ * 16 + ex) * CAP + slot]; } } \
        __syncthreads(); \
        EpiSwiglu<true> E{(void*)(ws + WS_HID)}; pg8::gemm_phase_gather_f8<EpiSwiglu<true>, pg8::StaticOrder<true>>(lds, g, S, E, tbl); } while (0)
#define GEMM_DN(L) do { constexpr bool F8 = F8L(L); pg8::Gemm g{(const bf16*)(ws + WS_HID), (const bf16*)(ws + WS_DN) + (size_t)(L) * 16 * 2048 * 1024, 65536, 2048, F8 ? FF / 2 : FF}; pg8::StaticOrder<true> S; S.init(65536, 2048, G, cid); \
        EpiPlain E{(unsigned char*)(ws + WS_R3), D, F8 ? F8_WINV : 1.0f, NOSTDN}; pg8::gemm_phase<EpiPlain, pg8::StaticOrder<true>, true, true, F8>(lds, g, S, E); } while (0)
#define NOSTDN 0
#define MOE_PHASES(L, base) \
    RUN(base + 0, phase_norm2_router(P, L, lds, tid, lane, wave)); SEAM(base + 0); \
    if (IN(base + 1)) { phase_topk(P, L, lds, tid, lane, wave); } SEAM(base + 1); \
    RUN(base + 3, GEMM_GU(L)); SEAM(base + 3); \
    RUN(base + 4, GEMM_DN(L)); SEAM(base + 4);
    MOE_PHASES(0, 6)
#if MK_DUP == 110
#undef NOSTDN
#define NOSTDN (P->pad + MK_NOST)
    if (IN(10)) { KP P = kparams(); unsigned char* ws = P->ws; GEMM_DN(0); }
#undef NOSTDN
#define NOSTDN 0
#endif
    if (IN(11)) { phase_combine<true>(P, 0, lane, wave); } SEAM(11);
#define GEMM_CIN() do { pg8::Gemm g{(const bf16*)(ws + WS_H), (const bf16*)(ws + WS_WCIN), NT, 6144, D}; pg8::StaticOrder<false> S; S.init(NT, 6144, G, cid); S.hot = NOST; \
        EpiCin E{(bf16*)(ws + WS_R2), (bf16*)(ws + WS_R2) + (size_t)NT * D, NOST}; pg8::gemm_phase<EpiCin, pg8::StaticOrder<false>, true, true>(lds, g, S, E); } while (0)
#define NOST 0
    RUN(12, GEMM_CIN()); SEAM(12);
#undef NOST
#if MK_DUP == 112
#define NOST (P->pad + 1)
    if (IN(12)) { GEMM_CIN(); }
#undef NOST
#endif
    RUN(13, phase_conv(P, lane, wave)); SEAM(13);
    if (IN(14)) {
        pg8::Gemm g{(const bf16*)(ws + WS_R3), (const bf16*)(ws + WS_WCOUT), NT, D, D}; pg8::StaticOrder<false> S; S.init(NT, D, G, cid);
        EpiResid<false> E{(const void*)(ws + WS_XLB), (bf16*)(ws + WS_XLB), MOD + 3 * 12288 + 2 * 2048};
        pg8::gemm_phase<EpiResid<false>, pg8::StaticOrder<false>, true, true>(lds, g, S, E);
    } SEAM(14);
    MOE_PHASES(1, 15)
    if (IN(20)) { phase_combine<false>(P, 1, lane, wave); }
#undef IN
#undef SEAM
}

extern "C" void kernel_launch(void* const* d_in, const int* in_sizes, int n_in, void* d_out, int out_size, void* d_ws, size_t ws_size, hipStream_t stream) {
    static int grid = 0;
    if (grid == 0) {
        if (n_in != 23 || out_size != NT * D || ws_size < WS_END) { fprintf(stderr, "kernel_launch: unexpected shapes (n_in %d out %d ws %zu)\n", n_in, out_size, ws_size); grid = -1; return; }
        int dev = 0, cus = 0, per_cu = 0;
        if (hipGetDevice(&dev) != hipSuccess || hipDeviceGetAttribute(&cus, hipDeviceAttributeMultiprocessorCount, dev) != hipSuccess) { grid = -1; return; }
        if (hipFuncSetAttribute((const void*)mega_fwd, hipFuncAttributeMaxDynamicSharedMemorySize, LDS_BYTES) != hipSuccess) { fprintf(stderr, "kernel_launch: hipFuncSetAttribute failed\n"); grid = -1; return; }
        if (hipOccupancyMaxActiveBlocksPerMultiprocessor(&per_cu, (const void*)mega_fwd, NWAVES * 64, LDS_BYTES) != hipSuccess || per_cu < 1) { fprintf(stderr, "kernel_launch: occupancy query says %d\n", per_cu); }
        (void)hipGetLastError();
        if (cus != 256) { fprintf(stderr, "kernel_launch: built for a 256-CU device (unit counts, the gathered-row table and the context projection assume 256 workgroups); found %d\n", cus); grid = -1; return; }
        grid = cus;
    }
    if (grid < 0) return;
    (void)hipMemsetAsync((char*)d_ws + WS_CTL, 0, CTL_ZERO_BYTES, stream);
    Params p{};
    for (int i = 0; i < 23; ++i) p.in[i] = (const float*)d_in[i];
    p.out = (float*)d_out; p.ws = (unsigned char*)d_ws; p.pad = 0;
    const int last = MK_STOP < NPHASE - 1 ? MK_STOP : NPHASE - 1;
#if MK_SPLIT
    for (int k = 0; k <= last; ++k) { p.ph_lo = k; p.ph_hi = k + 1; p.li = 0; hipLaunchKernelGGL(mega_fwd, dim3(grid), dim3(NWAVES * 64), LDS_BYTES, stream, p); }
#else
    p.ph_lo = 0; p.ph_hi = last + 1; p.li = 0;
    hipLaunchKernelGGL(mega_fwd, dim3(grid), dim3(NWAVES * 64), LDS_BYTES, stream, p);
#endif
}
```
